# Optimizing an MI355X kernel written in HIP

```python
import jax, jax.numpy as jnp
from jax import lax
import numpy as np

D_MODEL = 2048
BATCH = 2
SEQ = 4096
DEPTH = 1

EPS = 1e-6
NEG_INF = -1e30

RET_HEADS = 8
RET_QK_DIM = 128
RET_V_DIM = 256
RET_CHUNK = 128
RET_THETA = 10000.0
RET_QK_W = RET_HEADS * RET_QK_DIM
RET_V_W = RET_HEADS * RET_V_DIM

ATT_SEGMENTS = ((128, 1), (512, 4), (2048, 16))
ATT_HEADS_PER_GROUP = 8
ATT_HEAD_DIM = 128
ATT_ROT_DIM = ATT_HEAD_DIM // 4
ATT_THETA = 500000.0
ATT_HEADS = len(ATT_SEGMENTS) * ATT_HEADS_PER_GROUP
ATT_W = ATT_HEADS * ATT_HEAD_DIM
ATT_OUT_W = ATT_HEADS_PER_GROUP * ATT_HEAD_DIM

PEER_HEADS = 8
PEER_N_KEYS = 128
PEER_N_EXPERTS = PEER_N_KEYS * PEER_N_KEYS
PEER_QUERY_DIM = 256
PEER_TOPK = 16
PEER_TOKEN_BLOCK = 128

IN_SPLITS = (RET_QK_W, RET_QK_W, RET_V_W, RET_V_W, ATT_W, ATT_W, ATT_W, D_MODEL, D_MODEL)
IN_WIDTH = sum(IN_SPLITS)

kernel_name = 'hybrid_retention_dilated_attn_peer'


def rms_norm(x, g):
    xf = x.astype(jnp.float32)
    y = xf * lax.rsqrt(jnp.mean(xf * xf, axis=-1, keepdims=True) + EPS)
    return (y * g.astype(jnp.float32)).astype(x.dtype)


def rotary(x, rot_dim, theta):
    S = x.shape[1]
    half = rot_dim // 2
    freqs = theta ** (-jnp.arange(half, dtype=jnp.float32) / half)
    ang = jnp.arange(S, dtype=jnp.float32)[:, None] * freqs[None, :]
    cos = jnp.cos(ang)[None, :, None, :].astype(x.dtype)
    sin = jnp.sin(ang)[None, :, None, :].astype(x.dtype)
    x1 = x[..., :half]
    x2 = x[..., half:rot_dim]
    return jnp.concatenate([x1 * cos - x2 * sin, x2 * cos + x1 * sin, x[..., rot_dim:]], axis=-1)


def retention_direction(q, k, v, log_gamma, include_diag):
    B, S, H, dk = q.shape
    dv = v.shape[-1]
    C = RET_CHUNK
    nc = S // C
    qc = q.reshape(B, nc, C, H, dk).transpose(0, 1, 3, 2, 4)
    kc = k.reshape(B, nc, C, H, dk).transpose(0, 1, 3, 2, 4)
    vc = v.reshape(B, nc, C, H, dv).transpose(0, 1, 3, 2, 4)
    lg = log_gamma.astype(jnp.float32)
    pos = jnp.arange(C, dtype=jnp.float32)
    diff = pos[:, None] - pos[None, :]
    lower = (diff >= 0) if include_diag else (diff > 0)
    inner_decay = jnp.where(lower[None], jnp.exp(lg[:, None, None] * jnp.maximum(diff, 0.0)[None]), 0.0)
    q_decay = jnp.exp(lg[:, None] * (pos + 1.0)[None, :])
    k_decay = jnp.exp(lg[:, None] * (C - 1.0 - pos)[None, :])
    chunk_decay = jnp.exp(lg * C)
    scores = jnp.einsum('bnhid,bnhjd->bnhij', qc, kc) * inner_decay
    inner = jnp.einsum('bnhij,bnhje->bnhie', scores, vc)
    updates = jnp.einsum('bnhjd,hj,bnhje->bnhde', kc, k_decay, vc)

    def step(state, upd):
        return chunk_decay[None, :, None, None] * state + upd, state

    init = jnp.zeros((B, H, dk, dv), updates.dtype)
    _, prev = lax.scan(step, init, jnp.moveaxis(updates, 1, 0))
    prev = jnp.moveaxis(prev, 0, 1)
    cross = jnp.einsum('bnhid,bnhde->bnhie', qc, prev) * q_decay[None, None, :, :, None]
    out = inner + cross
    return out.transpose(0, 1, 3, 2, 4).reshape(B, S, H, dv)


def retention_branch(rq, rk, rv, rg, decay_fwd, decay_bwd, gn_g):
    B, S, _ = rq.shape
    q = rotary(rq.reshape(B, S, RET_HEADS, RET_QK_DIM), RET_QK_DIM, RET_THETA)
    k = rotary(rk.reshape(B, S, RET_HEADS, RET_QK_DIM), RET_QK_DIM, RET_THETA) * (RET_QK_DIM ** -0.5)
    v = rv.reshape(B, S, RET_HEADS, RET_V_DIM)
    lg_f = -jnp.exp(decay_fwd.astype(jnp.float32))
    lg_b = -jnp.exp(decay_bwd.astype(jnp.float32))
    fwd = retention_direction(q, k, v, lg_f, True)
    bwd = jnp.flip(retention_direction(jnp.flip(q, 1), jnp.flip(k, 1), jnp.flip(v, 1), lg_b, False), 1)
    o = (fwd + bwd).astype(jnp.float32)
    mu = jnp.mean(o, axis=-1, keepdims=True)
    var = jnp.mean(jnp.square(o - mu), axis=-1, keepdims=True)
    o = ((o - mu) * lax.rsqrt(var + EPS)).reshape(B, S, RET_V_W) * gn_g.astype(jnp.float32)
    return (jax.nn.silu(rg.astype(jnp.float32)) * o).astype(rg.dtype)


def dilated_window_attention(q, k, v, dilation, half):
    B, S, H, d = q.shape
    L = S // dilation
    N = B * dilation

    def by_residue(t):
        return t.reshape(B, L, dilation, H, d).transpose(0, 2, 1, 3, 4).reshape(N, L, H, d)

    qs, ks, vs = by_residue(q), by_residue(k), by_residue(v)
    blk = half
    nb = -(-L // blk)
    Lp = nb * blk
    qb = jnp.pad(qs, ((0, 0), (0, Lp - L), (0, 0), (0, 0))).reshape(N, nb, blk, H, d)
    kv_pad = ((0, 0), (blk, Lp - L + blk), (0, 0), (0, 0))
    kp = jnp.pad(ks, kv_pad).reshape(N, nb + 2, blk, H, d)
    vp = jnp.pad(vs, kv_pad).reshape(N, nb + 2, blk, H, d)
    kb = jnp.concatenate([kp[:, :-2], kp[:, 1:-1], kp[:, 2:]], axis=2)
    vb = jnp.concatenate([vp[:, :-2], vp[:, 1:-1], vp[:, 2:]], axis=2)
    s = jnp.einsum('nbihd,nbjhd->nbhij', qb, kb).astype(jnp.float32) * (d ** -0.5)
    qpos = jnp.arange(nb)[:, None] * blk + jnp.arange(blk)[None, :]
    kpos = jnp.arange(nb)[:, None] * blk - blk + jnp.arange(3 * blk)[None, :]
    rel = kpos[:, None, :] - qpos[:, :, None]
    valid = (jnp.abs(rel) <= half) & (kpos[:, None, :] >= 0) & (kpos[:, None, :] < L)
    s = jnp.where(valid[None, :, None], s, NEG_INF)
    m = jnp.max(s, axis=-1, keepdims=True)
    p = jnp.exp(s - m)
    l = jnp.sum(p, axis=-1, keepdims=True)
    o = jnp.einsum('nbhij,nbjhd->nbihd', p / l, vb)
    lse = (m + jnp.log(l))[..., 0].transpose(0, 1, 3, 2)
    o = o.reshape(N, Lp, H, d)[:, :L].reshape(B, dilation, L, H, d).transpose(0, 2, 1, 3, 4).reshape(B, S, H, d)
    lse = lse.reshape(N, Lp, H)[:, :L].reshape(B, dilation, L, H).transpose(0, 2, 1, 3).reshape(B, S, H)
    return o, lse


def dilated_attention_branch(aq, ak, av, q_norm_g, k_norm_g):
    B, S, _ = aq.shape
    shape = (B, S, ATT_HEADS, ATT_HEAD_DIM)
    q = rotary(rms_norm(aq.reshape(shape), q_norm_g), ATT_ROT_DIM, ATT_THETA)
    k = rotary(rms_norm(ak.reshape(shape), k_norm_g), ATT_ROT_DIM, ATT_THETA)
    v = av.reshape(shape)
    outs, lses = [], []
    for gi, (window, dilation) in enumerate(ATT_SEGMENTS):
        hs = slice(gi * ATT_HEADS_PER_GROUP, (gi + 1) * ATT_HEADS_PER_GROUP)
        o, lse = dilated_window_attention(q[:, :, hs], k[:, :, hs], v[:, :, hs], dilation, window // (2 * dilation))
        outs.append(o)
        lses.append(lse)
    w = jax.nn.softmax(jnp.stack(lses), axis=0)
    o = jnp.einsum('gbsh,gbshd->bshd', w, jnp.stack(outs))
    return o.reshape(B, S, ATT_OUT_W).astype(aq.dtype)


def peer_ffn(h, w_query, sub_keys, u, v):
    B, S, D = h.shape
    hq = PEER_QUERY_DIM // 2
    q = (h @ w_query).reshape(B, S, PEER_HEADS, PEER_QUERY_DIM).astype(jnp.float32)
    s1 = jnp.einsum('bshd,hkd->bshk', q[..., :hq], sub_keys[:, 0].astype(jnp.float32))
    s2 = jnp.einsum('bshd,hkd->bshk', q[..., hq:], sub_keys[:, 1].astype(jnp.float32))
    v1, i1 = lax.top_k(s1, PEER_TOPK)
    v2, i2 = lax.top_k(s2, PEER_TOPK)
    cand = (v1[..., :, None] + v2[..., None, :]).reshape(B, S, PEER_HEADS, PEER_TOPK * PEER_TOPK)
    best, pos = lax.top_k(cand, PEER_TOPK)
    e1 = jnp.take_along_axis(i1, pos // PEER_TOPK, axis=-1)
    e2 = jnp.take_along_axis(i2, pos % PEER_TOPK, axis=-1)
    experts = e1 * PEER_N_KEYS + e2
    gates = jax.nn.softmax(best, axis=-1)
    T = B * S
    nblk = T // PEER_TOKEN_BLOCK

    def block(args):
        hb, eb, gb = args
        a = jnp.einsum('td,thkd->thk', hb, u[eb])
        act = jax.nn.gelu(a.astype(jnp.float32), approximate=False) * gb
        return jnp.einsum('thk,thkd->td', act.astype(hb.dtype), v[eb])

    out = lax.map(block, (h.reshape(nblk, PEER_TOKEN_BLOCK, D),
                          experts.reshape(nblk, PEER_TOKEN_BLOCK, PEER_HEADS, PEER_TOPK),
                          gates.reshape(nblk, PEER_TOKEN_BLOCK, PEER_HEADS, PEER_TOPK)))
    return out.reshape(B, S, D)


def setup_inputs(seed: int = 0) -> dict:
    key = jax.random.key(seed)
    ks = jax.random.split(key, 16)
    f32 = jnp.float32

    def normal(k, shape, scale):
        return jax.random.normal(k, shape, f32) * scale

    heads = jnp.arange(RET_HEADS, dtype=f32)
    base = jnp.log(-jnp.log1p(-jnp.exp2(-5.0 - heads)))
    return {
        'x': normal(ks[0], (BATCH, SEQ, D_MODEL), 1.0),
        'mix_norm_g': 1.0 + normal(ks[1], (DEPTH, D_MODEL), 0.02),
        'w_in': normal(ks[2], (DEPTH, D_MODEL, IN_WIDTH), D_MODEL ** -0.5),
        'ret_decay_fwd': base + normal(ks[3], (DEPTH, RET_HEADS), 0.01),
        'ret_decay_bwd': base + normal(ks[4], (DEPTH, RET_HEADS), 0.01),
        'ret_gn_g': 1.0 + normal(ks[5], (DEPTH, RET_V_W), 0.02),
        'w_ret_out': normal(ks[6], (DEPTH, RET_V_W, D_MODEL), RET_V_W ** -0.5),
        'attn_q_norm_g': 1.0 + normal(ks[7], (DEPTH, ATT_HEAD_DIM), 0.02),
        'attn_k_norm_g': 1.0 + normal(ks[8], (DEPTH, ATT_HEAD_DIM), 0.02),
        'w_attn_out': normal(ks[9], (DEPTH, ATT_OUT_W, D_MODEL), ATT_OUT_W ** -0.5),
        'w_out': normal(ks[10], (DEPTH, D_MODEL, D_MODEL), D_MODEL ** -0.5),
        'ffn_norm_g': 1.0 + normal(ks[11], (DEPTH, D_MODEL), 0.02),
        'peer_w_query': normal(ks[12], (DEPTH, D_MODEL, PEER_HEADS * PEER_QUERY_DIM), D_MODEL ** -0.5),
        'peer_sub_keys': normal(ks[13], (DEPTH, PEER_HEADS, 2, PEER_N_KEYS, PEER_QUERY_DIM // 2), (PEER_QUERY_DIM // 2) ** -0.5),
        'peer_u': normal(ks[14], (DEPTH, PEER_N_EXPERTS, D_MODEL), D_MODEL ** -0.5),
        'peer_v': normal(ks[15], (DEPTH, PEER_N_EXPERTS, D_MODEL), PEER_TOPK ** -0.5),
    }


def reference(x, mix_norm_g, w_in, ret_decay_fwd, ret_decay_bwd, ret_gn_g, w_ret_out,
              attn_q_norm_g, attn_k_norm_g, w_attn_out, w_out, ffn_norm_g,
              peer_w_query, peer_sub_keys, peer_u, peer_v):
    split_at = np.cumsum(IN_SPLITS)[:-1].tolist()
    for l in range(DEPTH):
        h = rms_norm(x, mix_norm_g[l])
        proj = h @ w_in[l]
        rq, rk, rv, rg, aq, ak, av, gate_ret, gate_att = jnp.split(proj, split_at, axis=-1)
        ret = retention_branch(rq, rk, rv, rg, ret_decay_fwd[l], ret_decay_bwd[l], ret_gn_g[l]) @ w_ret_out[l]
        att = dilated_attention_branch(aq, ak, av, attn_q_norm_g[l], attn_k_norm_g[l]) @ w_attn_out[l]
        merged = jax.nn.sigmoid(gate_ret) * ret + jax.nn.sigmoid(gate_att) * att
        x = x + merged @ w_out[l]
        h2 = rms_norm(x, ffn_norm_g[l])
        x = x + peer_ffn(h2, peer_w_query[l], peer_sub_keys[l], peer_u[l], peer_v[l])
    return x
```

```cpp
#include <hip/hip_runtime.h>
#include <cstdio>
#include <cstdint>
namespace pg8 {
#define PG8_LAS __attribute__((address_space(3)))
typedef unsigned short bf16_t;
typedef short bf16x8 __attribute__((ext_vector_type(8)));
typedef float f32x4 __attribute__((ext_vector_type(4)));
typedef unsigned u32x4 __attribute__((ext_vector_type(4)));
constexpr int BM = 256, BK = 64, HALF = 128, HTB = HALF * BK * 2  , STAGE_BYTES = 8 * HTB, NXCD = 8, WGM = 8;

__host__ __device__ __forceinline__ int lds_byte(int r, int c) { const int st = (r >> 4) * 2 + (c >> 5), rr = r & 15, cc = c & 31, ob = rr * 64 + cc * 2; return st * 1024 + (ob ^ (((ob >> 9) & 1) << 5)); }
__host__ __device__ __forceinline__ void stage_rc(int b, int& R, int& C) { const int st = b / 1024, sb = b % 1024, swz = sb ^ (((sb >> 9) & 1) << 5); R = (st >> 1) * 16 + swz / 64; C = (st & 1) * 32 + (swz % 64) / 2; }
__host__ __device__ __forceinline__ int perm32(int rho) { const int n = rho >> 4, i = rho & 15; return 8 * (i >> 2) + 4 * n + (i & 3); }

struct Unit { int pm, pn; };
struct Gemm { const bf16_t* A; const bf16_t* Bt; int M, N, K; };

struct StaticOrder {
    int nM, nN, nwg, G, c;
    __host__ __device__ void init(int M, int N, int G_, int c_) { nM = M / BM; nN = N / BM; nwg = nM * nN; G = G_; c = c_; }
    __host__ __device__ bool next(int i, Unit& u) const {
        const long L = (long)i * G + c; if (L >= nwg) return false;
        int wgid = (int)L; { const int q = nwg / NXCD, r = nwg % NXCD, xcd = wgid % NXCD, off = wgid / NXCD; wgid = (xcd < r ? xcd * (q + 1) : r * (q + 1) + (xcd - r) * q) + off; }
        const int nig = WGM * nN, gid = wgid / nig, fm = gid * WGM, gsz = (nM - fm) < WGM ? (nM - fm) : WGM;
        u.pm = fm + ((wgid % nig) % gsz); u.pn = (wgid % nig) / gsz; return true;
    }
    __device__ __forceinline__ void a_ready(const Unit&) const {}
    __device__ __forceinline__ void done(const Unit&) const {}
};

__device__ __forceinline__ unsigned cvt_pk_bf16(float lo, float hi) { unsigned r; asm volatile("v_cvt_pk_bf16_f32 %0, %1, %2" : "=v"(r) : "v"(lo), "v"(hi)); return r; }
typedef float f32x2 __attribute__((ext_vector_type(2)));
__device__ __forceinline__ f32x2 gelu_pk(f32x2 v) {
    const f32x2 av = __builtin_elementwise_abs(v), d = av * 0.2316418882f + 1.0f;
    f32x2 t; t.x = __builtin_amdgcn_rcpf(d.x); t.y = __builtin_amdgcn_rcpf(d.y);
    f32x2 q = t * 0.5307027145f + (-0.7265760135f); q = q * t + 0.7107068705f; q = q * t + (-0.142248368f); q = q * t + 0.127414796f; q = q * t;
    const f32x2 s = (v * v) * (-0.72134752044f);
    f32x2 e; e.x = __builtin_amdgcn_exp2f(s.x); e.y = __builtin_amdgcn_exp2f(s.y);
    const f32x2 m = v * (q * e), r = v - m;
    f32x2 o; o.x = v.x < 0.f ? m.x : r.x; o.y = v.y < 0.f ? m.y : r.y; return o;
}

template <int ACT  > struct EpiBf16 {
    static constexpr bool PERM = true, AFTER_DRAIN = false; static_assert(ACT == 0 || ACT == 1, "EpiBf16: ACT is 0 (none) or 1 (gelu_pk)");
    bf16_t* O; int ldc; const float* bias; int split_cols; size_t split_stride; float scale0;
    __device__ __forceinline__ void operator()(const f32x4 (&acc)[2][2][4][2], const Unit& u, int wr, int wc, int fr, int fq) const {
        const int row0 = u.pm * BM + wr * 64 + fr; int colt = u.pn * BM; bf16_t* base = O;
        float sc = 1.f; if (split_cols) { const int t = colt / split_cols; base += (size_t)t * split_stride; colt -= t * split_cols; if (t == 0) sc = scale0; }
        const int col0 = colt + wc * 32 + 8 * fq, bcol0 = u.pn * BM + wc * 32 + 8 * fq;
        f32x4 bv[2][2];
#pragma unroll
        for (int bj = 0; bj < 2; ++bj)
#pragma unroll
            for (int n = 0; n < 2; ++n) bv[bj][n] = bias ? *(const f32x4*)(bias + bcol0 + bj * HALF + 4 * n) : (f32x4){0.f, 0.f, 0.f, 0.f};
#pragma unroll
        for (int ai = 0; ai < 2; ++ai)
#pragma unroll
            for (int m = 0; m < 4; ++m) { bf16_t* rowp = base + (size_t)(row0 + ai * HALF + m * 16) * ldc + col0;
#pragma unroll
                for (int bj = 0; bj < 2; ++bj) { f32x4 v0 = acc[ai][bj][m][0] + bv[bj][0], v1 = acc[ai][bj][m][1] + bv[bj][1];
                    if (ACT == 1) { f32x2 a = gelu_pk((f32x2){v0[0], v0[1]}), b = gelu_pk((f32x2){v0[2], v0[3]}), c = gelu_pk((f32x2){v1[0], v1[1]}), d = gelu_pk((f32x2){v1[2], v1[3]});
                        v0 = (f32x4){a.x, a.y, b.x, b.y}; v1 = (f32x4){c.x, c.y, d.x, d.y}; }
                    v0 = v0 * sc; v1 = v1 * sc; u32x4 w; w.x = cvt_pk_bf16(v0[0], v0[1]); w.y = cvt_pk_bf16(v0[2], v0[3]); w.z = cvt_pk_bf16(v1[0], v1[1]); w.w = cvt_pk_bf16(v1[2], v1[3]);
                    *(u32x4*)(rowp + bj * HALF) = w; } }
    }
};
template <class Epi, class Sched, bool ALIGN_EPI = false, bool SP2 = false>
__device__ __forceinline__ void gemm_phase(PG8_LAS unsigned char* lds, const Gemm g, const Sched& S, const Epi& E) {
    const int tid = threadIdx.x, wid = __builtin_amdgcn_readfirstlane(tid >> 6), lane = tid & 63, wr = wid >> 2, wc = wid & 3, fr = lane & 15, fq = lane >> 4;
    const int K = g.K, nt = K / BK;
    unsigned voffA[2], voffB[2];
#pragma unroll
    for (int i = 0; i < 2; ++i) { int R, C; stage_rc(tid * 16 + i * 8192, R, C); const int Rb = Epi::PERM ? ((R & ~31) + perm32(R & 31)) : R;
        voffA[i] = (unsigned)(R * K + C) * 2u; voffB[i] = (unsigned)(Rb * K + C) * 2u; }
    const size_t kstep = (size_t)(BK * 2);
    const size_t hstep = (size_t)HALF * K * 2;
    const size_t tstep = 2 * hstep;
    const unsigned ldsw = (unsigned)wid * 1024u;
    const int aoff = lds_byte(wr * 64 + fr, fq * 8), boff = lds_byte(wc * 32 + fr, fq * 8);
#define PG8_SA(b, h) (((b) * 2 + (h)) * HTB)
#define PG8_SB(b, h) ((4 + (b) * 2 + (h)) * HTB)
#define PG8_STAGE(bufoff, gbase, voff) do { _Pragma("unroll") for (int _i = 0; _i < 2; ++_i) \
        __builtin_amdgcn_global_load_lds((const unsigned*)((const char*)(gbase) + (voff)[_i]), (PG8_LAS unsigned*)(lds + (bufoff) + ldsw + _i * 8192), 16, 0, 0); } while (0)
#define PG8_LDA(dst, b, h) do { _Pragma("unroll") for (int m = 0; m < 4; ++m) _Pragma("unroll") for (int k = 0; k < 2; ++k) dst[m][k] = *(const PG8_LAS bf16x8*)(lds + PG8_SA(b, h) + aoff + m * 2048 + k * 1024); } while (0)
#define PG8_LDB(dst, b, h) do { _Pragma("unroll") for (int n = 0; n < 2; ++n) _Pragma("unroll") for (int k = 0; k < 2; ++k) dst[n][k] = *(const PG8_LAS bf16x8*)(lds + PG8_SB(b, h) + boff + n * 2048 + k * 1024); } while (0)
#define PG8_MMA(ai, bj, At, Bt) do { __builtin_amdgcn_s_setprio(1); _Pragma("unroll") for (int m = 0; m < 4; ++m) _Pragma("unroll") for (int n = 0; n < 2; ++n) _Pragma("unroll") for (int k = 0; k < 2; ++k) \
        acc[ai][bj][m][n] = __builtin_amdgcn_mfma_f32_16x16x32_bf16(Bt[n][k], At[m][k], acc[ai][bj][m][n], 0, 0, 0); __builtin_amdgcn_s_setprio(0); } while (0)
#define PG8_WAIT_V(n) asm volatile("s_waitcnt vmcnt(" #n ")" ::: "memory")
#define PG8_WAIT_L(n) asm volatile("s_waitcnt lgkmcnt(" #n ")" ::: "memory")
#define PG8_BAR __builtin_amdgcn_s_barrier()
#define PG8_SCHED __builtin_amdgcn_sched_barrier(0)
    Unit cur, nxt; int ui = 0;
    if (!S.next(0, cur)) return;
    f32x4 acc[2][2][4][2];
#pragma unroll
    for (int a = 0; a < 2; ++a)
#pragma unroll
        for (int b = 0; b < 2; ++b)
#pragma unroll
            for (int m = 0; m < 4; ++m)
#pragma unroll
                for (int n = 0; n < 2; ++n) acc[a][b][m][n] = (f32x4){0.f, 0.f, 0.f, 0.f};
    bf16x8 At[4][2], B0[2][2], B1[2][2];
    const char* cA = (const char*)g.A + (size_t)cur.pm * tstep; const char* cB = (const char*)g.Bt + (size_t)cur.pn * tstep;
    S.a_ready(cur);
    if constexpr (SP2) {
        PG8_STAGE(PG8_SB(0, 0), cB, voffB); PG8_STAGE(PG8_SB(0, 1), cB + hstep, voffB); PG8_STAGE(PG8_SA(0, 0), cA, voffA); PG8_STAGE(PG8_SA(0, 1), cA + hstep, voffA);
        if (wr == 1) PG8_BAR;
        PG8_WAIT_V(2); PG8_BAR;
        PG8_STAGE(PG8_SB(1, 0), cB + kstep, voffB); PG8_STAGE(PG8_SA(1, 0), cA + kstep, voffA); PG8_STAGE(PG8_SB(1, 1), cB + hstep + kstep, voffB);
        PG8_WAIT_V(6); PG8_BAR;
    } else {
        PG8_STAGE(PG8_SB(0, 0), cB, voffB); PG8_STAGE(PG8_SA(0, 0), cA, voffA); PG8_STAGE(PG8_SB(0, 1), cB + hstep, voffB); PG8_STAGE(PG8_SA(0, 1), cA + hstep, voffA);
        if (wr == 1) PG8_BAR;
        PG8_WAIT_V(4); PG8_BAR;
        PG8_STAGE(PG8_SB(1, 0), cB + kstep, voffB); PG8_STAGE(PG8_SA(1, 0), cA + kstep, voffA); PG8_STAGE(PG8_SB(1, 1), cB + hstep + kstep, voffB);
        PG8_WAIT_V(6); PG8_BAR;
    }
    for (;;) {
        const bool has_next = S.next(ui + 1, nxt);
        const char* nA = has_next ? (const char*)g.A + (size_t)nxt.pm * tstep : cA; const char* nB = has_next ? (const char*)g.Bt + (size_t)nxt.pn * tstep : cB;
        for (int t = 0; t < nt; t += 2) {
            const bool last = (t == nt - 2);
            const char* a1 = cA + (size_t)(t + 1) * kstep;
            const char* a2 = last ? nA : cA + (size_t)(t + 2) * kstep; const char* b2 = last ? nB : cB + (size_t)(t + 2) * kstep;
            const char* a3 = a2 + kstep; const char* b3 = b2 + kstep;
            if (last && has_next) S.a_ready(nxt);
            if constexpr (SP2) {
            PG8_LDB(B0, 0, 0); PG8_LDB(B1, 0, 1); PG8_SCHED; PG8_LDA(At, 0, 0); PG8_STAGE(PG8_SA(1, 1), a1 + hstep, voffA);
            PG8_WAIT_V(8); PG8_WAIT_L(0); PG8_BAR; PG8_MMA(0, 0, At, B0); PG8_MMA(0, 1, At, B1); PG8_BAR; PG8_SCHED;
            PG8_LDA(At, 0, 1); PG8_STAGE(PG8_SB(0, 0), b2, voffB); PG8_STAGE(PG8_SB(0, 1), b2 + hstep, voffB); PG8_STAGE(PG8_SA(0, 0), a2, voffA);
            PG8_WAIT_V(8); PG8_WAIT_L(0); PG8_BAR; PG8_MMA(1, 0, At, B0); PG8_MMA(1, 1, At, B1); PG8_BAR; PG8_SCHED;
            PG8_LDB(B0, 1, 0); PG8_LDB(B1, 1, 1); PG8_SCHED; PG8_LDA(At, 1, 0); PG8_STAGE(PG8_SA(0, 1), a2 + hstep, voffA);
            PG8_WAIT_V(8); PG8_WAIT_L(0); PG8_BAR; PG8_MMA(0, 0, At, B0); PG8_MMA(0, 1, At, B1); PG8_BAR; PG8_SCHED;
            PG8_LDA(At, 1, 1); PG8_STAGE(PG8_SB(1, 0), b3, voffB); PG8_STAGE(PG8_SB(1, 1), b3 + hstep, voffB); PG8_STAGE(PG8_SA(1, 0), a3, voffA);
            PG8_WAIT_V(8); PG8_WAIT_L(0); PG8_BAR; PG8_MMA(1, 0, At, B0); PG8_MMA(1, 1, At, B1); PG8_BAR; PG8_SCHED;
            } else {
            PG8_LDB(B0, 0, 0); PG8_SCHED; PG8_LDA(At, 0, 0); PG8_STAGE(PG8_SA(1, 1), a1 + hstep, voffA);
            PG8_WAIT_L(8); PG8_BAR; PG8_WAIT_L(0); PG8_MMA(0, 0, At, B0); PG8_BAR; PG8_SCHED;
            PG8_LDB(B1, 0, 1); PG8_STAGE(PG8_SB(0, 0), b2, voffB);
            PG8_BAR; PG8_WAIT_L(0); PG8_MMA(0, 1, At, B1); PG8_BAR;
            PG8_LDA(At, 0, 1); PG8_STAGE(PG8_SA(0, 0), a2, voffA);
            PG8_BAR; PG8_WAIT_L(0); PG8_MMA(1, 0, At, B0); PG8_BAR; PG8_SCHED;
            PG8_STAGE(PG8_SB(0, 1), b2 + hstep, voffB);
            PG8_WAIT_V(6); PG8_BAR; PG8_MMA(1, 1, At, B1); PG8_BAR;
            PG8_LDB(B0, 1, 0); PG8_SCHED; PG8_LDA(At, 1, 0); PG8_STAGE(PG8_SA(0, 1), a2 + hstep, voffA);
            PG8_WAIT_L(8); PG8_BAR; PG8_WAIT_L(0); PG8_MMA(0, 0, At, B0); PG8_BAR; PG8_SCHED;
            PG8_LDB(B1, 1, 1); PG8_STAGE(PG8_SB(1, 0), b3, voffB);
            PG8_BAR; PG8_WAIT_L(0); PG8_MMA(0, 1, At, B1); PG8_BAR;
            PG8_LDA(At, 1, 1); PG8_STAGE(PG8_SA(1, 0), a3, voffA);
            PG8_BAR; PG8_WAIT_L(0); PG8_MMA(1, 0, At, B0); PG8_BAR; PG8_SCHED;
            PG8_STAGE(PG8_SB(1, 1), b3 + hstep, voffB);
            PG8_WAIT_V(6); PG8_BAR; PG8_MMA(1, 1, At, B1); PG8_BAR;
            }
        }
        if constexpr (ALIGN_EPI) { if (wr == 0) PG8_BAR; }
        if constexpr (!Epi::AFTER_DRAIN) { E(acc, cur, wr, wc, fr, fq); S.done(cur); }
        if (!has_next) break;
#pragma unroll
        for (int a = 0; a < 2; ++a)
#pragma unroll
            for (int b = 0; b < 2; ++b)
#pragma unroll
                for (int m = 0; m < 4; ++m)
#pragma unroll
                    for (int n = 0; n < 2; ++n) acc[a][b][m][n] = (f32x4){0.f, 0.f, 0.f, 0.f};
        cur = nxt; cA = nA; cB = nB; ++ui;
        if constexpr (ALIGN_EPI) { if (wr == 1) PG8_BAR; }
    }
    PG8_WAIT_V(0);
    if constexpr (!ALIGN_EPI) { if (wr == 0) PG8_BAR; }
    PG8_BAR;
    if constexpr (Epi::AFTER_DRAIN) { E.fused(acc, cur, wr, wc, fr, fq, lds, wid, lane); S.done(cur); }
#undef PG8_SA
#undef PG8_SB
#undef PG8_STAGE
#undef PG8_LDA
#undef PG8_LDB
#undef PG8_MMA
#undef PG8_WAIT_V
#undef PG8_WAIT_L
#undef PG8_BAR
#undef PG8_SCHED
}
}

namespace pg8 {
__device__ __forceinline__ float bf2f_(unsigned short u) { return __builtin_bit_cast(float, (unsigned)u << 16); }
__device__ __forceinline__ float sigmoid_(float x) { return 1.0f / (1.0f + __expf(-x)); }
struct EpiProj {
    static constexpr bool PERM = true, AFTER_DRAIN = false;
    bf16_t* base;
    __device__ __forceinline__ void operator()(const f32x4 (&acc)[2][2][4][2], const Unit& u, int wr, int wc, int fr, int fq) const {
        constexpr size_t MT = 8192;
        int colt = u.pn * BM; int width, act = 0; size_t off;
        if (colt < 1024)       { width = 1024; off = 0; }
        else if (colt < 2048)  { colt -= 1024; width = 1024; off = MT * 1024; }
        else if (colt < 4096)  { colt -= 2048; width = 2048; off = MT * 2048; }
        else if (colt < 6144)  { colt -= 4096; width = 2048; off = MT * 4096; act = 1; }
        else if (colt < 9216)  { colt -= 6144; width = 3072; off = MT * 6144; }
        else if (colt < 12288) { colt -= 9216; width = 3072; off = MT * 9216; }
        else if (colt < 15360) { colt -= 12288; width = 3072; off = MT * 12288; }
        else if (colt < 17408) { colt -= 15360; width = 2048; off = MT * 15360; act = 2; }
        else                   { colt -= 17408; width = 2048; off = MT * 17408; act = 2; }
        const int row0 = u.pm * BM + wr * 64 + fr, col0 = colt + wc * 32 + 8 * fq;
        bf16_t* O = base + off;
#pragma unroll
        for (int ai = 0; ai < 2; ++ai)
#pragma unroll
            for (int m = 0; m < 4; ++m) { bf16_t* rowp = O + (size_t)(row0 + ai * HALF + m * 16) * width + col0;
#pragma unroll
                for (int bj = 0; bj < 2; ++bj) { f32x4 v0 = acc[ai][bj][m][0], v1 = acc[ai][bj][m][1];
                    if (act == 1) {
#pragma unroll
                        for (int e = 0; e < 4; ++e) { v0[e] = v0[e] * sigmoid_(v0[e]); v1[e] = v1[e] * sigmoid_(v1[e]); } }
                    else if (act == 2) {
#pragma unroll
                        for (int e = 0; e < 4; ++e) { v0[e] = sigmoid_(v0[e]); v1[e] = sigmoid_(v1[e]); } }
                    u32x4 w; w.x = cvt_pk_bf16(v0[0], v0[1]); w.y = cvt_pk_bf16(v0[2], v0[3]); w.z = cvt_pk_bf16(v1[0], v1[1]); w.w = cvt_pk_bf16(v1[2], v1[3]);
                    *(u32x4*)(rowp + bj * HALF) = w; } }
    }
};
struct EpiGateF32 {
    static constexpr bool PERM = false, AFTER_DRAIN = false;
    float* C; const bf16_t* gate; int ldc;
    __device__ __forceinline__ void operator()(const f32x4 (&acc)[2][2][4][2], const Unit& u, int wr, int wc, int fr, int fq) const {
        const int row0 = u.pm * BM + wr * 64 + fr, col0 = u.pn * BM + wc * 32 + 4 * fq;
#pragma unroll
        for (int ai = 0; ai < 2; ++ai)
#pragma unroll
            for (int m = 0; m < 4; ++m) { const size_t ro = (size_t)(row0 + ai * HALF + m * 16) * ldc + col0;
#pragma unroll
                for (int bj = 0; bj < 2; ++bj)
#pragma unroll
                    for (int n = 0; n < 2; ++n) { const size_t o = ro + bj * HALF + n * 16; const unsigned long long gb = *(const unsigned long long*)(gate + o);
                        f32x4 g; g[0] = bf2f_((unsigned short)gb); g[1] = bf2f_((unsigned short)(gb >> 16)); g[2] = bf2f_((unsigned short)(gb >> 32)); g[3] = bf2f_((unsigned short)(gb >> 48));
                        *(f32x4*)(C + o) = acc[ai][bj][m][n] * g; } }
    }
};
struct EpiGateAddBf16 {
    static constexpr bool PERM = false, AFTER_DRAIN = false;
    bf16_t* O; const float* prev; const bf16_t* gate; int ldc;
    __device__ __forceinline__ void operator()(const f32x4 (&acc)[2][2][4][2], const Unit& u, int wr, int wc, int fr, int fq) const {
        const int row0 = u.pm * BM + wr * 64 + fr, col0 = u.pn * BM + wc * 32 + 4 * fq;
#pragma unroll
        for (int ai = 0; ai < 2; ++ai)
#pragma unroll
            for (int m = 0; m < 4; ++m) { const size_t ro = (size_t)(row0 + ai * HALF + m * 16) * ldc + col0;
#pragma unroll
                for (int bj = 0; bj < 2; ++bj)
#pragma unroll
                    for (int n = 0; n < 2; ++n) { const size_t o = ro + bj * HALF + n * 16; const unsigned long long gb = *(const unsigned long long*)(gate + o);
                        f32x4 g; g[0] = bf2f_((unsigned short)gb); g[1] = bf2f_((unsigned short)(gb >> 16)); g[2] = bf2f_((unsigned short)(gb >> 32)); g[3] = bf2f_((unsigned short)(gb >> 48));
                        const f32x4 r = *(const f32x4*)(prev + o) + acc[ai][bj][m][n] * g;
                        unsigned long long w = (unsigned long long)cvt_pk_bf16(r[0], r[1]) | ((unsigned long long)cvt_pk_bf16(r[2], r[3]) << 32);
                        *(unsigned long long*)(O + o) = w; } }
    }
};
struct EpiResF32 {
    static constexpr bool PERM = false, AFTER_DRAIN = false;
    float* C; const float* res; int ldc;
    __device__ __forceinline__ void operator()(const f32x4 (&acc)[2][2][4][2], const Unit& u, int wr, int wc, int fr, int fq) const {
        const int row0 = u.pm * BM + wr * 64 + fr, col0 = u.pn * BM + wc * 32 + 4 * fq;
#pragma unroll
        for (int ai = 0; ai < 2; ++ai)
#pragma unroll
            for (int m = 0; m < 4; ++m) { const size_t ro = (size_t)(row0 + ai * HALF + m * 16) * ldc + col0;
#pragma unroll
                for (int bj = 0; bj < 2; ++bj)
#pragma unroll
                    for (int n = 0; n < 2; ++n) { const size_t o = ro + bj * HALF + n * 16;
                        f32x4 r = acc[ai][bj][m][n]; if (res) r = r + *(const f32x4*)(res + o);
                        *(f32x4*)(C + o) = r; } }
    }
};
}
#ifndef PG8_SP2
#define PG8_SP2 true
#endif
#ifndef PG8_ALIGN
#define PG8_ALIGN true
#endif

constexpr int NWAVES = 8;
constexpr int NTOK = 8192, SEQ = 4096, DM = 2048, INW = 19456;
constexpr int NEXP = 16384;
constexpr float EPS = 1e-6f;
#ifndef MK_N_LAUNCHES
#define MK_N_LAUNCHES 11
#endif
constexpr int N_PHASES = 11;
constexpr int N_LAUNCHES = MK_N_LAUNCHES;

constexpr size_t MiB = 1u << 20;
constexpr size_t WS_CTL = 0, CTL_ZERO_BYTES = 1 * MiB;
constexpr size_t WS_WINT = 1 * MiB;
constexpr size_t WS_WRET = 77 * MiB;
constexpr size_t WS_WATT = 85 * MiB;
constexpr size_t WS_WOUT = 89 * MiB;
constexpr size_t WS_WQ   = 97 * MiB;
constexpr size_t WS_XN   = 105 * MiB;
constexpr size_t WS_PROJ = 137 * MiB;
constexpr size_t WS_UBF  = 441 * MiB;
constexpr size_t WS_VBF  = 505 * MiB;
constexpr size_t WS_ATT  = 569 * MiB;
constexpr size_t WS_EIDX = 585 * MiB;
constexpr size_t WS_GATE = 589 * MiB;
constexpr size_t WS_RTAB = 593 * MiB;
constexpr size_t WS_ATAB = 595 * MiB;
constexpr size_t WS_END  = 596 * MiB;
constexpr size_t PO_RQ = 0, PO_RK = (size_t)NTOK * 1024, PO_RV = (size_t)NTOK * 2048, PO_RG = (size_t)NTOK * 4096, PO_AQ = (size_t)NTOK * 6144,
                 PO_AK = (size_t)NTOK * 9216, PO_AV = (size_t)NTOK * 12288, PO_GR = (size_t)NTOK * 15360, PO_GA = (size_t)NTOK * 17408;
constexpr int CW_BAR = 4096;

constexpr int RING_OFF = 0, RING_BYTES = 131072;
constexpr int LDSCTL_OFF = RING_BYTES, MISC_OFF = LDSCTL_OFF + 320;
constexpr int LDS_BYTES = 147456;

#define GAS __attribute__((address_space(1)))
#define LAS __attribute__((address_space(3)))
typedef unsigned short bf16;
typedef unsigned v4u __attribute__((ext_vector_type(4)));
typedef unsigned v2u __attribute__((ext_vector_type(2)));
typedef float f32x4 __attribute__((ext_vector_type(4)));
typedef float f32x2 __attribute__((ext_vector_type(2)));
typedef GAS unsigned gu32;
#define RLX_AGENT __ATOMIC_RELAXED, __HIP_MEMORY_SCOPE_AGENT
#define LDS_WAIT() asm volatile("s_waitcnt lgkmcnt(0)" ::: "memory")
#define VM_WAIT() asm volatile("s_waitcnt vmcnt(0)" ::: "memory")
__device__ __forceinline__ unsigned f2bf(float f) { unsigned u = __builtin_bit_cast(unsigned, f); return (u + 0x7fffu + ((u >> 16) & 1u)) >> 16; }
__device__ __forceinline__ unsigned pk2(float lo, float hi) { return f2bf(lo) | (f2bf(hi) << 16); }
__device__ __forceinline__ float bf2f(unsigned u16) { return __builtin_bit_cast(float, u16 << 16); }
__device__ __forceinline__ float bflo(unsigned w) { return __builtin_bit_cast(float, w << 16); }
__device__ __forceinline__ float bfhi(unsigned w) { return __builtin_bit_cast(float, w & 0xffff0000u); }
__device__ __forceinline__ float wave_sum(float v) {
#pragma unroll
    for (int o = 1; o < 64; o <<= 1) v += __shfl_xor(v, o);
    return v;
}
__device__ __forceinline__ float wave_max(float v) {
#pragma unroll
    for (int o = 1; o < 64; o <<= 1) v = fmaxf(v, __shfl_xor(v, o));
    return v;
}
#define XB_TMO      128
#define XB_XCNT(j)  (256  + 64 * (j))
#define XB_XSUB(j)  (1280 + 64 * (j))
#define XB_XGEN(j)  (2304 + 64 * (j))
#define XB_TOP      3328
#define XB_TOPGEN   3392
#define XCD_BAR_WORDS 3456
#define XB_SPIN_CAP (1u << 24)

__device__ __forceinline__ unsigned xb_ld(unsigned* p)              { return __hip_atomic_load(p, __ATOMIC_RELAXED, __HIP_MEMORY_SCOPE_AGENT); }
__device__ __forceinline__ unsigned xb_add(unsigned* p, unsigned v) { return __hip_atomic_fetch_add(p, v, __ATOMIC_RELAXED, __HIP_MEMORY_SCOPE_AGENT); }
__device__ __forceinline__ unsigned xb_xcc_id() { return (unsigned)__builtin_amdgcn_s_getreg((3 << 11) | 20) & 0xFu; }
#define XB_SPIN(cond, bar) do { unsigned _sp = 0; while (cond) { __builtin_amdgcn_s_sleep(1); \
    if ((++_sp & 255u) == 0u) { if (xb_ld(&(bar)[XB_TMO])) break; if (_sp > XB_SPIN_CAP) { atomicAdd(&(bar)[XB_TMO], 1u); break; } } } } while (0)

struct XcdBarrier {
    unsigned* bar; unsigned x;
    volatile LAS unsigned* st;
};

__device__ __forceinline__ XcdBarrier xcd_barrier_post(unsigned* bar, volatile LAS unsigned* st) {
    XcdBarrier b; b.bar = bar; b.x = xb_xcc_id(); b.st = st;
    if (threadIdx.x == 0) (void)xb_add(&bar[XB_XCNT(b.x)], 1u);
    return b;
}
__device__ __forceinline__ void xcd_barrier_complete(unsigned* bar, unsigned x, unsigned& nloc, unsigned& nx) {
    const unsigned G = gridDim.x * gridDim.y * gridDim.z;
    unsigned sum, cnt, mine, sp = 0u;
    for (;;) {
        sum = 0u; cnt = 0u; mine = 0u;
#pragma unroll
        for (unsigned j = 0; j < 16; ++j) { const unsigned c = xb_ld(&bar[XB_XCNT(j)]); sum += c; cnt += (c > 0u) ? 1u : 0u; mine = (j == x) ? c : mine; }
        if (sum == G) break;
        __builtin_amdgcn_s_sleep(1);
        if ((++sp & 255u) == 0u) { if (xb_ld(&bar[XB_TMO])) break; if (sp > XB_SPIN_CAP) { atomicAdd(&bar[XB_TMO], 1u); break; } }
    }
    nloc = mine > 0u ? mine : 1u; nx = cnt > 0u ? cnt : 1u;
}

__device__ __forceinline__ void xcd_barrier(const XcdBarrier& b) {
    asm volatile("s_waitcnt vmcnt(0)" ::: "memory");
    __syncthreads();
    if (threadIdx.x == 0) {
        unsigned* bar = b.bar;
        __builtin_amdgcn_s_waitcnt(0);
        unsigned nloc = b.st[0], nx = b.st[1];
        if (nloc == 0u) { xcd_barrier_complete(bar, b.x, nloc, nx); b.st[0] = nloc; b.st[1] = nx; }
        const unsigned old = xb_add(&bar[XB_XSUB(b.x)], 1u);
        const unsigned gen = old / nloc;
        if (old + 1u == (gen + 1u) * nloc) {
            __builtin_amdgcn_fence(__ATOMIC_RELEASE, "agent");
            asm volatile("s_waitcnt vmcnt(0)" ::: "memory");
            const unsigned og = xb_add(&bar[XB_TOP], 1u);
            const unsigned tg = og / nx;
            if (og + 1u == (tg + 1u) * nx) xb_add(&bar[XB_TOPGEN], 1u);
            else XB_SPIN(xb_ld(&bar[XB_TOPGEN]) == tg, bar);
            __builtin_amdgcn_fence(__ATOMIC_ACQUIRE, "agent");
            xb_add(&bar[XB_XGEN(b.x)], 1u);
            asm volatile("s_waitcnt vmcnt(0)" ::: "memory");
        } else {
            XB_SPIN(xb_ld(&bar[XB_XGEN(b.x)]) == gen, bar);
            __builtin_amdgcn_fence(__ATOMIC_ACQUIRE, "agent");
            asm volatile("s_waitcnt vmcnt(0)" ::: "memory");
        }
    }
    __syncthreads();
}

struct Frame {
    LAS unsigned char* lds;
    volatile LAS unsigned* MISC;
    gu32* ctl;
    int tid, lane, wave;
    int vcu, G;
    const float *x, *mix_g, *w_in, *dec_f, *dec_b, *gn_g, *w_ret, *qn_g, *kn_g, *w_att, *w_out, *ffn_g, *w_pq, *subk, *pu, *pv;
    float* out;
    bf16 *WinT, *WretT, *WattT, *WoutT, *WqT, *XN, *PROJ, *Ubf, *Vbf, *ATT;
    int* EIDX; float* GATE; f32x2* RTAB; f32x2* ATAB;
};

__device__ __forceinline__ void p0_transpose_item(const float* W, int K, int N, bf16* WT, LAS float* scr, int item, int lane) {
    const int nblk = N / 32, kb = item / nblk, nb = item % nblk, k0 = 64 * kb, n0 = 32 * nb;
#pragma unroll 8
    for (int i = 0; i < 32; ++i) { const int kk = 2 * i + (lane >> 5); scr[kk * 33 + (lane & 31)] = W[(size_t)(k0 + kk) * N + n0 + (lane & 31)]; }
    LDS_WAIT(); asm volatile("" ::: "memory");
    const int c = lane & 7;
#pragma unroll
    for (int j = 0; j < 4; ++j) { const int n = (lane >> 3) + 8 * j; const LAS float* s = scr + (8 * c) * 33 + n;
        v4u o; o.x = pk2(s[0 * 33], s[1 * 33]); o.y = pk2(s[2 * 33], s[3 * 33]); o.z = pk2(s[4 * 33], s[5 * 33]); o.w = pk2(s[6 * 33], s[7 * 33]);
        *(v4u*)(WT + (size_t)(n0 + n) * K + k0 + 8 * c) = o; }
    LDS_WAIT(); asm volatile("" ::: "memory");
}
__device__ __forceinline__ void rms_row_to_bf16(const float* xrow, const float* g, bf16* orow, int lane) {
    const f32x4* xr = (const f32x4*)xrow + lane; const f32x4* gr = (const f32x4*)g + lane;
    f32x4 v[8]; float s = 0.f;
#pragma unroll
    for (int j = 0; j < 8; ++j) { v[j] = xr[64 * j]; s += (v[j].x * v[j].x + v[j].y * v[j].y) + (v[j].z * v[j].z + v[j].w * v[j].w); }
    const float rstd = 1.0f / sqrtf(wave_sum(s) * (1.f / DM) + EPS);
    unsigned long long* o8 = (unsigned long long*)orow + lane;
#pragma unroll
    for (int j = 0; j < 8; ++j) { const f32x4 gg = gr[64 * j];
        o8[64 * j] = (unsigned long long)pk2(v[j].x * rstd * gg.x, v[j].y * rstd * gg.y) | ((unsigned long long)pk2(v[j].z * rstd * gg.z, v[j].w * rstd * gg.w) << 32); }
}
__device__ __forceinline__ void p0_prologue(Frame& F) {
    LAS float* scr = (LAS float*)(F.lds + RING_OFF + F.wave * 16384);
    const int gw = F.vcu * NWAVES + F.wave, NGW = F.G * NWAVES;
    constexpr int I_IN = (DM / 64) * (INW / 32), I_SQ = (DM / 64) * (DM / 32), I_AT = (1024 / 64) * (DM / 32);
    constexpr int NITEMS = I_IN + 3 * I_SQ + I_AT;
    for (int it = gw; it < NITEMS; it += NGW) {
        int r = it;
        if (r < I_IN) { p0_transpose_item(F.w_in, DM, INW, F.WinT, scr, r, F.lane); continue; } r -= I_IN;
        if (r < I_SQ) { p0_transpose_item(F.w_ret, DM, DM, F.WretT, scr, r, F.lane); continue; } r -= I_SQ;
        if (r < I_SQ) { p0_transpose_item(F.w_out, DM, DM, F.WoutT, scr, r, F.lane); continue; } r -= I_SQ;
        if (r < I_SQ) { p0_transpose_item(F.w_pq, DM, DM, F.WqT, scr, r, F.lane); continue; } r -= I_SQ;
        p0_transpose_item(F.w_att, 1024, DM, F.WattT, scr, r, F.lane);
    }
    constexpr int NCH = NEXP * DM / 512;
    for (int c = gw; c < 2 * NCH; c += NGW) {
        const float* src = (c < NCH) ? F.pu : F.pv; bf16* dst = (c < NCH) ? F.Ubf : F.Vbf; const size_t o = (size_t)(c < NCH ? c : c - NCH) * 512 + F.lane * 8;
        const f32x4 a = *(const f32x4*)(src + o), b = *(const f32x4*)(src + o + 4);
        v4u w; w.x = pk2(a.x, a.y); w.y = pk2(a.z, a.w); w.z = pk2(b.x, b.y); w.w = pk2(b.z, b.w);
        *(v4u*)(dst + o) = w;
    }
    for (int m = gw; m < NTOK; m += NGW) rms_row_to_bf16(F.x + (size_t)m * DM, F.mix_g, F.XN + (size_t)m * DM, F.lane);
    for (int idx = gw * 64 + F.lane; idx < SEQ * 64; idx += NGW * 64) { const int pos = idx >> 6, i = idx & 63;
        const float freq = powf(10000.0f, -(float)i / 64.0f), ang = (float)pos * freq; f32x2 cs; cs.x = cosf(ang); cs.y = sinf(ang); F.RTAB[idx] = cs; }
    for (int idx = gw * 64 + F.lane; idx < SEQ * 16; idx += NGW * 64) { const int pos = idx >> 4, i = idx & 15;
        const float freq = powf(500000.0f, -(float)i / 16.0f), ang = (float)pos * freq; f32x2 cs; cs.x = cosf(ang); cs.y = sinf(ang); F.ATAB[idx] = cs; }
}

__device__ __forceinline__ void p2_prep(Frame& F) {
    bf16* RQ = F.PROJ + PO_RQ; bf16* RK = F.PROJ + PO_RK; bf16* AQ = F.PROJ + PO_AQ; bf16* AK = F.PROJ + PO_AK;
    for (int m = F.vcu; m < NTOK; m += F.G) {
        const int pos = m & (SEQ - 1), h = F.tid >> 6, d = F.tid & 63; const f32x2 cs = F.RTAB[pos * 64 + d];
        { bf16* p = RQ + (size_t)m * 1024 + h * 128 + d; const float x1 = bf2f(p[0]), x2 = bf2f(p[64]); p[0] = (bf16)f2bf(x1 * cs.x - x2 * cs.y); p[64] = (bf16)f2bf(x2 * cs.x + x1 * cs.y); }
        { bf16* p = RK + (size_t)m * 1024 + h * 128 + d; const float x1 = bf2f(p[0]), x2 = bf2f(p[64]); const float sc = 0.08838834764831845f;
          p[0] = (bf16)f2bf((x1 * cs.x - x2 * cs.y) * sc); p[64] = (bf16)f2bf((x2 * cs.x + x1 * cs.y) * sc); }
    }
    const int gw = F.vcu * NWAVES + F.wave, NGW = F.G * NWAVES, l = F.lane;
    for (int it = gw; it < NTOK * 24; it += NGW) {
        const int m = it / 24, head = it % 24, pos = m & (SEQ - 1);
#pragma unroll
        for (int tsr = 0; tsr < 2; ++tsr) {
            bf16* p = (tsr ? AK : AQ) + (size_t)m * 3072 + head * 128; const float* g = tsr ? F.kn_g : F.qn_g;
            const float x0 = bf2f(p[l]), x1 = bf2f(p[l + 64]);
            const float rstd = 1.0f / sqrtf(wave_sum(x0 * x0 + x1 * x1) * (1.f / 128.f) + EPS);
            float y0 = x0 * rstd * g[l]; const float y1 = x1 * rstd * g[l + 64];
            const float oth = __shfl_xor(y0, 16);
            if (l < 32) { const f32x2 cs = F.ATAB[pos * 16 + (l & 15)]; y0 = (l < 16) ? (y0 * cs.x - oth * cs.y) : (y0 * cs.x + oth * cs.y); }
            p[l] = (bf16)f2bf(y0); p[l + 64] = (bf16)f2bf(y1);
        }
    }
}

__device__ __forceinline__ void p3_ret_naive(Frame& F, bf16* RETO) {
    LAS float* qs = (LAS float*)(F.lds + RING_OFF);
    LAS float* ks = qs + 32 * 128;
    LAS float* vs = ks + 32 * 132;
    LAS float* pst = vs + 32 * 256;
    const bf16* RQ = F.PROJ + PO_RQ; const bf16* RK = F.PROJ + PO_RK; const bf16* RV = F.PROJ + PO_RV; const bf16* RG = F.PROJ + PO_RG;
    const int t = F.tid;
    for (int item = F.vcu; item < 16 * 128; item += F.G) {
        const int bh = item >> 7, qt = item & 127, b = bh >> 3, h = bh & 7, n0 = qt * 32;
        const float lgf = -expf(F.dec_f[h]), lgb = -expf(F.dec_b[h]);
        __syncthreads();
        { const int row = t >> 4, c8 = (t & 15) * 8; const v4u w = *(const v4u*)(RQ + (size_t)(b * SEQ + n0 + row) * 1024 + h * 128 + c8);
          LAS float* d = qs + row * 128 + c8; d[0] = bflo(w.x); d[1] = bfhi(w.x); d[2] = bflo(w.y); d[3] = bfhi(w.y); d[4] = bflo(w.z); d[5] = bfhi(w.z); d[6] = bflo(w.w); d[7] = bfhi(w.w); }
        float acc[16];
#pragma unroll
        for (int k = 0; k < 16; ++k) acc[k] = 0.f;
        const int e = t & 255, ih = t >> 8;
        for (int m0 = 0; m0 < SEQ; m0 += 32) {
            __syncthreads();
            { const int row = t >> 4, c8 = (t & 15) * 8; const v4u w = *(const v4u*)(RK + (size_t)(b * SEQ + m0 + row) * 1024 + h * 128 + c8);
              LAS float* d = ks + row * 132 + c8; d[0] = bflo(w.x); d[1] = bfhi(w.x); d[2] = bflo(w.y); d[3] = bfhi(w.y); d[4] = bflo(w.z); d[5] = bfhi(w.z); d[6] = bflo(w.w); d[7] = bfhi(w.w);
              const int c16 = (t & 15) * 16; const bf16* vp = RV + (size_t)(b * SEQ + m0 + row) * 2048 + h * 256 + c16; const v4u w0 = *(const v4u*)vp, w1 = *(const v4u*)(vp + 8);
              LAS float* dv = vs + row * 256 + c16; dv[0] = bflo(w0.x); dv[1] = bfhi(w0.x); dv[2] = bflo(w0.y); dv[3] = bfhi(w0.y); dv[4] = bflo(w0.z); dv[5] = bfhi(w0.z); dv[6] = bflo(w0.w); dv[7] = bfhi(w0.w);
              dv[8] = bflo(w1.x); dv[9] = bfhi(w1.x); dv[10] = bflo(w1.y); dv[11] = bfhi(w1.y); dv[12] = bflo(w1.z); dv[13] = bfhi(w1.z); dv[14] = bflo(w1.w); dv[15] = bfhi(w1.w); }
            __syncthreads();
            { const int i = t >> 4, j0 = (t & 15) * 2; float s0 = 0.f, s1 = 0.f;
              const LAS f32x4* qp = (const LAS f32x4*)(qs + i * 128); const LAS f32x4* k0 = (const LAS f32x4*)(ks + j0 * 132); const LAS f32x4* k1 = (const LAS f32x4*)(ks + (j0 + 1) * 132);
#pragma unroll 8
              for (int d = 0; d < 32; ++d) { const f32x4 qv = qp[d], a = k0[d], c = k1[d]; s0 += (qv.x * a.x + qv.y * a.y) + (qv.z * a.z + qv.w * a.w); s1 += (qv.x * c.x + qv.y * c.y) + (qv.z * c.z + qv.w * c.w); }
              const int n = n0 + i; const int d0 = n - (m0 + j0), d1 = d0 - 1;
              const float w0 = d0 >= 0 ? expf(lgf * (float)d0) : expf(lgb * (float)(-d0)); const float w1 = d1 >= 0 ? expf(lgf * (float)d1) : expf(lgb * (float)(-d1));
              pst[j0 * 32 + i] = s0 * w0; pst[(j0 + 1) * 32 + i] = s1 * w1; }
            __syncthreads();
#pragma unroll 4
            for (int j = 0; j < 32; ++j) { const float vv = vs[j * 256 + e]; const LAS f32x4* pp = (const LAS f32x4*)(pst + j * 32 + ih * 16);
#pragma unroll
                for (int q4 = 0; q4 < 4; ++q4) { const f32x4 p = pp[q4]; acc[q4 * 4 + 0] += p.x * vv; acc[q4 * 4 + 1] += p.y * vv; acc[q4 * 4 + 2] += p.z * vv; acc[q4 * 4 + 3] += p.w * vv; } }
        }
        __syncthreads();
#pragma unroll
        for (int k = 0; k < 16; ++k) vs[(ih * 16 + k) * 256 + e] = acc[k];
        __syncthreads();
#pragma unroll
        for (int r = 0; r < 4; ++r) { const int i = F.wave * 4 + r; float v[4]; float s = 0.f;
#pragma unroll
            for (int q4 = 0; q4 < 4; ++q4) { v[q4] = vs[i * 256 + F.lane + 64 * q4]; s += v[q4]; }
            const float mu = wave_sum(s) * (1.f / 256.f); float s2 = 0.f;
#pragma unroll
            for (int q4 = 0; q4 < 4; ++q4) { v[q4] -= mu; s2 += v[q4] * v[q4]; }
            const float rstd = 1.0f / sqrtf(wave_sum(s2) * (1.f / 256.f) + EPS);
            const size_t mrow = (size_t)(b * SEQ + n0 + i) * 2048 + h * 256;
#pragma unroll
            for (int q4 = 0; q4 < 4; ++q4) { const int ee = F.lane + 64 * q4; RETO[mrow + ee] = (bf16)f2bf(v[q4] * rstd * F.gn_g[h * 256 + ee] * bf2f(RG[mrow + ee])); } }
    }
}

__device__ __forceinline__ void p3_att_naive(Frame& F) {
    const bf16* AQ = F.PROJ + PO_AQ; const bf16* AK = F.PROJ + PO_AK; const bf16* AV = F.PROJ + PO_AV;
    const int l = F.lane, hh = F.wave;
    for (int m = F.vcu; m < NTOK; m += F.G) {
        const int b = m >> 12, n = m & (SEQ - 1);
        float mrun = -1e30f, lrun = 0.f, a0 = 0.f, a1 = 0.f;
#pragma unroll 1
        for (int g = 0; g < 3; ++g) {
            const int dil = (g == 0) ? 1 : (g == 1 ? 4 : 16), head = g * 8 + hh;
            const unsigned qw = *(const unsigned*)(AQ + (size_t)m * 3072 + head * 128 + 2 * l); const float q0 = bflo(qw), q1 = bfhi(qw);
#pragma unroll 1
            for (int t0 = -64; t0 <= 64; t0 += 8) {
                unsigned kw[8], vw[8]; bool ok[8];
#pragma unroll
                for (int c = 0; c < 8; ++c) { const int tt = t0 + c, pos = n + dil * tt; ok[c] = (tt <= 64) && pos >= 0 && pos < SEQ; const int pc = ok[c] ? pos : n;
                    const size_t o = (size_t)(b * SEQ + pc) * 3072 + head * 128 + 2 * l; kw[c] = *(const unsigned*)(AK + o); vw[c] = *(const unsigned*)(AV + o); }
#pragma unroll
                for (int c = 0; c < 8; ++c) { const float s = wave_sum(q0 * bflo(kw[c]) + q1 * bfhi(kw[c])) * 0.08838834764831845f;
                    if (ok[c]) { const float mn = fmaxf(mrun, s), f = __expf(mrun - mn), p = __expf(s - mn); lrun = lrun * f + p; a0 = a0 * f + p * bflo(vw[c]); a1 = a1 * f + p * bfhi(vw[c]); mrun = mn; } }
            }
        }
        const float inv = 1.0f / lrun;
        *(unsigned*)(F.ATT + (size_t)m * 1024 + hh * 128 + 2 * l) = pk2(a0 * inv, a1 * inv);
    }
}

__device__ __forceinline__ void p7_norm(Frame& F, bf16* H2) {
    const int gw = F.vcu * NWAVES + F.wave, NGW = F.G * NWAVES;
    for (int m = gw; m < NTOK; m += NGW) rms_row_to_bf16(F.out + (size_t)m * DM, F.ffn_g, H2 + (size_t)m * DM, F.lane);
}

__device__ __forceinline__ void wave_argmax(float& v, int& i) {
#pragma unroll
    for (int o = 1; o < 64; o <<= 1) { const float ov = __shfl_xor(v, o); const int oi = __shfl_xor(i, o); if (ov > v || (ov == v && oi < i)) { v = ov; i = oi; } }
}
__device__ __forceinline__ void p9_topk(Frame& F, const float* PQ) {
    const int gw = F.vcu * NWAVES + F.wave, NGW = F.G * NWAVES, l = F.lane;
    LAS float* qs = (LAS float*)(F.lds + RING_OFF) + F.wave * 256;
    for (int it = gw; it < NTOK * 8; it += NGW) {
        const int tk = it >> 3, h = it & 7;
        { const f32x4 qv = *(const f32x4*)(PQ + (size_t)tk * DM + h * 256 + 4 * l); *(LAS f32x4*)(qs + 4 * l) = qv; }
        LDS_WAIT(); asm volatile("" ::: "memory");
        float sc[2][2];
#pragma unroll
        for (int hf = 0; hf < 2; ++hf)
#pragma unroll
            for (int kk = 0; kk < 2; ++kk) { const f32x4* kp = (const f32x4*)(F.subk + ((size_t)(h * 2 + hf) * 128 + l + 64 * kk) * 128); const LAS f32x4* qp = (const LAS f32x4*)(qs + hf * 128);
                float s = 0.f;
#pragma unroll 8
                for (int d = 0; d < 32; ++d) { const f32x4 a = kp[d], q = qp[d]; s += (a.x * q.x + a.y * q.y) + (a.z * q.z + a.w * q.w); }
                sc[hf][kk] = s; }
        float tv[2] = {0.f, 0.f}; int ti[2] = {0, 0};
#pragma unroll
        for (int hf = 0; hf < 2; ++hf) {
            float c0 = sc[hf][0], c1 = sc[hf][1];
#pragma unroll 1
            for (int r = 0; r < 16; ++r) { float bv; int bi; if (c0 >= c1) { bv = c0; bi = l; } else { bv = c1; bi = l + 64; }
                wave_argmax(bv, bi); if (l == r) { tv[hf] = bv; ti[hf] = bi; } if (bi == l) c0 = -INFINITY; if (bi == l + 64) c1 = -INFINITY; }
        }
        float cv[4];
        { const float va = __shfl(tv[0], l >> 2);
#pragma unroll
          for (int c = 0; c < 4; ++c) cv[c] = va + __shfl(tv[1], (l & 3) * 4 + c); }
        float best = 0.f; int bpos = 0;
#pragma unroll 1
        for (int r = 0; r < 16; ++r) { float bv = cv[0]; int bi = 4 * l;
#pragma unroll
            for (int c = 1; c < 4; ++c) if (cv[c] > bv) { bv = cv[c]; bi = 4 * l + c; }
            wave_argmax(bv, bi); if (l == r) { best = bv; bpos = bi; }
#pragma unroll
            for (int c = 0; c < 4; ++c) if (bi == 4 * l + c) cv[c] = -INFINITY; }
        const int e1 = __shfl(ti[0], bpos >> 4), e2 = __shfl(ti[1], bpos & 15);
        const float mx = __shfl(best, 0); float p = (l < 16) ? __expf(best - mx) : 0.f; const float den = wave_sum(p);
        if (l < 16) { F.EIDX[(size_t)tk * 128 + h * 16 + l] = e1 * 128 + e2; F.GATE[(size_t)tk * 128 + h * 16 + l] = p / den; }
        LDS_WAIT(); asm volatile("" ::: "memory");
    }
}

__device__ __forceinline__ void p10_peer_naive(Frame& F, const bf16* H2) {
    const int gw = F.vcu * NWAVES + F.wave, NGW = F.G * NWAVES, l = F.lane;
    for (int tk = gw; tk < NTOK; tk += NGW) {
        float hv[32];
#pragma unroll
        for (int j = 0; j < 4; ++j) { const v4u w = *(const v4u*)(H2 + (size_t)tk * DM + 512 * j + 8 * l);
            hv[8 * j + 0] = bflo(w.x); hv[8 * j + 1] = bfhi(w.x); hv[8 * j + 2] = bflo(w.y); hv[8 * j + 3] = bfhi(w.y); hv[8 * j + 4] = bflo(w.z); hv[8 * j + 5] = bfhi(w.z); hv[8 * j + 6] = bflo(w.w); hv[8 * j + 7] = bfhi(w.w); }
        const int e_lo = F.EIDX[(size_t)tk * 128 + l], e_hi = F.EIDX[(size_t)tk * 128 + 64 + l];
        const float g_lo = F.GATE[(size_t)tk * 128 + l], g_hi = F.GATE[(size_t)tk * 128 + 64 + l];
        float act_lo = 0.f, act_hi = 0.f;
#pragma unroll 2
        for (int k = 0; k < 128; ++k) { const int e = __shfl((k < 64) ? e_lo : e_hi, k & 63); const bf16* up = F.Ubf + (size_t)e * DM + 8 * l; float s = 0.f;
#pragma unroll
            for (int j = 0; j < 4; ++j) { const v4u w = *(const v4u*)(up + 512 * j);
                s += hv[8 * j + 0] * bflo(w.x) + hv[8 * j + 1] * bfhi(w.x) + hv[8 * j + 2] * bflo(w.y) + hv[8 * j + 3] * bfhi(w.y) + hv[8 * j + 4] * bflo(w.z) + hv[8 * j + 5] * bfhi(w.z) + hv[8 * j + 6] * bflo(w.w) + hv[8 * j + 7] * bfhi(w.w); }
            const float a = wave_sum(s); const float ge = 0.5f * a * (1.0f + erff(a * 0.70710678118654752f));
            if (k < 64) { if (l == k) act_lo = ge * g_lo; } else { if (l == k - 64) act_hi = ge * g_hi; } }
        float acc[32];
#pragma unroll
        for (int j = 0; j < 32; ++j) acc[j] = 0.f;
#pragma unroll 2
        for (int k = 0; k < 128; ++k) { const int e = __shfl((k < 64) ? e_lo : e_hi, k & 63); const float a = __shfl((k < 64) ? act_lo : act_hi, k & 63); const bf16* vp = F.Vbf + (size_t)e * DM + 8 * l;
#pragma unroll
            for (int j = 0; j < 4; ++j) { const v4u w = *(const v4u*)(vp + 512 * j);
                acc[8 * j + 0] += a * bflo(w.x); acc[8 * j + 1] += a * bfhi(w.x); acc[8 * j + 2] += a * bflo(w.y); acc[8 * j + 3] += a * bfhi(w.y); acc[8 * j + 4] += a * bflo(w.z); acc[8 * j + 5] += a * bfhi(w.z); acc[8 * j + 6] += a * bflo(w.w); acc[8 * j + 7] += a * bfhi(w.w); } }
        float* op = F.out + (size_t)tk * DM + 8 * l;
#pragma unroll
        for (int j = 0; j < 4; ++j) { f32x4 o0 = *(f32x4*)(op + 512 * j), o1 = *(f32x4*)(op + 512 * j + 4);
            o0.x += acc[8 * j + 0]; o0.y += acc[8 * j + 1]; o0.z += acc[8 * j + 2]; o0.w += acc[8 * j + 3]; o1.x += acc[8 * j + 4]; o1.y += acc[8 * j + 5]; o1.z += acc[8 * j + 6]; o1.w += acc[8 * j + 7];
            *(f32x4*)(op + 512 * j) = o0; *(f32x4*)(op + 512 * j + 4) = o1; }
    }
}

struct Args { const float* in[16]; float* out; unsigned char* ws; int ph_lo, ph_hi, li, pad; };
__global__ void __launch_bounds__(NWAVES * 64, 2) layer_fwd(Args args) {
    extern __shared__ __attribute__((aligned(16))) unsigned char lds[];
    Frame F;
    F.lds = (LAS unsigned char*)lds;
    F.MISC = (volatile LAS unsigned*)(F.lds + MISC_OFF);
    F.tid = threadIdx.x; F.lane = F.tid & 63; F.wave = __builtin_amdgcn_readfirstlane(F.tid >> 6);
    F.G = gridDim.x; { const int bx = blockIdx.x; F.vcu = (F.G % 8 == 0) ? (bx % 8) * (F.G / 8) + bx / 8 : bx; }
    unsigned char* ws = args.ws;
    F.ctl = (gu32*)(ws + WS_CTL);
    F.x = args.in[0]; F.mix_g = args.in[1]; F.w_in = args.in[2]; F.dec_f = args.in[3]; F.dec_b = args.in[4]; F.gn_g = args.in[5]; F.w_ret = args.in[6]; F.qn_g = args.in[7];
    F.kn_g = args.in[8]; F.w_att = args.in[9]; F.w_out = args.in[10]; F.ffn_g = args.in[11]; F.w_pq = args.in[12]; F.subk = args.in[13]; F.pu = args.in[14]; F.pv = args.in[15];
    F.out = args.out;
    F.WinT = (bf16*)(ws + WS_WINT); F.WretT = (bf16*)(ws + WS_WRET); F.WattT = (bf16*)(ws + WS_WATT); F.WoutT = (bf16*)(ws + WS_WOUT); F.WqT = (bf16*)(ws + WS_WQ);
    F.XN = (bf16*)(ws + WS_XN); F.PROJ = (bf16*)(ws + WS_PROJ); F.Ubf = (bf16*)(ws + WS_UBF); F.Vbf = (bf16*)(ws + WS_VBF); F.ATT = (bf16*)(ws + WS_ATT);
    F.EIDX = (int*)(ws + WS_EIDX); F.GATE = (float*)(ws + WS_GATE); F.RTAB = (f32x2*)(ws + WS_RTAB); F.ATAB = (f32x2*)(ws + WS_ATAB);
    bf16* RETO = F.XN;
    bf16* MERGED = F.PROJ + PO_RQ;
    bf16* H2 = F.PROJ + PO_RV;
    float* TMP = (float*)(F.PROJ + PO_AK);
    float* PQ = TMP;
    for (int u = F.tid; u < (LDS_BYTES - LDSCTL_OFF) / 4; u += NWAVES * 64) ((LAS unsigned*)(F.lds + LDSCTL_OFF))[u] = 0u;
    __syncthreads();
    XcdBarrier bar; bar.bar = (unsigned*)(F.ctl + CW_BAR); bar.x = 0; bar.st = nullptr;
    if (N_LAUNCHES == 1) bar = xcd_barrier_post((unsigned*)(F.ctl + CW_BAR), F.MISC + 8);
#define GRID_BAR() do { if (N_LAUNCHES == 1) xcd_barrier(bar); } while (0)
    const int lo = args.ph_lo, hi = args.ph_hi;
#define IN(k) (lo <= (k) && (k) < hi)
#define BOTH(k) (IN(k) && IN((k) + 1))
    if (IN(0)) { p0_prologue(F); VM_WAIT(); __syncthreads(); if (BOTH(0)) GRID_BAR(); }
    if (IN(1)) { pg8::Gemm g{F.XN, F.WinT, NTOK, INW, DM}; pg8::StaticOrder S; S.init(NTOK, INW, F.G, (int)blockIdx.x);
        pg8::EpiProj E{F.PROJ};
        pg8::gemm_phase<pg8::EpiProj, pg8::StaticOrder, PG8_ALIGN, PG8_SP2>(F.lds + RING_OFF, g, S, E);
        if (BOTH(1)) GRID_BAR(); }
    if (IN(2)) { p2_prep(F); if (BOTH(2)) GRID_BAR(); }
    if (IN(3)) { p3_ret_naive(F, RETO); p3_att_naive(F); if (BOTH(3)) GRID_BAR(); }
    if (IN(4)) { pg8::Gemm g{RETO, F.WretT, NTOK, DM, DM}; pg8::StaticOrder S; S.init(NTOK, DM, F.G, (int)blockIdx.x);
        pg8::EpiGateF32 E{TMP, F.PROJ + PO_GR, DM};
        pg8::gemm_phase<pg8::EpiGateF32, pg8::StaticOrder, PG8_ALIGN, PG8_SP2>(F.lds + RING_OFF, g, S, E);
        if (BOTH(4)) GRID_BAR(); }
    if (IN(5)) { pg8::Gemm g{F.ATT, F.WattT, NTOK, DM, 1024}; pg8::StaticOrder S; S.init(NTOK, DM, F.G, (int)blockIdx.x);
        pg8::EpiGateAddBf16 E{MERGED, TMP, F.PROJ + PO_GA, DM};
        pg8::gemm_phase<pg8::EpiGateAddBf16, pg8::StaticOrder, PG8_ALIGN, PG8_SP2>(F.lds + RING_OFF, g, S, E);
        if (BOTH(5)) GRID_BAR(); }
    if (IN(6)) { pg8::Gemm g{MERGED, F.WoutT, NTOK, DM, DM}; pg8::StaticOrder S; S.init(NTOK, DM, F.G, (int)blockIdx.x);
        pg8::EpiResF32 E{F.out, F.x, DM};
        pg8::gemm_phase<pg8::EpiResF32, pg8::StaticOrder, PG8_ALIGN, PG8_SP2>(F.lds + RING_OFF, g, S, E);
        if (BOTH(6)) GRID_BAR(); }
    if (IN(7)) { p7_norm(F, H2); if (BOTH(7)) GRID_BAR(); }
    if (IN(8)) { pg8::Gemm g{H2, F.WqT, NTOK, DM, DM}; pg8::StaticOrder S; S.init(NTOK, DM, F.G, (int)blockIdx.x);
        pg8::EpiResF32 E{PQ, nullptr, DM};
        pg8::gemm_phase<pg8::EpiResF32, pg8::StaticOrder, PG8_ALIGN, PG8_SP2>(F.lds + RING_OFF, g, S, E);
        if (BOTH(8)) GRID_BAR(); }
    if (IN(9)) { p9_topk(F, PQ); if (BOTH(9)) GRID_BAR(); }
    if (IN(10)) { p10_peer_naive(F, H2); }
#undef IN
#undef BOTH
}

extern "C" void kernel_launch(void* const* d_in, const int* in_sizes, int n_in, void* d_out, int out_size, void* d_ws, size_t ws_size, hipStream_t stream) {
    static int grid = 0;
    if (grid == 0) {
        if (n_in != 16 || in_sizes[0] != NTOK * DM || out_size != NTOK * DM || ws_size < WS_END) { fprintf(stderr, "kernel_launch: unexpected shapes / workspace (%d inputs, ws %zu)\n", n_in, ws_size); grid = -1; return; }
        int dev = 0, cus = 0, per_cu = 0;
        if (hipGetDevice(&dev) != hipSuccess || hipDeviceGetAttribute(&cus, hipDeviceAttributeMultiprocessorCount, dev) != hipSuccess) { grid = -1; return; }
        if (hipFuncSetAttribute((const void*)layer_fwd, hipFuncAttributeMaxDynamicSharedMemorySize, LDS_BYTES) != hipSuccess) { grid = -1; return; }
        if (hipOccupancyMaxActiveBlocksPerMultiprocessor(&per_cu, (const void*)layer_fwd, NWAVES * 64, LDS_BYTES) != hipSuccess || per_cu < 1) { fprintf(stderr, "kernel_launch: occupancy query says %d\n", per_cu); grid = -1; (void)hipGetLastError(); return; }
        (void)hipGetLastError();
        grid = cus;
    }
    if (grid < 0) return;
    if (hipMemsetAsync((char*)d_ws + WS_CTL, 0, CTL_ZERO_BYTES, stream) != hipSuccess) return;
    Args a{};
    for (int i = 0; i < 16; ++i) a.in[i] = (const float*)d_in[i];
    a.out = (float*)d_out; a.ws = (unsigned char*)d_ws;
    for (int li = 0; li < N_LAUNCHES; ++li) {
        a.ph_lo = (N_LAUNCHES == 1) ? 0 : li; a.ph_hi = (N_LAUNCHES == 1) ? N_PHASES : li + 1; a.li = li;
        hipLaunchKernelGGL(layer_fwd, dim3(grid), dim3(NWAVES * 64), LDS_BYTES, stream, a);
    }
}
```

```cpp
#include <hip/hip_runtime.h>
#include <cstdio>
#include <cstdint>
namespace pg8 {
#define PG8_LAS __attribute__((address_space(3)))
typedef unsigned short bf16_t;
typedef short bf16x8 __attribute__((ext_vector_type(8)));
typedef float f32x4 __attribute__((ext_vector_type(4)));
typedef unsigned u32x4 __attribute__((ext_vector_type(4)));
constexpr int BM = 256, BK = 64, HALF = 128, HTB = HALF * BK * 2  , STAGE_BYTES = 8 * HTB, NXCD = 8, WGM = 8;

__host__ __device__ __forceinline__ int lds_byte(int r, int c) { const int st = (r >> 4) * 2 + (c >> 5), rr = r & 15, cc = c & 31, ob = rr * 64 + cc * 2; return st * 1024 + (ob ^ (((ob >> 9) & 1) << 5)); }
__host__ __device__ __forceinline__ void stage_rc(int b, int& R, int& C) { const int st = b / 1024, sb = b % 1024, swz = sb ^ (((sb >> 9) & 1) << 5); R = (st >> 1) * 16 + swz / 64; C = (st & 1) * 32 + (swz % 64) / 2; }
__host__ __device__ __forceinline__ int perm32(int rho) { const int n = rho >> 4, i = rho & 15; return 8 * (i >> 2) + 4 * n + (i & 3); }

struct Unit { int pm, pn; };
struct Gemm { const bf16_t* A; const bf16_t* Bt; int M, N, K; };

struct StaticOrder {
    int nM, nN, nwg, G, c;
    __host__ __device__ void init(int M, int N, int G_, int c_) { nM = M / BM; nN = N / BM; nwg = nM * nN; G = G_; c = c_; }
    __host__ __device__ bool next(int i, Unit& u) const {
        const long L = (long)i * G + c; if (L >= nwg) return false;
        int wgid = (int)L; { const int q = nwg / NXCD, r = nwg % NXCD, xcd = wgid % NXCD, off = wgid / NXCD; wgid = (xcd < r ? xcd * (q + 1) : r * (q + 1) + (xcd - r) * q) + off; }
        const int nig = WGM * nN, gid = wgid / nig, fm = gid * WGM, gsz = (nM - fm) < WGM ? (nM - fm) : WGM;
        u.pm = fm + ((wgid % nig) % gsz); u.pn = (wgid % nig) / gsz; return true;
    }
    __device__ __forceinline__ void a_ready(const Unit&) const {}
    __device__ __forceinline__ void done(const Unit&) const {}
};

__device__ __forceinline__ unsigned cvt_pk_bf16(float lo, float hi) { unsigned r; asm volatile("v_cvt_pk_bf16_f32 %0, %1, %2" : "=v"(r) : "v"(lo), "v"(hi)); return r; }
template <class Epi, class Sched, bool ALIGN_EPI = false, bool SP2 = false, bool TILED = false>
__device__ __forceinline__ void gemm_phase(PG8_LAS unsigned char* lds, const Gemm g, const Sched& S, const Epi& E) {
    const int tid = threadIdx.x, wid = __builtin_amdgcn_readfirstlane(tid >> 6), lane = tid & 63, wr = wid >> 2, wc = wid & 3, fr = lane & 15, fq = lane >> 4;
    const int K = g.K, nt = K / BK;
    unsigned voffA[2], voffB[2];
#pragma unroll
    for (int i = 0; i < 2; ++i) { int R, C; stage_rc(tid * 16 + i * 8192, R, C); const int Rb = Epi::PERM ? ((R & ~31) + perm32(R & 31)) : R;
        voffA[i] = TILED ? (unsigned)(R * BK + C) * 2u : (unsigned)(R * K + C) * 2u; voffB[i] = TILED ? (unsigned)(Rb * BK + C) * 2u : (unsigned)(Rb * K + C) * 2u; }
    const size_t kstep = TILED ? (size_t)(BM * BK * 2) : (size_t)(BK * 2);
    const size_t hstep = TILED ? (size_t)(HALF * BK * 2) : (size_t)HALF * K * 2;
    const size_t tstep = TILED ? (size_t)K * BM * 2 : 2 * hstep;
    const unsigned ldsw = (unsigned)wid * 1024u;
    const int aoff = lds_byte(wr * 64 + fr, fq * 8), boff = lds_byte(wc * 32 + fr, fq * 8);
#define PG8_SA(b, h) (((b) * 2 + (h)) * HTB)
#define PG8_SB(b, h) ((4 + (b) * 2 + (h)) * HTB)
#define PG8_STAGE(bufoff, gbase, voff) do { _Pragma("unroll") for (int _i = 0; _i < 2; ++_i) \
        __builtin_amdgcn_global_load_lds((const unsigned*)((const char*)(gbase) + (voff)[_i]), (PG8_LAS unsigned*)(lds + (bufoff) + ldsw + _i * 8192), 16, 0, 0); } while (0)
#define PG8_LDA(dst, b, h) do { _Pragma("unroll") for (int m = 0; m < 4; ++m) _Pragma("unroll") for (int k = 0; k < 2; ++k) dst[m][k] = *(const PG8_LAS bf16x8*)(lds + PG8_SA(b, h) + aoff + m * 2048 + k * 1024); } while (0)
#define PG8_LDB(dst, b, h) do { _Pragma("unroll") for (int n = 0; n < 2; ++n) _Pragma("unroll") for (int k = 0; k < 2; ++k) dst[n][k] = *(const PG8_LAS bf16x8*)(lds + PG8_SB(b, h) + boff + n * 2048 + k * 1024); } while (0)
#define PG8_MMA(ai, bj, At, Bt) do { __builtin_amdgcn_s_setprio(1); _Pragma("unroll") for (int m = 0; m < 4; ++m) _Pragma("unroll") for (int n = 0; n < 2; ++n) _Pragma("unroll") for (int k = 0; k < 2; ++k) \
        acc[ai][bj][m][n] = __builtin_amdgcn_mfma_f32_16x16x32_bf16(Bt[n][k], At[m][k], acc[ai][bj][m][n], 0, 0, 0); __builtin_amdgcn_s_setprio(0); } while (0)
#define PG8_WAIT_V(n) asm volatile("s_waitcnt vmcnt(" #n ")" ::: "memory")
#define PG8_WAIT_L(n) asm volatile("s_waitcnt lgkmcnt(" #n ")" ::: "memory")
#define PG8_BAR __builtin_amdgcn_s_barrier()
#define PG8_SCHED __builtin_amdgcn_sched_barrier(0)
    Unit cur, nxt; int ui = 0;
    if (!S.next(0, cur)) return;
    f32x4 acc[2][2][4][2];
#pragma unroll
    for (int a = 0; a < 2; ++a)
#pragma unroll
        for (int b = 0; b < 2; ++b)
#pragma unroll
            for (int m = 0; m < 4; ++m)
#pragma unroll
                for (int n = 0; n < 2; ++n) acc[a][b][m][n] = (f32x4){0.f, 0.f, 0.f, 0.f};
    bf16x8 At[4][2], B0[2][2], B1[2][2];
    const char* cA = (const char*)g.A + (size_t)cur.pm * tstep; const char* cB = (const char*)g.Bt + (size_t)cur.pn * tstep;
    S.a_ready(cur);
    if constexpr (SP2) {
        PG8_STAGE(PG8_SB(0, 0), cB, voffB); PG8_STAGE(PG8_SB(0, 1), cB + hstep, voffB); PG8_STAGE(PG8_SA(0, 0), cA, voffA); PG8_STAGE(PG8_SA(0, 1), cA + hstep, voffA);
        if (wr == 1) PG8_BAR;
        PG8_WAIT_V(2); PG8_BAR;
        PG8_STAGE(PG8_SB(1, 0), cB + kstep, voffB); PG8_STAGE(PG8_SA(1, 0), cA + kstep, voffA); PG8_STAGE(PG8_SB(1, 1), cB + hstep + kstep, voffB);
        PG8_WAIT_V(6); PG8_BAR;
    } else {
        PG8_STAGE(PG8_SB(0, 0), cB, voffB); PG8_STAGE(PG8_SA(0, 0), cA, voffA); PG8_STAGE(PG8_SB(0, 1), cB + hstep, voffB); PG8_STAGE(PG8_SA(0, 1), cA + hstep, voffA);
        if (wr == 1) PG8_BAR;
        PG8_WAIT_V(4); PG8_BAR;
        PG8_STAGE(PG8_SB(1, 0), cB + kstep, voffB); PG8_STAGE(PG8_SA(1, 0), cA + kstep, voffA); PG8_STAGE(PG8_SB(1, 1), cB + hstep + kstep, voffB);
        PG8_WAIT_V(6); PG8_BAR;
    }
    for (;;) {
        const bool has_next = S.next(ui + 1, nxt);
        const char* nA = has_next ? (const char*)g.A + (size_t)nxt.pm * tstep : cA; const char* nB = has_next ? (const char*)g.Bt + (size_t)nxt.pn * tstep : cB;
        for (int t = 0; t < nt; t += 2) {
            const bool last = (t == nt - 2);
            const char* a1 = cA + (size_t)(t + 1) * kstep;
            const char* a2 = last ? nA : cA + (size_t)(t + 2) * kstep; const char* b2 = last ? nB : cB + (size_t)(t + 2) * kstep;
            const char* a3 = a2 + kstep; const char* b3 = b2 + kstep;
            if (last && has_next) S.a_ready(nxt);
            if constexpr (SP2) {
            PG8_LDB(B0, 0, 0); PG8_LDB(B1, 0, 1); PG8_SCHED; PG8_LDA(At, 0, 0); PG8_STAGE(PG8_SA(1, 1), a1 + hstep, voffA);
            PG8_WAIT_V(8); PG8_WAIT_L(0); PG8_BAR; PG8_MMA(0, 0, At, B0); PG8_MMA(0, 1, At, B1); PG8_BAR; PG8_SCHED;
            PG8_LDA(At, 0, 1); PG8_STAGE(PG8_SB(0, 0), b2, voffB); PG8_STAGE(PG8_SB(0, 1), b2 + hstep, voffB); PG8_STAGE(PG8_SA(0, 0), a2, voffA);
            PG8_WAIT_V(8); PG8_WAIT_L(0); PG8_BAR; PG8_MMA(1, 0, At, B0); PG8_MMA(1, 1, At, B1); PG8_BAR; PG8_SCHED;
            PG8_LDB(B0, 1, 0); PG8_LDB(B1, 1, 1); PG8_SCHED; PG8_LDA(At, 1, 0); PG8_STAGE(PG8_SA(0, 1), a2 + hstep, voffA);
            PG8_WAIT_V(8); PG8_WAIT_L(0); PG8_BAR; PG8_MMA(0, 0, At, B0); PG8_MMA(0, 1, At, B1); PG8_BAR; PG8_SCHED;
            PG8_LDA(At, 1, 1); PG8_STAGE(PG8_SB(1, 0), b3, voffB); PG8_STAGE(PG8_SB(1, 1), b3 + hstep, voffB); PG8_STAGE(PG8_SA(1, 0), a3, voffA);
            PG8_WAIT_V(8); PG8_WAIT_L(0); PG8_BAR; PG8_MMA(1, 0, At, B0); PG8_MMA(1, 1, At, B1); PG8_BAR; PG8_SCHED;
            } else {
            PG8_LDB(B0, 0, 0); PG8_SCHED; PG8_LDA(At, 0, 0); PG8_STAGE(PG8_SA(1, 1), a1 + hstep, voffA);
            PG8_WAIT_L(8); PG8_BAR; PG8_WAIT_L(0); PG8_MMA(0, 0, At, B0); PG8_BAR; PG8_SCHED;
            PG8_LDB(B1, 0, 1); PG8_STAGE(PG8_SB(0, 0), b2, voffB);
            PG8_BAR; PG8_WAIT_L(0); PG8_MMA(0, 1, At, B1); PG8_BAR;
            PG8_LDA(At, 0, 1); PG8_STAGE(PG8_SA(0, 0), a2, voffA);
            PG8_BAR; PG8_WAIT_L(0); PG8_MMA(1, 0, At, B0); PG8_BAR; PG8_SCHED;
            PG8_STAGE(PG8_SB(0, 1), b2 + hstep, voffB);
            PG8_WAIT_V(6); PG8_BAR; PG8_MMA(1, 1, At, B1); PG8_BAR;
            PG8_LDB(B0, 1, 0); PG8_SCHED; PG8_LDA(At, 1, 0); PG8_STAGE(PG8_SA(0, 1), a2 + hstep, voffA);
            PG8_WAIT_L(8); PG8_BAR; PG8_WAIT_L(0); PG8_MMA(0, 0, At, B0); PG8_BAR; PG8_SCHED;
            PG8_LDB(B1, 1, 1); PG8_STAGE(PG8_SB(1, 0), b3, voffB);
            PG8_BAR; PG8_WAIT_L(0); PG8_MMA(0, 1, At, B1); PG8_BAR;
            PG8_LDA(At, 1, 1); PG8_STAGE(PG8_SA(1, 0), a3, voffA);
            PG8_BAR; PG8_WAIT_L(0); PG8_MMA(1, 0, At, B0); PG8_BAR; PG8_SCHED;
            PG8_STAGE(PG8_SB(1, 1), b3 + hstep, voffB);
            PG8_WAIT_V(6); PG8_BAR; PG8_MMA(1, 1, At, B1); PG8_BAR;
            }
        }
        if constexpr (ALIGN_EPI) { if (wr == 0) PG8_BAR; }
        if constexpr (!Epi::AFTER_DRAIN) { E(acc, cur, wr, wc, fr, fq); S.done(cur); }
        if (!has_next) break;
#pragma unroll
        for (int a = 0; a < 2; ++a)
#pragma unroll
            for (int b = 0; b < 2; ++b)
#pragma unroll
                for (int m = 0; m < 4; ++m)
#pragma unroll
                    for (int n = 0; n < 2; ++n) acc[a][b][m][n] = (f32x4){0.f, 0.f, 0.f, 0.f};
        cur = nxt; cA = nA; cB = nB; ++ui;
        if constexpr (ALIGN_EPI) { if (wr == 1) PG8_BAR; }
    }
    PG8_WAIT_V(0);
    if constexpr (!ALIGN_EPI) { if (wr == 0) PG8_BAR; }
    PG8_BAR;
    if constexpr (Epi::AFTER_DRAIN) { E.fused(acc, cur, wr, wc, fr, fq, lds, wid, lane); S.done(cur); }
#undef PG8_SA
#undef PG8_SB
#undef PG8_STAGE
#undef PG8_LDA
#undef PG8_LDB
#undef PG8_MMA
#undef PG8_WAIT_V
#undef PG8_WAIT_L
#undef PG8_BAR
#undef PG8_SCHED
}
}

namespace pg8 {
__device__ __forceinline__ float bf2f_(unsigned short u) { return __builtin_bit_cast(float, (unsigned)u << 16); }
__device__ __forceinline__ float sigmoid_(float x) { return 1.0f / (1.0f + __expf(-x)); }
struct EpiProj {
    static constexpr bool PERM = true, AFTER_DRAIN = false;
    bf16_t* base;
    unsigned long long* ssq;
    const float* rtab;
    __device__ __forceinline__ void operator()(const f32x4 (&acc)[2][2][4][2], const Unit& u, int wr, int wc, int fr, int fq) const {
        constexpr size_t MT = 8192;
        int colt = u.pn * BM; int width, act = 0; size_t off;
        if (colt < 1024)       { width = 1024; off = 0; }
        else if (colt < 2048)  { colt -= 1024; width = 1024; off = MT * 1024; }
        else if (colt < 4096)  { colt -= 2048; width = 2048; off = MT * 2048; }
        else if (colt < 6144)  { colt -= 4096; width = 2048; off = MT * 4096; act = 1; }
        else if (colt < 9216)  { colt -= 6144; width = 3072; off = MT * 6144; act = 3; }
        else if (colt < 12288) { colt -= 9216; width = 3072; off = MT * 9216; act = 4; }
        else if (colt < 15360) { colt -= 12288; width = 3072; off = MT * 12288; }
        else if (colt < 17408) { colt -= 15360; width = 2048; off = MT * 15360; act = 2; }
        else                   { colt -= 17408; width = 2048; off = MT * 17408; act = 2; }
        const int row0 = u.pm * BM + wr * 64 + fr, col0 = colt + wc * 32 + 8 * fq;
        const bool rot = (u.pn * BM) < 2048; const float rsc = ((u.pn * BM) >= 1024) ? 0.08838834764831845f : 1.0f;
        bf16_t* O = base + off;
#pragma unroll
        for (int ai = 0; ai < 2; ++ai)
#pragma unroll
            for (int m = 0; m < 4; ++m) { bf16_t* rowp = O + (size_t)(row0 + ai * HALF + m * 16) * width + col0;
#pragma unroll
                for (int bj = 0; bj < 2; ++bj) { f32x4 v0 = acc[ai][bj][m][0], v1 = acc[ai][bj][m][1];
                    if (rot) { const int pos = (row0 + ai * HALF + m * 16) & 4095; const float* tp = rtab + ((size_t)pos * 64 + 16 * wc + 4 * fq) * 2;
                        const f32x4 c0 = *(const f32x4*)tp, c1 = *(const f32x4*)(tp + 4);
                        const float a0 = v0[0] * c0[0] - v0[1] * c0[1], b0 = v0[1] * c0[0] + v0[0] * c0[1], a1 = v0[2] * c0[2] - v0[3] * c0[3], b1 = v0[3] * c0[2] + v0[2] * c0[3];
                        const float a2 = v1[0] * c1[0] - v1[1] * c1[1], b2 = v1[1] * c1[0] + v1[0] * c1[1], a3 = v1[2] * c1[2] - v1[3] * c1[3], b3 = v1[3] * c1[2] + v1[2] * c1[3];
                        v0[0] = a0 * rsc; v0[1] = b0 * rsc; v0[2] = a1 * rsc; v0[3] = b1 * rsc; v1[0] = a2 * rsc; v1[1] = b2 * rsc; v1[2] = a3 * rsc; v1[3] = b3 * rsc; }
                    if (act >= 3) {
                        float ss = (v0[0] * v0[0] + v0[1] * v0[1]) + (v0[2] * v0[2] + v0[3] * v0[3]) + (v1[0] * v1[0] + v1[1] * v1[1]) + (v1[2] * v1[2] + v1[3] * v1[3]);
                        { auto r1 = __builtin_amdgcn_permlane16_swap(__float_as_uint(ss), __float_as_uint(ss), false, false); ss = __uint_as_float(r1[0]) + __uint_as_float(r1[1]); }
                        { auto r2 = __builtin_amdgcn_permlane32_swap(__float_as_uint(ss), __float_as_uint(ss), false, false); ss = __uint_as_float(r2[0]) + __uint_as_float(r2[1]); }
                        if (fq == 0) atomicAdd(ssq + ((size_t)(act - 3) * MT + (row0 + ai * HALF + m * 16)) * 24 + (colt >> 7) + bj, (unsigned long long)(ss * 16777216.0f + 0.5f)); }
                    if (act == 1) {
#pragma unroll
                        for (int e = 0; e < 4; ++e) { v0[e] = v0[e] * sigmoid_(v0[e]); v1[e] = v1[e] * sigmoid_(v1[e]); } }
                    else if (act == 2) {
#pragma unroll
                        for (int e = 0; e < 4; ++e) { v0[e] = sigmoid_(v0[e]); v1[e] = sigmoid_(v1[e]); } }
                    u32x4 w; w.x = cvt_pk_bf16(v0[0], v0[1]); w.y = cvt_pk_bf16(v0[2], v0[3]); w.z = cvt_pk_bf16(v1[0], v1[1]); w.w = cvt_pk_bf16(v1[2], v1[3]);
                    __builtin_nontemporal_store(w, (u32x4*)(rowp + bj * HALF)); } }
    }
};
struct EpiGateF32 {
    static constexpr bool PERM = false, AFTER_DRAIN = false;
    float* C; const bf16_t* gate; int ldc;
    __device__ __forceinline__ void operator()(const f32x4 (&acc)[2][2][4][2], const Unit& u, int wr, int wc, int fr, int fq) const {
        const int row0 = u.pm * BM + wr * 64 + fr, col0 = u.pn * BM + wc * 32 + 4 * fq;
#pragma unroll
        for (int ai = 0; ai < 2; ++ai)
#pragma unroll
            for (int m = 0; m < 4; ++m) { const size_t ro = (size_t)(row0 + ai * HALF + m * 16) * ldc + col0;
#pragma unroll
                for (int bj = 0; bj < 2; ++bj)
#pragma unroll
                    for (int n = 0; n < 2; ++n) { const size_t o = ro + bj * HALF + n * 16; const unsigned long long gb = *(const unsigned long long*)(gate + o);
                        f32x4 g; g[0] = bf2f_((unsigned short)gb); g[1] = bf2f_((unsigned short)(gb >> 16)); g[2] = bf2f_((unsigned short)(gb >> 32)); g[3] = bf2f_((unsigned short)(gb >> 48));
                        *(f32x4*)(C + o) = acc[ai][bj][m][n] * g; } }
    }
};
struct EpiGateAddBf16 {
    static constexpr bool PERM = false, AFTER_DRAIN = false;
    bf16_t* O; const float* prev; const bf16_t* gate; int ldc;
    __device__ __forceinline__ void operator()(const f32x4 (&acc)[2][2][4][2], const Unit& u, int wr, int wc, int fr, int fq) const {
        const int row0 = u.pm * BM + wr * 64 + fr, col0 = u.pn * BM + wc * 32 + 4 * fq;
#pragma unroll
        for (int ai = 0; ai < 2; ++ai)
#pragma unroll
            for (int m = 0; m < 4; ++m) { const size_t ro = (size_t)(row0 + ai * HALF + m * 16) * ldc + col0;
#pragma unroll
                for (int bj = 0; bj < 2; ++bj)
#pragma unroll
                    for (int n = 0; n < 2; ++n) { const size_t o = ro + bj * HALF + n * 16; const unsigned long long gb = *(const unsigned long long*)(gate + o);
                        f32x4 g; g[0] = bf2f_((unsigned short)gb); g[1] = bf2f_((unsigned short)(gb >> 16)); g[2] = bf2f_((unsigned short)(gb >> 32)); g[3] = bf2f_((unsigned short)(gb >> 48));
                        const f32x4 r = *(const f32x4*)(prev + o) + acc[ai][bj][m][n] * g;
                        unsigned long long w = (unsigned long long)cvt_pk_bf16(r[0], r[1]) | ((unsigned long long)cvt_pk_bf16(r[2], r[3]) << 32);
                        *(unsigned long long*)(O + o) = w; } }
    }
};
struct EpiResNorm {
    static constexpr bool PERM = false, AFTER_DRAIN = false;
    float* C; const float* res; bf16_t* H2u; const float* g; unsigned long long* RSQ; unsigned* RMX; int ldc;
    __device__ __forceinline__ void operator()(const f32x4 (&acc)[2][2][4][2], const Unit& u, int wr, int wc, int fr, int fq) const {
        const int row0 = u.pm * BM + wr * 64 + fr, col0 = u.pn * BM + wc * 32 + 4 * fq;
        f32x4 gv[2][2];
#pragma unroll
        for (int bj = 0; bj < 2; ++bj)
#pragma unroll
            for (int n = 0; n < 2; ++n) gv[bj][n] = *(const f32x4*)(g + col0 + bj * HALF + n * 16);
#pragma unroll
        for (int ai = 0; ai < 2; ++ai)
#pragma unroll
            for (int m = 0; m < 4; ++m) { const int row = row0 + ai * HALF + m * 16; const size_t ro = (size_t)row * ldc + col0; float ss = 0.f, mx = 0.f;
#pragma unroll
                for (int bj = 0; bj < 2; ++bj)
#pragma unroll
                    for (int n = 0; n < 2; ++n) { const size_t o = ro + bj * HALF + n * 16;
                        const f32x4 r = acc[ai][bj][m][n] + *(const f32x4*)(res + o);
                        *(f32x4*)(C + o) = r; ss += (r[0] * r[0] + r[1] * r[1]) + (r[2] * r[2] + r[3] * r[3]);
                        const f32x4 h = r * gv[bj][n]; mx = fmaxf(fmaxf(mx, fmaxf(fabsf(h[0]), fabsf(h[1]))), fmaxf(fabsf(h[2]), fabsf(h[3])));
                        *(unsigned long long*)(H2u + o) = (unsigned long long)cvt_pk_bf16(h[0], h[1]) | ((unsigned long long)cvt_pk_bf16(h[2], h[3]) << 32); }
                { auto r1 = __builtin_amdgcn_permlane16_swap(__float_as_uint(ss), __float_as_uint(ss), false, false); ss = __uint_as_float(r1[0]) + __uint_as_float(r1[1]); }
                { auto r2 = __builtin_amdgcn_permlane32_swap(__float_as_uint(ss), __float_as_uint(ss), false, false); ss = __uint_as_float(r2[0]) + __uint_as_float(r2[1]); }
                { auto r1 = __builtin_amdgcn_permlane16_swap(__float_as_uint(mx), __float_as_uint(mx), false, false); mx = fmaxf(__uint_as_float(r1[0]), __uint_as_float(r1[1])); }
                { auto r2 = __builtin_amdgcn_permlane32_swap(__float_as_uint(mx), __float_as_uint(mx), false, false); mx = fmaxf(__uint_as_float(r2[0]), __uint_as_float(r2[1])); }
                if (fq == 0) { atomicAdd(RSQ + row, (unsigned long long)(ss * 16777216.0f + 0.5f)); atomicMax(RMX + row, __float_as_uint(mx)); } }
    }
};
struct EpiHiLoScaled {
    static constexpr bool PERM = true, AFTER_DRAIN = false;
    bf16_t* H; bf16_t* L; const unsigned long long* RSQ; int ldc; float inv_n, eps;
    __device__ __forceinline__ void operator()(const f32x4 (&acc)[2][2][4][2], const Unit& u, int wr, int wc, int fr, int fq) const {
        const int row0 = u.pm * BM + wr * 64 + fr, col0 = u.pn * BM + wc * 32 + 8 * fq;
#pragma unroll
        for (int ai = 0; ai < 2; ++ai)
#pragma unroll
            for (int m = 0; m < 4; ++m) { const int row = row0 + ai * HALF + m * 16; const size_t ro = (size_t)row * ldc + col0;
                const float rs = 1.0f / sqrtf((float)RSQ[row] * (inv_n * (1.0f / 16777216.0f)) + eps);
#pragma unroll
                for (int bj = 0; bj < 2; ++bj) { const f32x4 v0 = acc[ai][bj][m][0] * rs, v1 = acc[ai][bj][m][1] * rs;
                    u32x4 wh; wh.x = cvt_pk_bf16(v0[0], v0[1]); wh.y = cvt_pk_bf16(v0[2], v0[3]); wh.z = cvt_pk_bf16(v1[0], v1[1]); wh.w = cvt_pk_bf16(v1[2], v1[3]);
                    u32x4 wl;
                    wl.x = cvt_pk_bf16(v0[0] - __builtin_bit_cast(float, wh.x << 16), v0[1] - __builtin_bit_cast(float, wh.x & 0xffff0000u));
                    wl.y = cvt_pk_bf16(v0[2] - __builtin_bit_cast(float, wh.y << 16), v0[3] - __builtin_bit_cast(float, wh.y & 0xffff0000u));
                    wl.z = cvt_pk_bf16(v1[0] - __builtin_bit_cast(float, wh.z << 16), v1[1] - __builtin_bit_cast(float, wh.z & 0xffff0000u));
                    wl.w = cvt_pk_bf16(v1[2] - __builtin_bit_cast(float, wh.w << 16), v1[3] - __builtin_bit_cast(float, wh.w & 0xffff0000u));
                    *(u32x4*)(H + ro + bj * HALF) = wh; *(u32x4*)(L + ro + bj * HALF) = wl; } }
    }
};
}
#ifndef PG8_SP2
#define PG8_SP2 true
#endif
#ifndef PG8_ALIGN
#define PG8_ALIGN true
#endif

constexpr int NWAVES = 8;
constexpr int NTOK = 8192, SEQ = 4096, DM = 2048, INW = 19456;
constexpr int NEXP = 16384;
constexpr float EPS = 1e-6f;
#ifndef MK_N_LAUNCHES
#define MK_N_LAUNCHES 1
#endif
constexpr int N_PHASES = 15;
constexpr int N_LAUNCHES = MK_N_LAUNCHES;

constexpr size_t MiB = 1u << 20;
constexpr size_t WS_CTL = 0, CTL_ZERO_BYTES = 32768;
constexpr size_t WS_WINT = 1 * MiB;
constexpr size_t WS_WRET = 77 * MiB;
constexpr size_t WS_WATT = 85 * MiB;
constexpr size_t WS_WOUT = 89 * MiB;
constexpr size_t WS_WQ   = 97 * MiB;
constexpr size_t WS_XN   = 105 * MiB;
constexpr size_t WS_PROJ = 137 * MiB;
constexpr size_t WS_UBF  = 441 * MiB;
constexpr size_t WS_VBF  = 505 * MiB;
constexpr size_t WS_ATT  = 569 * MiB;
constexpr size_t WS_EIDX = 585 * MiB;
constexpr size_t WS_GATE = 589 * MiB;
constexpr size_t WS_RTAB = 593 * MiB;
constexpr size_t WS_ATAB = 595 * MiB;
constexpr size_t WS_SKH  = 596 * MiB;
constexpr size_t WS_SKL  = 596 * MiB + 512 * 1024;
constexpr size_t WS_SU   = 597 * MiB;
constexpr size_t WS_END  = 598 * MiB;
constexpr size_t PO_RQ = 0, PO_RK = (size_t)NTOK * 1024, PO_RV = (size_t)NTOK * 2048, PO_RG = (size_t)NTOK * 4096, PO_AQ = (size_t)NTOK * 6144,
                 PO_AK = (size_t)NTOK * 9216, PO_AV = (size_t)NTOK * 12288, PO_GR = (size_t)NTOK * 15360, PO_GA = (size_t)NTOK * 17408;
constexpr int CW_BAR = 4096;

constexpr int RING_OFF = 0, RING_BYTES = 131072;
constexpr int LDSCTL_OFF = RING_BYTES, MISC_OFF = LDSCTL_OFF + 320;
constexpr int LDS_BYTES = 147456;

#define GAS __attribute__((address_space(1)))
#define LAS __attribute__((address_space(3)))
typedef unsigned short bf16;
typedef unsigned v4u __attribute__((ext_vector_type(4)));
typedef unsigned v2u __attribute__((ext_vector_type(2)));
typedef float f32x4 __attribute__((ext_vector_type(4)));
typedef float f32x2 __attribute__((ext_vector_type(2)));
typedef GAS unsigned gu32;
#define RLX_AGENT __ATOMIC_RELAXED, __HIP_MEMORY_SCOPE_AGENT
#define LDS_WAIT() asm volatile("s_waitcnt lgkmcnt(0)" ::: "memory")
#define VM_WAIT() asm volatile("s_waitcnt vmcnt(0)" ::: "memory")
__device__ __forceinline__ unsigned f2bf(float f) { unsigned u = __builtin_bit_cast(unsigned, f); return (u + 0x7fffu + ((u >> 16) & 1u)) >> 16; }
__device__ __forceinline__ unsigned pk2(float lo, float hi) { unsigned r; asm("v_cvt_pk_bf16_f32 %0, %1, %2" : "=v"(r) : "v"(lo), "v"(hi)); return r; }
__device__ __forceinline__ float bf2f(unsigned u16) { return __builtin_bit_cast(float, u16 << 16); }
__device__ __forceinline__ float bflo(unsigned w) { return __builtin_bit_cast(float, w << 16); }
__device__ __forceinline__ float bfhi(unsigned w) { return __builtin_bit_cast(float, w & 0xffff0000u); }
__device__ __forceinline__ float wave_sum(float v) {
#pragma unroll
    for (int o = 1; o < 64; o <<= 1) v += __shfl_xor(v, o);
    return v;
}
__device__ __forceinline__ float wave_max(float v) {
#pragma unroll
    for (int o = 1; o < 64; o <<= 1) v = fmaxf(v, __shfl_xor(v, o));
    return v;
}
#define XB_TMO      128
#define XB_XCNT(j)  (256  + 64 * (j))
#define XB_XSUB(j)  (1280 + 64 * (j))
#define XB_XGEN(j)  (2304 + 64 * (j))
#define XB_TOP      3328
#define XB_TOPGEN   3392
#define XCD_BAR_WORDS 3456
#define XB_SPIN_CAP (1u << 24)

__device__ __forceinline__ unsigned xb_ld(unsigned* p)              { return __hip_atomic_load(p, __ATOMIC_RELAXED, __HIP_MEMORY_SCOPE_AGENT); }
__device__ __forceinline__ unsigned xb_add(unsigned* p, unsigned v) { return __hip_atomic_fetch_add(p, v, __ATOMIC_RELAXED, __HIP_MEMORY_SCOPE_AGENT); }
__device__ __forceinline__ unsigned xb_xcc_id() { return (unsigned)__builtin_amdgcn_s_getreg((3 << 11) | 20) & 0xFu; }
#define XB_SPIN(cond, bar) do { unsigned _sp = 0; while (cond) { __builtin_amdgcn_s_sleep(1); \
    if ((++_sp & 255u) == 0u) { if (xb_ld(&(bar)[XB_TMO])) break; if (_sp > XB_SPIN_CAP) { atomicAdd(&(bar)[XB_TMO], 1u); break; } } } } while (0)

struct XcdBarrier {
    unsigned* bar; unsigned x;
    volatile LAS unsigned* st;
};

__device__ __forceinline__ XcdBarrier xcd_barrier_post(unsigned* bar, volatile LAS unsigned* st) {
    XcdBarrier b; b.bar = bar; b.x = xb_xcc_id(); b.st = st;
    if (threadIdx.x == 0) (void)xb_add(&bar[XB_XCNT(b.x)], 1u);
    return b;
}
__device__ __forceinline__ void xcd_barrier_complete(unsigned* bar, unsigned x, unsigned& nloc, unsigned& nx) {
    const unsigned G = gridDim.x * gridDim.y * gridDim.z;
    unsigned sum, cnt, mine, sp = 0u;
    for (;;) {
        sum = 0u; cnt = 0u; mine = 0u;
#pragma unroll
        for (unsigned j = 0; j < 16; ++j) { const unsigned c = xb_ld(&bar[XB_XCNT(j)]); sum += c; cnt += (c > 0u) ? 1u : 0u; mine = (j == x) ? c : mine; }
        if (sum == G) break;
        __builtin_amdgcn_s_sleep(1);
        if ((++sp & 255u) == 0u) { if (xb_ld(&bar[XB_TMO])) break; if (sp > XB_SPIN_CAP) { atomicAdd(&bar[XB_TMO], 1u); break; } }
    }
    nloc = mine > 0u ? mine : 1u; nx = cnt > 0u ? cnt : 1u;
}

__device__ __forceinline__ void xcd_barrier(const XcdBarrier& b) {
    asm volatile("s_waitcnt vmcnt(0)" ::: "memory");
    __syncthreads();
    if (threadIdx.x == 0) {
        unsigned* bar = b.bar;
        __builtin_amdgcn_s_waitcnt(0);
        unsigned nloc = b.st[0], nx = b.st[1];
        if (nloc == 0u) { xcd_barrier_complete(bar, b.x, nloc, nx); b.st[0] = nloc; b.st[1] = nx; }
        const unsigned old = xb_add(&bar[XB_XSUB(b.x)], 1u);
        const unsigned gen = old / nloc;
        if (old + 1u == (gen + 1u) * nloc) {
            __builtin_amdgcn_fence(__ATOMIC_RELEASE, "agent");
            asm volatile("s_waitcnt vmcnt(0)" ::: "memory");
            const unsigned og = xb_add(&bar[XB_TOP], 1u);
            const unsigned tg = og / nx;
            if (og + 1u == (tg + 1u) * nx) xb_add(&bar[XB_TOPGEN], 1u);
            else XB_SPIN(xb_ld(&bar[XB_TOPGEN]) == tg, bar);
            __builtin_amdgcn_fence(__ATOMIC_ACQUIRE, "agent");
            xb_add(&bar[XB_XGEN(b.x)], 1u);
            asm volatile("s_waitcnt vmcnt(0)" ::: "memory");
        } else {
            XB_SPIN(xb_ld(&bar[XB_XGEN(b.x)]) == gen, bar);
            __builtin_amdgcn_fence(__ATOMIC_ACQUIRE, "agent");
            asm volatile("s_waitcnt vmcnt(0)" ::: "memory");
        }
    }
    __syncthreads();
}

struct Frame {
    LAS unsigned char* lds;
    volatile LAS unsigned* MISC;
    gu32* ctl;
    int tid, lane, wave;
    int vcu, G;
    const float *x, *mix_g, *w_in, *dec_f, *dec_b, *gn_g, *w_ret, *qn_g, *kn_g, *w_att, *w_out, *ffn_g, *w_pq, *subk, *pu, *pv;
    float* out;
    bf16 *WinT, *WretT, *WattT, *WoutT, *WqT, *XN, *PROJ, *Ubf, *Vbf, *ATT;
    int* EIDX; float* GATE; f32x2* RTAB; f32x2* ATAB; bf16 *SKH, *SKL;
};

template <bool ROTP = false> __device__ __forceinline__ void p0_transpose_item(const float* W, int K, int N, bf16* WT, LAS float* scr, int item, int lane) {
    const int nblk = N / 32, kb = item / nblk, nb = item % nblk, k0 = 64 * kb, n0 = 32 * nb;
    int ncol = n0 + (lane & 31);
    if (ROTP && ncol < 2048) { const int cp = ncol & 127; ncol = (ncol & ~127) + (cp >> 1) + 64 * (cp & 1); }
#pragma unroll 8
    for (int i = 0; i < 32; ++i) { const int kk = 2 * i + (lane >> 5); scr[kk * 33 + (lane & 31)] = __builtin_nontemporal_load(W + (size_t)(k0 + kk) * N + ncol); }
    LDS_WAIT(); asm volatile("" ::: "memory");
    const int c = lane & 7;
#pragma unroll
    for (int j = 0; j < 4; ++j) { const int n = (lane >> 3) + 8 * j; const LAS float* s = scr + (8 * c) * 33 + n;
        v4u o; o.x = pk2(s[0 * 33], s[1 * 33]); o.y = pk2(s[2 * 33], s[3 * 33]); o.z = pk2(s[4 * 33], s[5 * 33]); o.w = pk2(s[6 * 33], s[7 * 33]);
        if (ROTP) *(v4u*)(WT + ((size_t)((n0 + n) >> 8) * (K >> 6) + (k0 >> 6)) * 16384 + ((n0 + n) & 255) * 64 + 8 * c) = o;
        else *(v4u*)(WT + (size_t)(n0 + n) * K + k0 + 8 * c) = o; }
    LDS_WAIT(); asm volatile("" ::: "memory");
}
__device__ __forceinline__ void rms_row_to_bf16_tiled(const float* xrow, const float* g, bf16* obase, int m, int lane) {
    const f32x4* xr = (const f32x4*)xrow + lane; const f32x4* gr = (const f32x4*)g + lane;
    f32x4 v[8]; float s = 0.f;
#pragma unroll
    for (int j = 0; j < 8; ++j) { v[j] = __builtin_nontemporal_load(xr + 64 * j); s += (v[j].x * v[j].x + v[j].y * v[j].y) + (v[j].z * v[j].z + v[j].w * v[j].w); }
    const float rstd = 1.0f / sqrtf(wave_sum(s) * (1.f / DM) + EPS);
#pragma unroll
    for (int j = 0; j < 8; ++j) { const f32x4 gg = gr[64 * j]; const int k = 256 * j + 4 * lane;
        unsigned long long* o8 = (unsigned long long*)(obase + ((size_t)(m >> 8) * (DM >> 6) + (k >> 6)) * 16384 + (m & 255) * 64 + (k & 63));
        *o8 = (unsigned long long)pk2(v[j].x * rstd * gg.x, v[j].y * rstd * gg.y) | ((unsigned long long)pk2(v[j].z * rstd * gg.z, v[j].w * rstd * gg.w) << 32); }
}
__device__ __forceinline__ void p0_prologue(Frame& F) {
    LAS float* scr = (LAS float*)(F.lds + RING_OFF + F.wave * 16384);
    const int gw = F.vcu * NWAVES + F.wave, NGW = F.G * NWAVES;
    constexpr int I_IN = (DM / 64) * (INW / 32), I_SQ = (DM / 64) * (DM / 32), I_AT = (1024 / 64) * (DM / 32);
    constexpr int NITEMS = I_IN + 3 * I_SQ + I_AT;
    for (int it = gw; it < NITEMS; it += NGW) {
        int r = it;
        if (r < I_IN) { p0_transpose_item<true>(F.w_in, DM, INW, F.WinT, scr, r, F.lane); continue; } r -= I_IN;
        if (r < I_SQ) { p0_transpose_item(F.w_ret, DM, DM, F.WretT, scr, r, F.lane); continue; } r -= I_SQ;
        if (r < I_SQ) { p0_transpose_item(F.w_out, DM, DM, F.WoutT, scr, r, F.lane); continue; } r -= I_SQ;
        if (r < I_SQ) { p0_transpose_item(F.w_pq, DM, DM, F.WqT, scr, r, F.lane); continue; } r -= I_SQ;
        p0_transpose_item(F.w_att, 1024, DM, F.WattT, scr, r, F.lane);
    }
    for (int m = gw; m < NTOK; m += NGW) rms_row_to_bf16_tiled(F.x + (size_t)m * DM, F.mix_g, F.XN, m, F.lane);
    for (int idx = gw * 64 + F.lane; idx < 8 * 2 * 128 * 128 / 2; idx += NGW * 64) { const f32x2 v = *(const f32x2*)(F.subk + 2 * idx);
        const unsigned hi = pk2(v.x, v.y); const unsigned lo = pk2(v.x - bflo(hi), v.y - bfhi(hi)); ((unsigned*)F.SKH)[idx] = hi; ((unsigned*)F.SKL)[idx] = lo; }
    for (int idx = gw * 64 + F.lane; idx < SEQ * 64; idx += NGW * 64) { const int pos = idx >> 6, i = idx & 63;
        const float freq = powf(10000.0f, -(float)i / 64.0f), ang = (float)pos * freq; f32x2 cs; cs.x = cosf(ang); cs.y = sinf(ang); F.RTAB[idx] = cs; }
    for (int idx = gw * 64 + F.lane; idx < SEQ * 16; idx += NGW * 64) { const int pos = idx >> 4, i = idx & 15;
        const float freq = powf(500000.0f, -(float)i / 16.0f), ang = (float)pos * freq; f32x2 cs; cs.x = cosf(ang); cs.y = sinf(ang); F.ATAB[idx] = cs; }
}

template <int CTRL> __device__ __forceinline__ float dpp_f(float x) { return __builtin_bit_cast(float, __builtin_amdgcn_mov_dpp(__builtin_bit_cast(int, x), CTRL, 0xf, 0xf, true)); }

typedef short bf16x8 __attribute__((ext_vector_type(8)));
typedef float f32x16 __attribute__((ext_vector_type(16)));
#define MFMA32(a, b, c) __builtin_amdgcn_mfma_f32_32x32x16_bf16((a), (b), (c), 0, 0, 0)
__device__ __forceinline__ unsigned cvtpk(float lo, float hi) { unsigned r; asm volatile("v_cvt_pk_bf16_f32 %0, %1, %2" : "=v"(r) : "v"(lo), "v"(hi)); return r; }

__device__ __forceinline__ void ret_phaseB(Frame& F, bf16* UF, bf16* UB) {
    for (int task = F.vcu * 512 + F.tid; task < 131072; task += F.G * 512) {
        const int piece = task & 4095, bh = (task >> 12) & 15, dir = task >> 16, b = bh >> 3, h = bh & 7;
        const float cd = expf(-expf(dir ? F.dec_b[h] : F.dec_f[h]) * 128.0f);
        bf16* base = (dir ? UB : UF) + (size_t)piece * 8;
        float s[8];
#pragma unroll
        for (int i = 0; i < 8; ++i) s[i] = 0.f;
        const size_t cstride = (size_t)8 * 32768;
        bf16* p0 = base + (size_t)(b * 32 * 8 + h) * 32768;
        v4u wv[32];
#pragma unroll
        for (int cc = 0; cc < 32; ++cc) { const int c = dir ? 31 - cc : cc; wv[cc] = *(const v4u*)(p0 + c * cstride); }
#pragma unroll
        for (int cc = 0; cc < 32; ++cc) { const int c = dir ? 31 - cc : cc; const v4u w = wv[cc];
            v4u o; o.x = pk2(s[0], s[1]); o.y = pk2(s[2], s[3]); o.z = pk2(s[4], s[5]); o.w = pk2(s[6], s[7]); *(v4u*)(p0 + c * cstride) = o;
            s[0] = s[0] * cd + bflo(w.x); s[1] = s[1] * cd + bfhi(w.x); s[2] = s[2] * cd + bflo(w.y); s[3] = s[3] * cd + bfhi(w.y);
            s[4] = s[4] * cd + bflo(w.z); s[5] = s[5] * cd + bfhi(w.z); s[6] = s[6] * cd + bflo(w.w); s[7] = s[7] * cd + bfhi(w.w); }
    }
}


constexpr int LROW = 272;
template <int NI> __device__ __forceinline__ void tile_ld(v4u (&g)[NI], const bf16* src, size_t src_stride, int tid) {
    const bf16* p = src + (size_t)(tid >> 4) * src_stride + (tid & 15) * 8;
#pragma unroll
    for (int i = 0; i < NI; ++i) g[i] = *(const v4u*)(p + (size_t)(32 * i) * src_stride);
}
template <int NI> __device__ __forceinline__ void tile_st(const v4u (&g)[NI], LAS unsigned char* dst, int tid) {
    LAS unsigned char* p = dst + (tid >> 4) * LROW + (tid & 15) * 16;
#pragma unroll
    for (int i = 0; i < NI; ++i) *(LAS v4u*)(p + 32 * i * LROW) = g[i];
}
#define BLK_SYNC() do { asm volatile("s_waitcnt lgkmcnt(0)" ::: "memory"); __builtin_amdgcn_s_barrier(); asm volatile("" ::: "memory"); } while (0)


template <int NI> __device__ __forceinline__ void tile_out(bf16* dst, const LAS unsigned char* srcl, int tid) {
    const LAS unsigned char* p = srcl + (tid >> 4) * LROW + (tid & 15) * 16; bf16* d = dst + (size_t)(tid >> 4) * 128 + (tid & 15) * 8;
#pragma unroll
    for (int i = 0; i < NI; ++i) *(v4u*)(d + (size_t)(32 * i) * 128) = *(const LAS v4u*)(p + 32 * i * LROW);
}

__device__ __forceinline__ void att_merge(Frame& F, const bf16* OGN, const float* LSE) {
#pragma unroll 4
    for (int task = F.vcu * 512 + F.tid; task < NTOK * 128; task += F.G * 512) {
        const int m = task >> 7, c8 = (task & 127) * 8, hh = c8 >> 7;
        const float l0 = LSE[(size_t)m * 8 + hh], l1 = LSE[(size_t)NTOK * 8 + (size_t)m * 8 + hh], l2 = LSE[(size_t)2 * NTOK * 8 + (size_t)m * 8 + hh];
        const float mx = fmaxf(l0, fmaxf(l1, l2)); float w0 = __expf(l0 - mx), w1 = __expf(l1 - mx), w2 = __expf(l2 - mx); const float inv = 1.0f / (w0 + w1 + w2); w0 *= inv; w1 *= inv; w2 *= inv;
        const size_t o = (size_t)m * 1024 + c8;
        const v4u a = *(const v4u*)(OGN + o), bq = *(const v4u*)(OGN + (size_t)NTOK * 1024 + o), c = *(const v4u*)(OGN + (size_t)2 * NTOK * 1024 + o);
        v4u res;
        res.x = pk2(w0 * bflo(a.x) + w1 * bflo(bq.x) + w2 * bflo(c.x), w0 * bfhi(a.x) + w1 * bfhi(bq.x) + w2 * bfhi(c.x));
        res.y = pk2(w0 * bflo(a.y) + w1 * bflo(bq.y) + w2 * bflo(c.y), w0 * bfhi(a.y) + w1 * bfhi(bq.y) + w2 * bfhi(c.y));
        res.z = pk2(w0 * bflo(a.z) + w1 * bflo(bq.z) + w2 * bflo(c.z), w0 * bfhi(a.z) + w1 * bfhi(bq.z) + w2 * bfhi(c.z));
        res.w = pk2(w0 * bflo(a.w) + w1 * bflo(bq.w) + w2 * bflo(c.w), w0 * bfhi(a.w) + w1 * bfhi(bq.w) + w2 * bfhi(c.w));
        *(v4u*)(F.ATT + o) = res;
    }
}

typedef short trv4 __attribute__((ext_vector_type(4)));
constexpr int VROW = 320;
__device__ __forceinline__ void att_phase3(Frame& F, bf16* OGN, float* LSE, const unsigned long long* SSQ) {
    const bf16* AQ = F.PROJ + PO_AQ; const bf16* AK = F.PROJ + PO_AK; const bf16* AV = F.PROJ + PO_AV;
    LAS unsigned char* Lk = F.lds + RING_OFF;
    const int tid = F.tid, lane = F.lane, r = lane & 31, lh = lane >> 5, w = F.wave;
    for (int unit = F.vcu; unit < 2 * 24 * 16; unit += F.G) {
        int blk = unit & 15; asm volatile("" : "+v"(blk));
        int ts = tid; asm volatile("" : "+v"(ts));
        const int bh = unit >> 4, head = bh % 24, b = bh / 24, g = head >> 3, hh = head & 7, sh = 2 * g, dil = 1 << sh, L = SEQ >> sh;
        const int nb = L >> 8, p = blk / nb, l0 = (blk % nb) * 256, lq = l0 + 32 * w + r;
        const size_t mq = (size_t)b * SEQ + (size_t)lq * dil + p;
        __syncthreads();
        { const int ch = ts & 15, c8 = ch * 8; const float* kg_ = F.kn_g; asm volatile("" : "+s"(kg_));
          const f32x4 g0 = *(const f32x4*)(kg_ + c8), g1 = *(const f32x4*)(kg_ + c8 + 4);
          const float gg[8] = {g0.x, g0.y, g0.z, g0.w, g1.x, g1.y, g1.z, g1.w};
#pragma unroll 1
          for (int ib = 0; ib < 12; ib += 6) {
              v4u wr_[6]; unsigned long long sq_[6];
#pragma unroll
              for (int i = 0; i < 6; ++i) { const int slot = 32 * (ib + i) + (ts >> 4), l = l0 - 64 + slot; const bool ok = (l >= 0 && l < L); const int pos = ok ? l * dil + p : 0; const size_t mk = (size_t)b * SEQ + pos;
                  wr_[i] = *(const v4u*)(AK + mk * 3072 + head * 128 + c8); sq_[i] = SSQ[((size_t)NTOK + mk) * 24 + head]; }
#pragma unroll
              for (int i = 0; i < 6; ++i) { const int slot = 32 * (ib + i) + (ts >> 4), l = l0 - 64 + slot; const bool ok = (l >= 0 && l < L); const int pos = ok ? l * dil + p : 0;
                  const v4u w_ = wr_[i]; const float rstd = 1.0f / sqrtf((float)sq_[i] * (1.f / (128.f * 16777216.0f)) + EPS);
                  float x[8] = {bflo(w_.x), bfhi(w_.x), bflo(w_.y), bfhi(w_.y), bflo(w_.z), bfhi(w_.z), bflo(w_.w), bfhi(w_.w)};
#pragma unroll
                  for (int j = 0; j < 8; ++j) x[j] = x[j] * rstd * gg[j];
                  float oth[8];
#pragma unroll
                  for (int j = 0; j < 8; ++j) oth[j] = dpp_f<0x4E>(x[j]);
                  if (ch < 4) { const f32x2* tab = F.ATAB + pos * 16 + 8 * (ch & 1);
#pragma unroll
                      for (int j = 0; j < 8; ++j) { const f32x2 cs = tab[j]; x[j] = (ch < 2) ? (x[j] * cs.x - oth[j] * cs.y) : (x[j] * cs.x + oth[j] * cs.y); } }
                  v4u v; v.x = pk2(x[0], x[1]); v.y = pk2(x[2], x[3]); v.z = pk2(x[4], x[5]); v.w = pk2(x[6], x[7]);
                  if (!ok) v = (v4u){0u, 0u, 0u, 0u};
                  *(LAS v4u*)(Lk + slot * LROW + 2 * c8) = v; } } }
        bf16x8 qf[8];
        { const bf16* qp = AQ + mq * 3072 + head * 128 + 8 * lh; const float rstd = 1.0f / sqrtf((float)SSQ[mq * 24 + head] * (1.f / (128.f * 16777216.0f)) + EPS); const int posq = lq * dil + p;
          const float* qg_ = F.qn_g; asm volatile("" : "+s"(qg_));
          float y0[8], y1[8];
#pragma unroll
          for (int ks = 0; ks < 8; ++ks) { const v4u w_ = *(const v4u*)(qp + 16 * ks); const f32x4 g0 = *(const f32x4*)(qg_ + 16 * ks + 8 * lh), g1 = *(const f32x4*)(qg_ + 16 * ks + 8 * lh + 4);
              float x[8] = {bflo(w_.x) * rstd * g0.x, bfhi(w_.x) * rstd * g0.y, bflo(w_.y) * rstd * g0.z, bfhi(w_.y) * rstd * g0.w, bflo(w_.z) * rstd * g1.x, bfhi(w_.z) * rstd * g1.y, bflo(w_.w) * rstd * g1.z, bfhi(w_.w) * rstd * g1.w};
              if (ks == 0) {
#pragma unroll
                  for (int j = 0; j < 8; ++j) y0[j] = x[j]; }
              else if (ks == 1) {
#pragma unroll
                  for (int j = 0; j < 8; ++j) y1[j] = x[j];
                  const f32x2* tab = F.ATAB + posq * 16 + 8 * lh; float a0[8], a1[8];
#pragma unroll
                  for (int j = 0; j < 8; ++j) { const f32x2 cs = tab[j]; a0[j] = y0[j] * cs.x - y1[j] * cs.y; a1[j] = y1[j] * cs.x + y0[j] * cs.y; }
                  v4u q0; q0.x = pk2(a0[0], a0[1]); q0.y = pk2(a0[2], a0[3]); q0.z = pk2(a0[4], a0[5]); q0.w = pk2(a0[6], a0[7]); qf[0] = __builtin_bit_cast(bf16x8, q0);
                  v4u q1; q1.x = pk2(a1[0], a1[1]); q1.y = pk2(a1[2], a1[3]); q1.z = pk2(a1[4], a1[5]); q1.w = pk2(a1[6], a1[7]); qf[1] = __builtin_bit_cast(bf16x8, q1); }
              else { v4u qq; qq.x = pk2(x[0], x[1]); qq.y = pk2(x[2], x[3]); qq.z = pk2(x[4], x[5]); qq.w = pk2(x[6], x[7]); qf[ks] = __builtin_bit_cast(bf16x8, qq); } } }
#pragma unroll
        for (int ks = 0; ks < 8; ++ks) asm volatile("" : "+v"(qf[ks]));
        __syncthreads();
        v4u vv[12];
        { const int c8 = (ts & 15) * 8;
#pragma unroll
          for (int i = 0; i < 12; ++i) { const int slot = 32 * i + (ts >> 4), l = l0 - 64 + slot; vv[i] = (v4u){0u, 0u, 0u, 0u};
              if (l >= 0 && l < L) vv[i] = *(const v4u*)(AV + ((size_t)b * SEQ + (size_t)l * dil + p) * 3072 + head * 128 + c8); } }
        f32x16 st[5];
#pragma unroll
        for (int kt = 0; kt < 5; ++kt) { const LAS unsigned char* kp = Lk + (32 * w + 32 * kt + r) * LROW + 16 * lh; f32x16 a = (f32x16){0};
#pragma unroll
            for (int ks = 0; ks < 8; ++ks) { const bf16x8 kf = *(const LAS bf16x8*)(kp + 32 * ks); a = MFMA32(kf, qf[ks], a); }
            st[kt] = a; asm volatile("" ::: "memory"); }
        __syncthreads();
        { const int c8 = (ts & 15) * 8;
#pragma unroll
          for (int i = 0; i < 12; ++i) { const int slot = 32 * i + (ts >> 4); *(LAS v4u*)(Lk + slot * VROW + 2 * c8) = vv[i]; } }
        float mx = -1e30f;
#pragma unroll
        for (int kt = 0; kt < 5; ++kt)
#pragma unroll
            for (int reg = 0; reg < 16; ++reg) { const int lk = l0 + 32 * w - 64 + 32 * kt + (reg & 3) + 8 * (reg >> 2) + 4 * lh; const int rel = lk - lq;
                const bool ok = (lk >= 0) && (lk < L) && (rel <= 64) && (rel >= -64);
                const float s = ok ? st[kt][reg] * 0.08838834764831845f : -1e30f; st[kt][reg] = s; mx = fmaxf(mx, s); }
        mx = fmaxf(mx, __shfl_xor(mx, 32));
        float sum = 0.f;
#pragma unroll
        for (int kt = 0; kt < 5; ++kt)
#pragma unroll
            for (int reg = 0; reg < 16; ++reg) { const float pv = __expf(st[kt][reg] - mx); st[kt][reg] = pv; sum += pv; }
        sum += __shfl_xor(sum, 32);
        bf16x8 pb[5][2];
#pragma unroll
        for (int kt = 0; kt < 5; ++kt)
#pragma unroll
            for (int s = 0; s < 2; ++s) { v4u pk; pk.x = cvtpk(st[kt][8 * s], st[kt][8 * s + 1]); pk.y = cvtpk(st[kt][8 * s + 2], st[kt][8 * s + 3]); pk.z = cvtpk(st[kt][8 * s + 4], st[kt][8 * s + 5]); pk.w = cvtpk(st[kt][8 * s + 6], st[kt][8 * s + 7]);
                pb[kt][s] = __builtin_bit_cast(bf16x8, pk); }
        __syncthreads();
        f32x16 acc[4];
#pragma unroll
        for (int dt = 0; dt < 4; ++dt) acc[dt] = (f32x16){0};
        const LAS unsigned char* vtr = Lk + (32 * w + 4 * lh + ((lane & 15) >> 2)) * VROW + (16 * ((lane >> 4) & 1) + 4 * (lane & 3)) * 2;
#pragma unroll
        for (int kt = 0; kt < 5; ++kt)
#pragma unroll
            for (int s = 0; s < 2; ++s) { asm volatile("" ::: "memory");
#pragma unroll
                for (int dt = 0; dt < 4; ++dt) { const LAS unsigned char* vp = vtr + (32 * kt + 16 * s) * VROW + 64 * dt;
                    const trv4 lo = __builtin_amdgcn_ds_read_tr16_b64_v4i16((LAS trv4*)vp), hi = __builtin_amdgcn_ds_read_tr16_b64_v4i16((LAS trv4*)(vp + 8 * VROW));
                    const bf16x8 av = (bf16x8){lo[0], lo[1], lo[2], lo[3], hi[0], hi[1], hi[2], hi[3]}; acc[dt] = MFMA32(av, pb[kt][s], acc[dt]); } }
        const float inv = 1.0f / sum;
        __syncthreads();
        { LAS unsigned char* ot = Lk + w * (32 * LROW); LAS unsigned char* op = ot + r * LROW + 8 * lh;
#pragma unroll
          for (int dt = 0; dt < 4; ++dt)
#pragma unroll
              for (int q = 0; q < 4; ++q) { v2u o; o.x = cvtpk(acc[dt][4 * q] * inv, acc[dt][4 * q + 1] * inv); o.y = cvtpk(acc[dt][4 * q + 2] * inv, acc[dt][4 * q + 3] * inv); *(LAS v2u*)(op + 64 * dt + 16 * q) = o; }
          LDS_WAIT(); asm volatile("" ::: "memory");
#pragma unroll
          for (int i4 = 0; i4 < 8; ++i4) { const int qr = 4 * i4 + (lane >> 4); const size_t mrow = (size_t)b * SEQ + (size_t)(l0 + 32 * w + qr) * dil + p;
              *(v4u*)(OGN + (size_t)g * NTOK * 1024 + mrow * 1024 + hh * 128 + (lane & 15) * 8) = *(const LAS v4u*)(ot + qr * LROW + (lane & 15) * 16); } }
        if (lh == 0) LSE[(size_t)g * NTOK * 8 + mq * 8 + hh] = mx + __logf(sum);
    }
}

constexpr int KROW = 320;
constexpr int VROW2 = 576;
__device__ __forceinline__ bf16x8 tr_frag(const LAS unsigned char* p, int step_bytes) {
    const trv4 lo = __builtin_amdgcn_ds_read_tr16_b64_v4i16((LAS trv4*)p), hi = __builtin_amdgcn_ds_read_tr16_b64_v4i16((LAS trv4*)(p + step_bytes));
    return (bf16x8){lo[0], lo[1], lo[2], lo[3], hi[0], hi[1], hi[2], hi[3]};
}
__device__ __forceinline__ void ret_phaseA3(Frame& F, bf16* UF, bf16* UB) {
    const bf16* RK = F.PROJ + PO_RK; const bf16* RV = F.PROJ + PO_RV;
    LAS unsigned char* Lv = F.lds + RING_OFF;
    LAS unsigned char* Lk2 = Lv + 128 * VROW2;
    const int tid = F.tid, lane = F.lane, r = lane & 31, lh = lane >> 5, w = F.wave;
    const int ar = (lane & 15) >> 2, ac = 16 * ((lane >> 4) & 1) + 4 * (lane & 3);
    for (int u = F.vcu; u < 512; u += F.G) {
        const int h = u & 7, m0 = (u >> 3) * 128; const float lgf = -expf(F.dec_f[h]), lgb = -expf(F.dec_b[h]);
        v4u gk[4], gv[8];
        { const bf16* kp = RK + (size_t)(m0 + (tid >> 4)) * 1024 + h * 128 + (tid & 15) * 8;
#pragma unroll
          for (int i = 0; i < 4; ++i) gk[i] = *(const v4u*)(kp + (size_t)(32 * i) * 1024);
          const bf16* vp = RV + (size_t)(m0 + (tid >> 5)) * 2048 + h * 256 + (tid & 31) * 8;
#pragma unroll
          for (int i = 0; i < 8; ++i) gv[i] = *(const v4u*)(vp + (size_t)(16 * i) * 2048); }
        BLK_SYNC();
#pragma unroll
        for (int i = 0; i < 8; ++i) *(LAS v4u*)(Lv + ((tid >> 5) + 16 * i) * VROW2 + (tid & 31) * 16) = gv[i];
        f32x16 af[4], ab[4];
#pragma unroll
        for (int dir = 0; dir < 2; ++dir) {
            if (dir) BLK_SYNC();
#pragma unroll
            for (int i = 0; i < 4; ++i) { const int j = (tid >> 4) + 32 * i; const float dc = dir ? __expf(lgb * (float)j) : __expf(lgf * (float)(127 - j)); v4u o;
                o.x = pk2(bflo(gk[i].x) * dc, bfhi(gk[i].x) * dc); o.y = pk2(bflo(gk[i].y) * dc, bfhi(gk[i].y) * dc); o.z = pk2(bflo(gk[i].z) * dc, bfhi(gk[i].z) * dc); o.w = pk2(bflo(gk[i].w) * dc, bfhi(gk[i].w) * dc);
                *(LAS v4u*)(Lk2 + j * KROW + (tid & 15) * 16) = o; }
            BLK_SYNC();
            f32x16 acc[4];
#pragma unroll
            for (int mt = 0; mt < 4; ++mt) acc[mt] = (f32x16){0};
            const LAS unsigned char* kb = Lk2 + (8 * lh + ar) * KROW + ac * 2; const LAS unsigned char* vb = Lv + (8 * lh + ar) * VROW2 + (32 * w + ac) * 2;
#pragma unroll
            for (int ks = 0; ks < 8; ++ks) { const bf16x8 bv = tr_frag(vb + 16 * ks * VROW2, 4 * VROW2);
#pragma unroll
                for (int mt = 0; mt < 4; ++mt) { const bf16x8 a = tr_frag(kb + 16 * ks * KROW + 64 * mt, 4 * KROW); acc[mt] = MFMA32(a, bv, acc[mt]); } }
#pragma unroll
            for (int mt = 0; mt < 4; ++mt) { if (dir) ab[mt] = acc[mt]; else af[mt] = acc[mt]; }
        }
        BLK_SYNC();
        LAS unsigned char* op = Lv + (32 * w + r) * LROW + 8 * lh;
#pragma unroll
        for (int mt = 0; mt < 4; ++mt)
#pragma unroll
            for (int g = 0; g < 4; ++g) { v2u o; o.x = cvtpk(af[mt][4 * g], af[mt][4 * g + 1]); o.y = cvtpk(af[mt][4 * g + 2], af[mt][4 * g + 3]); *(LAS v2u*)(op + 64 * mt + 16 * g) = o; }
        BLK_SYNC();
        tile_out<8>(UF + (size_t)u * 32768, Lv, tid);
        BLK_SYNC();
#pragma unroll
        for (int mt = 0; mt < 4; ++mt)
#pragma unroll
            for (int g = 0; g < 4; ++g) { v2u o; o.x = cvtpk(ab[mt][4 * g], ab[mt][4 * g + 1]); o.y = cvtpk(ab[mt][4 * g + 2], ab[mt][4 * g + 3]); *(LAS v2u*)(op + 64 * mt + 16 * g) = o; }
        BLK_SYNC();
        tile_out<8>(UB + (size_t)u * 32768, Lv, tid);
    }
}

__device__ __forceinline__ void ret_phaseC3(Frame& F, const bf16* SF, const bf16* SB, bf16* RETO) {
    const bf16* QR = F.PROJ + PO_RQ; const bf16* KR = F.PROJ + PO_RK; const bf16* RG = F.PROJ + PO_RG; const bf16* RV = F.PROJ + PO_RV;
    LAS unsigned char* Lq = F.lds + RING_OFF;
    LAS unsigned char* Lx = Lq + 128 * LROW;
    LAS float* red = (LAS float*)(Lx + 128 * VROW2);
    const int tid = F.tid, lane = F.lane, r = lane & 31, lh = lane >> 5, w = F.wave, it = w & 3, eh = w >> 2;
    v4u g[8];
    int u = F.vcu;
    for (; u < 512; u += F.G) {
        const int h = u & 7, m0 = (u >> 3) * 128;
        const float lgf = -expf(F.dec_f[h]), lgb = -expf(F.dec_b[h]);
        int i = 32 * it + r; asm volatile("" : "+v"(i));
        { v4u gq[4], gk[4]; tile_ld<4>(gq, QR + (size_t)m0 * 1024 + h * 128, 1024, tid); tile_ld<4>(gk, KR + (size_t)m0 * 1024 + h * 128, 1024, tid);
          tile_st<4>(gq, Lq, tid); tile_st<4>(gk, Lx, tid); }
        BLK_SYNC();
        tile_ld<8>(g, SF + (size_t)u * 32768, 128, tid);
        const LAS unsigned char* qp = Lq + i * LROW + 16 * lh;
        bf16x8 pb[4][2];
#pragma unroll
        for (int jt = 0; jt < 4; ++jt) { f32x16 st = (f32x16){0}; const LAS unsigned char* kp = Lx + (32 * jt + r) * LROW + 16 * lh;
#pragma unroll
            for (int ks = 0; ks < 8; ++ks) { const bf16x8 kf = *(const LAS bf16x8*)(kp + 32 * ks), qv = *(const LAS bf16x8*)(qp + 32 * ks); st = MFMA32(kf, qv, st); }
#pragma unroll
            for (int reg = 0; reg < 16; ++reg) { const int j = 32 * jt + (reg & 3) + 8 * (reg >> 2) + 4 * lh; const int dd = i - j;
                st[reg] *= __expf(dd >= 0 ? lgf * (float)dd : lgb * (float)(-dd)); }
#pragma unroll
            for (int s = 0; s < 2; ++s) { v4u pk; pk.x = cvtpk(st[8 * s], st[8 * s + 1]); pk.y = cvtpk(st[8 * s + 2], st[8 * s + 3]); pk.z = cvtpk(st[8 * s + 4], st[8 * s + 5]); pk.w = cvtpk(st[8 * s + 6], st[8 * s + 7]);
                pb[jt][s] = __builtin_bit_cast(bf16x8, pk); }
            asm volatile("" ::: "memory"); }
        BLK_SYNC();
        tile_st<8>(g, Lx, tid);
        BLK_SYNC();
        tile_ld<8>(g, SB + (size_t)u * 32768, 128, tid);
        f32x16 acc[4];
#pragma unroll
        for (int et = 0; et < 4; ++et) acc[et] = (f32x16){0};
        const float sfi = __expf(lgf * (float)(i + 1)), sbi = __expf(lgb * (float)(128 - i));
        const LAS unsigned char* xp = Lx + (128 * eh + r) * LROW + 16 * lh;
#pragma unroll
        for (int ks = 0; ks < 8; ++ks) {
            if ((ks & 1) == 0) asm volatile("" ::: "memory");
            const bf16x8 qv = *(const LAS bf16x8*)(qp + 32 * ks);
#pragma unroll
            for (int et = 0; et < 4; ++et) { const bf16x8 a = *(const LAS bf16x8*)(xp + et * 32 * LROW + 32 * ks); acc[et] = MFMA32(a, qv, acc[et]); } }
        { const float rt = sfi / sbi;
#pragma unroll
          for (int et = 0; et < 4; ++et) acc[et] *= rt; }
        BLK_SYNC();
        tile_st<8>(g, Lx, tid);
        BLK_SYNC();
        { const bf16* vp = RV + (size_t)(m0 + (tid >> 5)) * 2048 + h * 256 + (tid & 31) * 8;
#pragma unroll
          for (int x = 0; x < 8; ++x) g[x] = *(const v4u*)(vp + (size_t)(16 * x) * 2048); }
#pragma unroll
        for (int ks = 0; ks < 8; ++ks) {
            if ((ks & 1) == 0) asm volatile("" ::: "memory");
            const bf16x8 qv = *(const LAS bf16x8*)(qp + 32 * ks);
#pragma unroll
            for (int et = 0; et < 4; ++et) { const bf16x8 a = *(const LAS bf16x8*)(xp + et * 32 * LROW + 32 * ks); acc[et] = MFMA32(a, qv, acc[et]); } }
#pragma unroll
        for (int et = 0; et < 4; ++et) acc[et] *= sbi;
        BLK_SYNC();
#pragma unroll
        for (int x = 0; x < 8; ++x) *(LAS v4u*)(Lx + ((tid >> 5) + 16 * x) * VROW2 + (tid & 31) * 16) = g[x];
        BLK_SYNC();
        { const LAS unsigned char* vp = Lx + (4 * lh + ((lane & 15) >> 2)) * VROW2 + (128 * eh + 16 * ((lane >> 4) & 1) + 4 * (lane & 3)) * 2;
#pragma unroll
          for (int jt = 0; jt < 4; ++jt)
#pragma unroll
              for (int s = 0; s < 2; ++s) {
                  asm volatile("" ::: "memory");
#pragma unroll
                  for (int et = 0; et < 4; ++et) { const bf16x8 av = tr_frag(vp + (32 * jt + 16 * s) * VROW2 + 64 * et, 8 * VROW2); acc[et] = MFMA32(av, pb[jt][s], acc[et]); } } }
        float s1 = 0.f, s2 = 0.f;
#pragma unroll
        for (int et = 0; et < 4; ++et)
#pragma unroll
            for (int reg = 0; reg < 16; ++reg) { const float v = acc[et][reg]; s1 += v; s2 += v * v; }
        s1 += __shfl_xor(s1, 32); s2 += __shfl_xor(s2, 32);
        if (lh == 0) { red[(w * 32 + r) * 2] = s1; red[(w * 32 + r) * 2 + 1] = s2; }
        BLK_SYNC();
        { const int ow = w ^ 4; s1 += red[(ow * 32 + r) * 2]; s2 += red[(ow * 32 + r) * 2 + 1]; }
        const float mu = s1 * (1.f / 256.f), var = fmaxf(s2 * (1.f / 256.f) - mu * mu, 0.f), rstd = 1.0f / sqrtf(var + EPS);
        { LAS unsigned char* op = Lx + i * 528 + (128 * eh + 4 * lh) * 2;
#pragma unroll
          for (int et = 0; et < 4; ++et)
#pragma unroll
              for (int gq4 = 0; gq4 < 4; ++gq4) { v2u o; o.x = cvtpk((acc[et][4 * gq4] - mu) * rstd, (acc[et][4 * gq4 + 1] - mu) * rstd); o.y = cvtpk((acc[et][4 * gq4 + 2] - mu) * rstd, (acc[et][4 * gq4 + 3] - mu) * rstd);
                  *(LAS v2u*)(op + (32 * et + 8 * gq4) * 2) = o; } }
        BLK_SYNC();
        { const int c8 = (tid & 31) * 8; const f32x4 g0 = *(const f32x4*)(F.gn_g + h * 256 + c8), g1 = *(const f32x4*)(F.gn_g + h * 256 + c8 + 4);
#pragma unroll
          for (int p8 = 0; p8 < 8; ++p8) { const int row = 16 * p8 + (tid >> 5); const size_t go = (size_t)(m0 + row) * 2048 + h * 256 + c8;
              const v4u x = *(const LAS v4u*)(Lx + row * 528 + c8 * 2), rg = *(const v4u*)(RG + go); v4u o;
              o.x = pk2(bflo(x.x) * g0.x * bflo(rg.x), bfhi(x.x) * g0.y * bfhi(rg.x)); o.y = pk2(bflo(x.y) * g0.z * bflo(rg.y), bfhi(x.y) * g0.w * bfhi(rg.y));
              o.z = pk2(bflo(x.z) * g1.x * bflo(rg.z), bfhi(x.z) * g1.y * bfhi(rg.z)); o.w = pk2(bflo(x.w) * g1.z * bflo(rg.w), bfhi(x.w) * g1.w * bfhi(rg.w));
              *(v4u*)(RETO + go) = o; } }
        BLK_SYNC();
    }
}

typedef int v4i __attribute__((ext_vector_type(4)));
typedef int v16i __attribute__((ext_vector_type(16)));
__device__ __forceinline__ unsigned q4(f32x4 v, float inv, int zp) {
    const int a = (int)rintf(v.x * inv) + zp, b = (int)rintf(v.y * inv) + zp, c = (int)rintf(v.z * inv) + zp, d = (int)rintf(v.w * inv) + zp;
    return (unsigned)(a & 255) | ((unsigned)(b & 255) << 8) | ((unsigned)(c & 255) << 16) | ((unsigned)(d & 255) << 24);
}
__device__ __forceinline__ void conv_tab8(const float* srcT, unsigned char* dst, float* SC, int wv, int nw, int lane) {
#pragma unroll 2
    for (int e = wv; e < NEXP; e += nw) { const f32x4* src = (const f32x4*)(srcT + (size_t)e * DM) + lane;
        f32x4 v[8]; float m = 0.f;
#pragma unroll
        for (int j = 0; j < 8; ++j) { v[j] = __builtin_nontemporal_load(src + 64 * j); m = fmaxf(m, fmaxf(fmaxf(fabsf(v[j].x), fabsf(v[j].y)), fmaxf(fabsf(v[j].z), fabsf(v[j].w)))); }
        m = wave_max(m); const float sc = (m > 0.f) ? m * (1.0f / 127.0f) : 1.0f, inv = 1.0f / sc;
#pragma unroll
        for (int j = 0; j < 8; ++j) *(unsigned*)(dst + ((size_t)j * NEXP + e) * 256 + 4 * lane) = q4(v[j], inv, 0);
        if (lane == 0) SC[e] = sc; }
}
__device__ __forceinline__ int mbcnt64(unsigned long long m) { return __builtin_amdgcn_mbcnt_hi((unsigned)(m >> 32), __builtin_amdgcn_mbcnt_lo((unsigned)m, 0u)); }
__device__ __forceinline__ void peer_sort_pos(int elo, int ehi, int& plo, int& phi) {
    int off = 0, pl = 0, ph = 0; const int rl = elo >> 12, rh = ehi >> 12;
#pragma unroll
    for (int r = 0; r < 4; ++r) { const unsigned long long ml = __ballot(rl == r), mh = __ballot(rh == r);
        const int cl = __builtin_popcountll(ml), ch = __builtin_popcountll(mh); const int bl = off + mbcnt64(ml), bh = off + cl + mbcnt64(mh);
        pl = (rl == r) ? bl : pl; ph = (rh == r) ? bh : ph; off += cl + ch; }
    plo = pl; phi = ph;
}

template <int CTRL> __device__ __forceinline__ int dppi(int x) { return __builtin_amdgcn_mov_dpp(x, CTRL, 0xf, 0xf, true); }
__device__ __forceinline__ int row_sum16(int x) { x += dppi<0xB1>(x); x += dppi<0x4E>(x); x += dppi<0x141>(x); x += dppi<0x128>(x); return x; }

__device__ __forceinline__ void peerUv_fetch(v4u (&ld)[8], float& su, int& kk, const LAS int* sl, const unsigned char* Us, const float* SU, int c, int sub) {
#pragma unroll
    for (int i = 0; i < 8; ++i) { const int e = sl[4 * i + sub] & 16383; ld[i] = *(const v4u*)(Us + (size_t)e * 256 + 16 * c); }
    const int ent = sl[4 * (c & 7) + sub]; kk = ent >> 14; su = SU[ent & 16383];
}
__device__ __forceinline__ void peerUv_consume(const v4u (&ld)[8], const v4u h, float su, int kk, float sh, float* prow, int c) {
    int res = 0;
#pragma unroll
    for (int i = 0; i < 8; ++i) { int d = __builtin_amdgcn_sdot4((int)ld[i].x, (int)h.x, 0, false); d = __builtin_amdgcn_sdot4((int)ld[i].y, (int)h.y, d, false);
        d = __builtin_amdgcn_sdot4((int)ld[i].z, (int)h.z, d, false); d = __builtin_amdgcn_sdot4((int)ld[i].w, (int)h.w, d, false);
        d = row_sum16(d); res = (c == i) ? d : res; }
    if (c < 8) prow[kk] = (float)res * su * sh;
}
__device__ __forceinline__ void peer_U8v(Frame& F, const bf16* H2u, const unsigned long long* RSQ, const unsigned* RMX, const unsigned char* U8, const float* SU, float* PART) {
    const int s = blockIdx.x & 7, rho = blockIdx.x >> 3, nrho = F.G >> 3, TPW = NTOK / nrho, rounds = TPW / 64;
    const int lane = F.lane, c = lane & 15, sub = lane >> 4;
    const unsigned char* Us = U8 + (size_t)s * NEXP * 256; float* PARTs = PART + (size_t)s * NTOK * 128;
    LAS int* slist = (LAS int*)(F.lds + RING_OFF) + F.wave * 1024;
    for (int rd = 0; rd < rounds; ++rd) {
        const int tb = rho * TPW + rd * 64 + F.wave * 8;
        v4u hq[8]; float sh[8];
#pragma unroll
        for (int tt = 0; tt < 8; ++tt) { const size_t o = (size_t)(tb + tt) * 128 + lane; const int elo = F.EIDX[o], ehi = F.EIDX[o + 64]; int plo, phi; peer_sort_pos(elo, ehi, plo, phi);
            slist[tt * 128 + plo] = elo | (lane << 14); slist[tt * 128 + phi] = ehi | ((64 + lane) << 14);
            { const float rmx = __uint_as_float(RMX[tb + tt]), sc = (rmx > 0.f) ? rmx * (1.0f / 127.0f) : 1.0f, inv = 1.0f / sc;
              const bf16* hp = H2u + (size_t)(tb + tt) * DM + 256 * s + 16 * c; const v4u w0 = *(const v4u*)hp, w1 = *(const v4u*)(hp + 8);
              f32x4 f0 = {bflo(w0.x), bfhi(w0.x), bflo(w0.y), bfhi(w0.y)}, f1 = {bflo(w0.z), bfhi(w0.z), bflo(w0.w), bfhi(w0.w)}, f2 = {bflo(w1.x), bfhi(w1.x), bflo(w1.y), bfhi(w1.y)}, f3 = {bflo(w1.z), bfhi(w1.z), bflo(w1.w), bfhi(w1.w)};
              v4u hv; hv.x = q4(f0, inv, 0); hv.y = q4(f1, inv, 0); hv.z = q4(f2, inv, 0); hv.w = q4(f3, inv, 0); hq[tt] = hv;
              sh[tt] = sc / sqrtf((float)RSQ[tb + tt] * (1.0f / (2048.0f * 16777216.0f)) + EPS); } }
        LDS_WAIT(); asm volatile("" ::: "memory");
        const int qx = (rd & 1) ? 3 : 0;
        v4u lA[8], lB[8]; float suA, suB; int kA, kB;
#define PU_F(L, S_, K_, qq_, tt_) peerUv_fetch(L, S_, K_, slist + (tt_) * 128 + 32 * (((qq_) & 3) ^ qx), Us, SU, c, sub)
#define PU_C(L, S_, K_, tt_) peerUv_consume(L, hq[tt_], S_, K_, sh[tt_], PARTs + (size_t)(tb + (tt_)) * 128, c)
        PU_F(lA, suA, kA, 0, 0);
#pragma unroll 1
        for (int qq = 0; qq < 4; ++qq) {
            PU_F(lB, suB, kB, qq, 1); PU_C(lA, suA, kA, 0);
            PU_F(lA, suA, kA, qq, 2); PU_C(lB, suB, kB, 1);
            PU_F(lB, suB, kB, qq, 3); PU_C(lA, suA, kA, 2);
            PU_F(lA, suA, kA, qq, 4); PU_C(lB, suB, kB, 3);
            PU_F(lB, suB, kB, qq, 5); PU_C(lA, suA, kA, 4);
            PU_F(lA, suA, kA, qq, 6); PU_C(lB, suB, kB, 5);
            PU_F(lB, suB, kB, qq, 7); PU_C(lA, suA, kA, 6);
            PU_F(lA, suA, kA, qq + 1, 0); PU_C(lB, suB, kB, 7);
        }
#undef PU_F
#undef PU_C
        LDS_WAIT(); asm volatile("" ::: "memory");
    }
}

__device__ __forceinline__ void tr4(unsigned a, unsigned b, unsigned c, unsigned d, unsigned& o0, unsigned& o1, unsigned& o2, unsigned& o3) {
    const unsigned t0 = __builtin_amdgcn_perm(a, b, 0x01050004u), t1 = __builtin_amdgcn_perm(a, b, 0x03070206u);
    const unsigned t2 = __builtin_amdgcn_perm(c, d, 0x01050004u), t3 = __builtin_amdgcn_perm(c, d, 0x03070206u);
    o0 = __builtin_amdgcn_perm(t0, t2, 0x01000504u); o1 = __builtin_amdgcn_perm(t0, t2, 0x03020706u);
    o2 = __builtin_amdgcn_perm(t1, t3, 0x01000504u); o3 = __builtin_amdgcn_perm(t1, t3, 0x03020706u);
}
__device__ __forceinline__ void peerVd_consume(int (&acc)[16], const v4u (&ld)[8], const unsigned (&wq)[2]) {
#pragma unroll
    for (int blk = 0; blk < 2; ++blk) { const int w = (int)wq[blk]; unsigned t[4];
        tr4(ld[4 * blk].x, ld[4 * blk + 1].x, ld[4 * blk + 2].x, ld[4 * blk + 3].x, t[0], t[1], t[2], t[3]);
#pragma unroll
        for (int j = 0; j < 4; ++j) acc[j] = __builtin_amdgcn_sdot4((int)t[j], w, acc[j], false);
        tr4(ld[4 * blk].y, ld[4 * blk + 1].y, ld[4 * blk + 2].y, ld[4 * blk + 3].y, t[0], t[1], t[2], t[3]);
#pragma unroll
        for (int j = 0; j < 4; ++j) acc[4 + j] = __builtin_amdgcn_sdot4((int)t[j], w, acc[4 + j], false);
        tr4(ld[4 * blk].z, ld[4 * blk + 1].z, ld[4 * blk + 2].z, ld[4 * blk + 3].z, t[0], t[1], t[2], t[3]);
#pragma unroll
        for (int j = 0; j < 4; ++j) acc[8 + j] = __builtin_amdgcn_sdot4((int)t[j], w, acc[8 + j], false);
        tr4(ld[4 * blk].w, ld[4 * blk + 1].w, ld[4 * blk + 2].w, ld[4 * blk + 3].w, t[0], t[1], t[2], t[3]);
#pragma unroll
        for (int j = 0; j < 4; ++j) acc[12 + j] = __builtin_amdgcn_sdot4((int)t[j], w, acc[12 + j], false); }
}
__device__ __forceinline__ void peer_actw(Frame& F, const float* PART, const float* SV, unsigned short* SE16, unsigned char* SWB, float* SWT) {
    const int gw = F.vcu * NWAVES + F.wave, NGW = F.G * NWAVES, lane = F.lane;
#pragma unroll 2
    for (int t = gw; t < NTOK; t += NGW) { const size_t o = (size_t)t * 128 + lane; const int elo = F.EIDX[o], ehi = F.EIDX[o + 64];
        float a0 = 0.f, a1 = 0.f;
#pragma unroll
        for (int sp = 0; sp < 8; ++sp) { a0 += PART[(size_t)sp * NTOK * 128 + o]; a1 += PART[(size_t)sp * NTOK * 128 + o + 64]; }
        a0 = 0.5f * a0 * (1.0f + erff(a0 * 0.70710678118654752f)) * F.GATE[o] * SV[elo]; a1 = 0.5f * a1 * (1.0f + erff(a1 * 0.70710678118654752f)) * F.GATE[o + 64] * SV[ehi];
        const float wm = wave_max(fmaxf(fabsf(a0), fabsf(a1))); const float sc = (wm > 0.f) ? wm * (1.0f / 127.0f) : 1.0f, inv = 1.0f / sc;
        const int q0 = (int)rintf(a0 * inv), q1 = (int)rintf(a1 * inv);
        int plo, phi; peer_sort_pos(elo, ehi, plo, phi);
        SE16[(size_t)t * 128 + plo] = (unsigned short)elo; SE16[(size_t)t * 128 + phi] = (unsigned short)ehi;
        SWB[(size_t)t * 128 + (plo >> 4) * 16 + (plo & 3) * 4 + ((plo >> 2) & 3)] = (unsigned char)q0; SWB[(size_t)t * 128 + (phi >> 4) * 16 + (phi & 3) * 4 + ((phi >> 2) & 3)] = (unsigned char)q1;
        if (lane == 0) SWT[t] = sc; }
}
__device__ __forceinline__ float xsum4(float x) {
    { auto r = __builtin_amdgcn_permlane16_swap(__float_as_uint(x), __float_as_uint(x), false, false); x = __uint_as_float(r[0]) + __uint_as_float(r[1]); }
    { auto r = __builtin_amdgcn_permlane32_swap(__float_as_uint(x), __float_as_uint(x), false, false); x = __uint_as_float(r[0]) + __uint_as_float(r[1]); }
    return x;
}
__device__ __forceinline__ void peerVe_fetch(v4u (&ld)[8], unsigned (&wq)[2], const LAS unsigned short* se, const LAS unsigned* swq, const unsigned char* Vs, int c, int sub) {
#pragma unroll
    for (int i = 0; i < 8; ++i) { const int e = se[4 * i + sub]; ld[i] = *(const v4u*)(Vs + (size_t)e * 256 + 16 * c); }
    wq[0] = swq[sub]; wq[1] = swq[4 + sub];
}
__device__ __forceinline__ void peer_V8d(Frame& F, const float* X1, const unsigned char* V8, const unsigned short* SE16, const unsigned char* SWB, const float* SWT) {
    const int s = blockIdx.x & 7, rho = blockIdx.x >> 3, nrho = F.G >> 3, TPW = NTOK / nrho, rounds = TPW / 32;
    const int lane = F.lane, c = lane & 15, sub = lane >> 4;
    const unsigned char* Vs = V8 + (size_t)s * NEXP * 256;
    LAS unsigned short* sle = (LAS unsigned short*)(F.lds + RING_OFF + F.wave * 1536);
    LAS unsigned char* swb = (LAS unsigned char*)(sle + 512);
    for (int rd = 0; rd < rounds; ++rd) {
        const int tb = rho * TPW + rd * 32 + F.wave * 4;
        int acc[4][16]; float swt[4];
#pragma unroll
        for (int tt = 0; tt < 4; ++tt) { *(LAS unsigned*)(sle + tt * 128 + 2 * lane) = *(const unsigned*)(SE16 + (size_t)(tb + tt) * 128 + 2 * lane);
            if (lane < 32) *(LAS unsigned*)(swb + tt * 128 + 4 * lane) = *(const unsigned*)(SWB + (size_t)(tb + tt) * 128 + 4 * lane);
            swt[tt] = SWT[tb + tt];
#pragma unroll
            for (int k = 0; k < 16; ++k) acc[tt][k] = 0; }
        LDS_WAIT(); asm volatile("" ::: "memory");
        const int qx = (rd & 1) ? 3 : 0;
        v4u lA[8], lB[8]; unsigned wA[2], wB[2];
#define PV_F(L, Wt, qq_, tt_) peerVe_fetch(L, Wt, sle + (tt_) * 128 + 32 * (((qq_) & 3) ^ qx), (const LAS unsigned*)(swb + (tt_) * 128 + 32 * (((qq_) & 3) ^ qx)), Vs, c, sub)
        PV_F(lA, wA, 0, 0);
#pragma unroll 1
        for (int qq = 0; qq < 4; ++qq) {
            PV_F(lB, wB, qq, 1); peerVd_consume(acc[0], lA, wA);
            PV_F(lA, wA, qq, 2); peerVd_consume(acc[1], lB, wB);
            PV_F(lB, wB, qq, 3); peerVd_consume(acc[2], lA, wA);
            PV_F(lA, wA, qq + 1, 0); peerVd_consume(acc[3], lB, wB);
        }
#undef PV_F
#pragma unroll
        for (int tt = 0; tt < 4; ++tt) { float f[16];
#pragma unroll
            for (int k = 0; k < 16; ++k) f[k] = xsum4((float)acc[tt][k] * swt[tt]);
            if (sub == 0) { const size_t oo = (size_t)(tb + tt) * DM + 256 * s + 16 * c;
#pragma unroll
                for (int k4 = 0; k4 < 4; ++k4) { f32x4 o = *(const f32x4*)(X1 + oo + 4 * k4); o.x += f[4 * k4]; o.y += f[4 * k4 + 1]; o.z += f[4 * k4 + 2]; o.w += f[4 * k4 + 3]; *(f32x4*)(F.out + oo + 4 * k4) = o; } } }
        LDS_WAIT(); asm volatile("" ::: "memory");
    }
}


__device__ __forceinline__ int ord_i(float x) { const int b = __builtin_bit_cast(int, x); return b ^ ((b >> 31) & 0x7fffffff); }
__device__ __forceinline__ float ord_f(int k) { return __builtin_bit_cast(float, k ^ ((k >> 31) & 0x7fffffff)); }
__device__ __forceinline__ int imax3(int a, int b, int c) { int r; asm("v_max3_i32 %0, %1, %2, %3" : "=v"(r) : "v"(a), "v"(b), "v"(c)); return r; }
constexpr int TK_MIN = (int)0x80000000;
__device__ __forceinline__ void topk_phase(Frame& F, const bf16* QH, const bf16* QL, const bf16* SKH, const bf16* SKL) {
    const int tid = F.tid, lane = F.lane, r = lane & 31, lh = lane >> 5;
    LAS unsigned char* Lkh = F.lds + RING_OFF;
    LAS unsigned char* Lkl = Lkh + 128 * LROW;
    LAS int* top = (LAS int*)(Lkl + 128 * LROW) + F.wave * 1536;
    LAS int* best = top + 1024;
    for (int task = F.vcu; task < 8 * (NTOK / 256); task += F.G) {
        const int h = task & 7, t0 = ((task >> 3) * 8 + F.wave) * 32;
#pragma unroll 1
        for (int hf = 0; hf < 2; ++hf) {
            __syncthreads();
            { v4u gh[4], gl[4]; tile_ld<4>(gh, SKH + (size_t)(h * 2 + hf) * 16384, 128, tid); tile_ld<4>(gl, SKL + (size_t)(h * 2 + hf) * 16384, 128, tid); tile_st<4>(gh, Lkh, tid); tile_st<4>(gl, Lkl, tid); }
            bf16x8 qh[8], ql[8];
            { const size_t o = (size_t)(t0 + r) * DM + h * 256 + hf * 128 + 8 * lh;
#pragma unroll
              for (int ks = 0; ks < 8; ++ks) { qh[ks] = *(const bf16x8*)(QH + o + 16 * ks); ql[ks] = *(const bf16x8*)(QL + o + 16 * ks); } }
            __syncthreads();
            int pk[64];
#pragma unroll
            for (int kt = 0; kt < 4; ++kt) { f32x16 a = (f32x16){0}; const int ko = (32 * kt + r) * LROW + 16 * lh;
#pragma unroll
                for (int ks = 0; ks < 8; ++ks) { const bf16x8 kh = *(const LAS bf16x8*)(Lkh + ko + 32 * ks), kl = *(const LAS bf16x8*)(Lkl + ko + 32 * ks);
                    a = MFMA32(kl, qh[ks], a); a = MFMA32(kh, ql[ks], a); a = MFMA32(kh, qh[ks], a); }
#pragma unroll
                for (int reg = 0; reg < 16; ++reg) { const int key = 32 * kt + (reg & 3) + 8 * (reg >> 2) + 4 * lh; pk[16 * kt + reg] = (ord_i(a[reg]) & ~127) | (127 - key); }
                asm volatile("" ::: "memory"); }
#pragma unroll 1
            for (int it = 0; it < 16; ++it) {
                int m = imax3(pk[0], pk[1], pk[2]);
#pragma unroll
                for (int i = 3; i < 63; i += 2) m = imax3(m, pk[i], pk[i + 1]);
                m = max(m, pk[63]);
                const int o = __shfl_xor(m, 32); const int W = max(m, o);
                if (lh == 0) top[(hf * 16 + it) * 32 + r] = W;
#pragma unroll
                for (int i = 0; i < 64; ++i) pk[i] = (pk[i] == W) ? TK_MIN : pk[i];
            }
        }
        LDS_WAIT(); asm volatile("" ::: "memory");
        float v1[16], v2[16];
#pragma unroll
        for (int a = 0; a < 16; ++a) { v1[a] = ord_f(top[a * 32 + r] & ~127); v2[a] = ord_f(top[(16 + a) * 32 + r] & ~127); }
        int cp[25];
        { const float s0 = v1[0] + v2[0], s1 = v1[0] + v2[1]; const int c0 = (ord_i(s0) & ~255) | 255, c1 = (ord_i(s1) & ~255) | 254; cp[0] = lh ? c1 : c0; }
        { const float s0 = v1[0] + v2[2], s1 = v1[0] + v2[3]; const int c0 = (ord_i(s0) & ~255) | 253, c1 = (ord_i(s1) & ~255) | 252; cp[1] = lh ? c1 : c0; }
        { const float s0 = v1[0] + v2[4], s1 = v1[0] + v2[5]; const int c0 = (ord_i(s0) & ~255) | 251, c1 = (ord_i(s1) & ~255) | 250; cp[2] = lh ? c1 : c0; }
        { const float s0 = v1[0] + v2[6], s1 = v1[0] + v2[7]; const int c0 = (ord_i(s0) & ~255) | 249, c1 = (ord_i(s1) & ~255) | 248; cp[3] = lh ? c1 : c0; }
        { const float s0 = v1[0] + v2[8], s1 = v1[0] + v2[9]; const int c0 = (ord_i(s0) & ~255) | 247, c1 = (ord_i(s1) & ~255) | 246; cp[4] = lh ? c1 : c0; }
        { const float s0 = v1[0] + v2[10], s1 = v1[0] + v2[11]; const int c0 = (ord_i(s0) & ~255) | 245, c1 = (ord_i(s1) & ~255) | 244; cp[5] = lh ? c1 : c0; }
        { const float s0 = v1[0] + v2[12], s1 = v1[0] + v2[13]; const int c0 = (ord_i(s0) & ~255) | 243, c1 = (ord_i(s1) & ~255) | 242; cp[6] = lh ? c1 : c0; }
        { const float s0 = v1[0] + v2[14], s1 = v1[0] + v2[15]; const int c0 = (ord_i(s0) & ~255) | 241, c1 = (ord_i(s1) & ~255) | 240; cp[7] = lh ? c1 : c0; }
        { const float s0 = v1[1] + v2[0], s1 = v1[1] + v2[1]; const int c0 = (ord_i(s0) & ~255) | 239, c1 = (ord_i(s1) & ~255) | 238; cp[8] = lh ? c1 : c0; }
        { const float s0 = v1[1] + v2[2], s1 = v1[1] + v2[3]; const int c0 = (ord_i(s0) & ~255) | 237, c1 = (ord_i(s1) & ~255) | 236; cp[9] = lh ? c1 : c0; }
        { const float s0 = v1[1] + v2[4], s1 = v1[1] + v2[5]; const int c0 = (ord_i(s0) & ~255) | 235, c1 = (ord_i(s1) & ~255) | 234; cp[10] = lh ? c1 : c0; }
        { const float s0 = v1[1] + v2[6], s1 = v1[1] + v2[7]; const int c0 = (ord_i(s0) & ~255) | 233, c1 = (ord_i(s1) & ~255) | 232; cp[11] = lh ? c1 : c0; }
        { const float s0 = v1[2] + v2[0], s1 = v1[2] + v2[1]; const int c0 = (ord_i(s0) & ~255) | 223, c1 = (ord_i(s1) & ~255) | 222; cp[12] = lh ? c1 : c0; }
        { const float s0 = v1[2] + v2[2], s1 = v1[2] + v2[3]; const int c0 = (ord_i(s0) & ~255) | 221, c1 = (ord_i(s1) & ~255) | 220; cp[13] = lh ? c1 : c0; }
        { const float s0 = v1[2] + v2[4], s1 = v1[3] + v2[0]; const int c0 = (ord_i(s0) & ~255) | 219, c1 = (ord_i(s1) & ~255) | 207; cp[14] = lh ? c1 : c0; }
        { const float s0 = v1[3] + v2[1], s1 = v1[3] + v2[2]; const int c0 = (ord_i(s0) & ~255) | 206, c1 = (ord_i(s1) & ~255) | 205; cp[15] = lh ? c1 : c0; }
        { const float s0 = v1[3] + v2[3], s1 = v1[4] + v2[0]; const int c0 = (ord_i(s0) & ~255) | 204, c1 = (ord_i(s1) & ~255) | 191; cp[16] = lh ? c1 : c0; }
        { const float s0 = v1[4] + v2[1], s1 = v1[4] + v2[2]; const int c0 = (ord_i(s0) & ~255) | 190, c1 = (ord_i(s1) & ~255) | 189; cp[17] = lh ? c1 : c0; }
        { const float s0 = v1[5] + v2[0], s1 = v1[5] + v2[1]; const int c0 = (ord_i(s0) & ~255) | 175, c1 = (ord_i(s1) & ~255) | 174; cp[18] = lh ? c1 : c0; }
        { const float s0 = v1[6] + v2[0], s1 = v1[6] + v2[1]; const int c0 = (ord_i(s0) & ~255) | 159, c1 = (ord_i(s1) & ~255) | 158; cp[19] = lh ? c1 : c0; }
        { const float s0 = v1[7] + v2[0], s1 = v1[7] + v2[1]; const int c0 = (ord_i(s0) & ~255) | 143, c1 = (ord_i(s1) & ~255) | 142; cp[20] = lh ? c1 : c0; }
        { const float s0 = v1[8] + v2[0], s1 = v1[9] + v2[0]; const int c0 = (ord_i(s0) & ~255) | 127, c1 = (ord_i(s1) & ~255) | 111; cp[21] = lh ? c1 : c0; }
        { const float s0 = v1[10] + v2[0], s1 = v1[11] + v2[0]; const int c0 = (ord_i(s0) & ~255) | 95, c1 = (ord_i(s1) & ~255) | 79; cp[22] = lh ? c1 : c0; }
        { const float s0 = v1[12] + v2[0], s1 = v1[13] + v2[0]; const int c0 = (ord_i(s0) & ~255) | 63, c1 = (ord_i(s1) & ~255) | 47; cp[23] = lh ? c1 : c0; }
        { const float s0 = v1[14] + v2[0], s1 = v1[15] + v2[0]; const int c0 = (ord_i(s0) & ~255) | 31, c1 = (ord_i(s1) & ~255) | 15; cp[24] = lh ? c1 : c0; }
#pragma unroll 1
        for (int it = 0; it < 16; ++it) {
            int m = imax3(cp[0], cp[1], cp[2]);
#pragma unroll
            for (int i = 3; i < 25; i += 2) m = imax3(m, cp[i], cp[i + 1]);
            const int o = __shfl_xor(m, 32); const int W = max(m, o);
            if (lh == 0) best[it * 32 + r] = W;
#pragma unroll
            for (int i = 0; i < 25; ++i) cp[i] = (cp[i] == W) ? TK_MIN : cp[i];
        }
        LDS_WAIT(); asm volatile("" ::: "memory");
        float bv[16]; int bp[16];
#pragma unroll
        for (int it = 0; it < 16; ++it) { const int W = best[it * 32 + r]; bv[it] = ord_f(W & ~255); bp[it] = 255 - (W & 255); }
        float den = 0.f, ex[16];
#pragma unroll
        for (int it = 0; it < 16; ++it) { ex[it] = __expf(bv[it] - bv[0]); den += ex[it]; }
        const float inv = 1.0f / den;
        int* ei = F.EIDX + (size_t)(t0 + r) * 128 + h * 16 + 8 * lh; float* go = F.GATE + (size_t)(t0 + r) * 128 + h * 16 + 8 * lh;
        int eo[8]; float gv[8];
#pragma unroll
        for (int j = 0; j < 8; ++j) { const int pA = bp[j], pB = bp[8 + j]; const int p = lh ? pB : pA;
            const int e1 = 127 - (top[(p >> 4) * 32 + r] & 127), e2 = 127 - (top[(16 + (p & 15)) * 32 + r] & 127);
            eo[j] = e1 * 128 + e2; gv[j] = (lh ? ex[8 + j] : ex[j]) * inv; }
        { v4u w; w.x = eo[0]; w.y = eo[1]; w.z = eo[2]; w.w = eo[3]; *(v4u*)ei = w; w.x = eo[4]; w.y = eo[5]; w.z = eo[6]; w.w = eo[7]; *(v4u*)(ei + 4) = w;
          f32x4 g; g.x = gv[0]; g.y = gv[1]; g.z = gv[2]; g.w = gv[3]; *(f32x4*)go = g; g.x = gv[4]; g.y = gv[5]; g.z = gv[6]; g.w = gv[7]; *(f32x4*)(go + 4) = g; }
        LDS_WAIT(); asm volatile("" ::: "memory");
    }
}
struct Args { const float* in[16]; float* out; unsigned char* ws; int ph_lo, ph_hi, li, pad; };
__global__ void __launch_bounds__(NWAVES * 64, 2) layer_fwd(Args args) {
    extern __shared__ __attribute__((aligned(16))) unsigned char lds[];
    Frame F;
    F.lds = (LAS unsigned char*)lds;
    F.MISC = (volatile LAS unsigned*)(F.lds + MISC_OFF);
    F.tid = threadIdx.x; F.lane = F.tid & 63; F.wave = __builtin_amdgcn_readfirstlane(F.tid >> 6);
    F.G = gridDim.x; { const int bx = blockIdx.x; F.vcu = (F.G % 8 == 0) ? (bx % 8) * (F.G / 8) + bx / 8 : bx; }
    unsigned char* ws = args.ws;
    F.ctl = (gu32*)(ws + WS_CTL);
    F.x = args.in[0]; F.mix_g = args.in[1]; F.w_in = args.in[2]; F.dec_f = args.in[3]; F.dec_b = args.in[4]; F.gn_g = args.in[5]; F.w_ret = args.in[6]; F.qn_g = args.in[7];
    F.kn_g = args.in[8]; F.w_att = args.in[9]; F.w_out = args.in[10]; F.ffn_g = args.in[11]; F.w_pq = args.in[12]; F.subk = args.in[13]; F.pu = args.in[14]; F.pv = args.in[15];
    F.out = args.out;
    F.WinT = (bf16*)(ws + WS_WINT); F.WretT = (bf16*)(ws + WS_WRET); F.WattT = (bf16*)(ws + WS_WATT); F.WoutT = (bf16*)(ws + WS_WOUT); F.WqT = (bf16*)(ws + WS_WQ);
    F.XN = (bf16*)(ws + WS_XN); F.PROJ = (bf16*)(ws + WS_PROJ); F.Ubf = (bf16*)(ws + WS_UBF); F.Vbf = (bf16*)(ws + WS_VBF); F.ATT = (bf16*)(ws + WS_ATT);
    F.EIDX = (int*)(ws + WS_EIDX); F.GATE = (float*)(ws + WS_GATE); F.RTAB = (f32x2*)(ws + WS_RTAB); F.ATAB = (f32x2*)(ws + WS_ATAB); F.SKH = (bf16*)(ws + WS_SKH); F.SKL = (bf16*)(ws + WS_SKL);
    bf16* KDF = (bf16*)(ws + WS_WINT); bf16* KDB = KDF + (size_t)512 * 16384; bf16* VT = (bf16*)(ws + WS_WINT + 32 * MiB);
    bf16* UF = F.XN; bf16* UB = (bf16*)(ws + WS_WINT + 32 * MiB);
    bf16* OGN = (bf16*)(ws + WS_UBF + 64 * MiB); float* LSE = (float*)(ws + WS_WINT + 64 * MiB);
    bf16* RETO = KDF;
    bf16* MERGED = F.PROJ + PO_RQ;
    bf16* H2 = F.PROJ + PO_RV;
    float* TMP = (float*)(F.PROJ + PO_AK);
    bf16* QH = (bf16*)TMP; bf16* QL = QH + (size_t)NTOK * DM;
    float* X1 = (float*)(F.PROJ + PO_GR);
    unsigned char* U8 = ws + WS_UBF; unsigned char* V8 = ws + WS_UBF + 32 * MiB; float* SU = (float*)(ws + WS_SU); float* SV = SU + NEXP;
    unsigned long long* RSQ = (unsigned long long*)(SV + NEXP); unsigned* RMX = (unsigned*)(RSQ + NTOK);
    unsigned short* SE16 = (unsigned short*)(ws + WS_WINT); unsigned char* SWB = ws + WS_WINT + 2 * MiB; float* SWT = (float*)(ws + WS_WINT + 3 * MiB);
    unsigned long long* SSQ = (unsigned long long*)(ws + WS_UBF + 112 * MiB);
    float* PART = (float*)(ws + WS_WINT + 32 * MiB);
    for (int u = F.tid; u < (LDS_BYTES - LDSCTL_OFF) / 4; u += NWAVES * 64) ((LAS unsigned*)(F.lds + LDSCTL_OFF))[u] = 0u;
    __syncthreads();
    XcdBarrier bar; bar.bar = (unsigned*)(F.ctl + CW_BAR); bar.x = 0; bar.st = nullptr;
    if (N_LAUNCHES == 1) bar = xcd_barrier_post((unsigned*)(F.ctl + CW_BAR), F.MISC + 8);
#define GRID_BAR() do { if (N_LAUNCHES == 1) xcd_barrier(bar); } while (0)
    const int lo = args.ph_lo, hi = args.ph_hi;
#define IN(k) (lo <= (k) && (k) < hi)
#define BOTH(k) (IN(k) && IN((k) + 1))
    if (IN(0)) { { for (int z_ = F.vcu * 512 + F.tid; z_ < 2 * NTOK * 24; z_ += F.G * 512) SSQ[z_] = 0ull; for (int z_ = F.vcu * 512 + F.tid; z_ < NTOK; z_ += F.G * 512) { RSQ[z_] = 0ull; RMX[z_] = 0u; } p0_prologue(F); VM_WAIT(); __syncthreads(); } if (BOTH(0)) GRID_BAR(); }
    if (IN(1)) { { pg8::Gemm g{F.XN, F.WinT, NTOK, INW, DM}; pg8::StaticOrder S; S.init(NTOK, INW, F.G, (int)blockIdx.x);
        pg8::EpiProj E{F.PROJ, SSQ, (const float*)F.RTAB};
        pg8::gemm_phase<pg8::EpiProj, pg8::StaticOrder, PG8_ALIGN, PG8_SP2, true>(F.lds + RING_OFF, g, S, E);
        { const int nfull = (NTOK / 256) * (INW / 256) % F.G; int wv = F.vcu * NWAVES + F.wave, nw = F.G * NWAVES; bool go = (nfull == 0);
          if (nfull > 0 && (int)blockIdx.x >= nfull) { wv = ((int)blockIdx.x - nfull) * NWAVES + F.wave; nw = (F.G - nfull) * NWAVES; go = true; }
          if (go) { conv_tab8(F.pu, U8, SU, wv, nw, F.lane); conv_tab8(F.pv, V8, SV, wv, nw, F.lane); } }
        } if (BOTH(1)) GRID_BAR(); }
    if (IN(3)) { { ret_phaseA3(F, UF, UB); att_phase3(F, OGN, LSE, SSQ); } if (BOTH(3)) GRID_BAR(); }
    if (IN(4)) { { ret_phaseB(F, UF, UB); att_merge(F, OGN, LSE); } if (BOTH(4)) GRID_BAR(); }
    if (IN(5)) { { ret_phaseC3(F, UF, UB, RETO); } if (BOTH(5)) GRID_BAR(); }
    if (IN(6)) { { pg8::Gemm g{RETO, F.WretT, NTOK, DM, DM}; pg8::StaticOrder S; S.init(NTOK, DM, F.G, (int)blockIdx.x);
        pg8::EpiGateF32 E{TMP, F.PROJ + PO_GR, DM};
        pg8::gemm_phase<pg8::EpiGateF32, pg8::StaticOrder, PG8_ALIGN, PG8_SP2>(F.lds + RING_OFF, g, S, E);
        } VM_WAIT(); __syncthreads(); }
    if (IN(7)) { { pg8::Gemm g{F.ATT, F.WattT, NTOK, DM, 1024}; pg8::StaticOrder S; S.init(NTOK, DM, F.G, (int)blockIdx.x);
        pg8::EpiGateAddBf16 E{MERGED, TMP, F.PROJ + PO_GA, DM};
        pg8::gemm_phase<pg8::EpiGateAddBf16, pg8::StaticOrder, PG8_ALIGN, PG8_SP2>(F.lds + RING_OFF, g, S, E);
        } if (BOTH(7)) GRID_BAR(); }
    if (IN(8)) { { pg8::Gemm g{MERGED, F.WoutT, NTOK, DM, DM}; pg8::StaticOrder S; S.init(NTOK, DM, F.G, (int)blockIdx.x);
        pg8::EpiResNorm E{X1, F.x, H2, F.ffn_g, RSQ, RMX, DM};
        pg8::gemm_phase<pg8::EpiResNorm, pg8::StaticOrder, PG8_ALIGN, PG8_SP2>(F.lds + RING_OFF, g, S, E);
        } if (BOTH(8)) GRID_BAR(); }
    if (IN(10)) { { pg8::Gemm g{H2, F.WqT, NTOK, DM, DM}; pg8::StaticOrder S; S.init(NTOK, DM, F.G, (int)blockIdx.x);
        pg8::EpiHiLoScaled E{QH, QL, RSQ, DM, 1.0f / DM, EPS};
        pg8::gemm_phase<pg8::EpiHiLoScaled, pg8::StaticOrder, PG8_ALIGN, PG8_SP2>(F.lds + RING_OFF, g, S, E);
        } if (BOTH(10)) GRID_BAR(); }
    if (IN(11)) { { topk_phase(F, QH, QL, F.SKH, F.SKL); } if (BOTH(11)) GRID_BAR(); }
    if (IN(12)) { { peer_U8v(F, H2, RSQ, RMX, U8, SU, PART); } if (BOTH(12)) GRID_BAR(); }
    if (IN(13)) { { peer_actw(F, PART, SV, SE16, SWB, SWT); } if (BOTH(13)) GRID_BAR(); }
    if (IN(14)) { { peer_V8d(F, X1, V8, SE16, SWB, SWT); } }
#undef IN
#undef BOTH
}

extern "C" void kernel_launch(void* const* d_in, const int* in_sizes, int n_in, void* d_out, int out_size, void* d_ws, size_t ws_size, hipStream_t stream) {
    static int grid = 0;
    if (grid == 0) {
        if (n_in != 16 || in_sizes[0] != NTOK * DM || out_size != NTOK * DM || ws_size < WS_END) { fprintf(stderr, "kernel_launch: unexpected shapes / workspace (%d inputs, ws %zu)\n", n_in, ws_size); grid = -1; return; }
        int dev = 0, cus = 0, per_cu = 0;
        if (hipGetDevice(&dev) != hipSuccess || hipDeviceGetAttribute(&cus, hipDeviceAttributeMultiprocessorCount, dev) != hipSuccess) { grid = -1; return; }
        if (hipFuncSetAttribute((const void*)layer_fwd, hipFuncAttributeMaxDynamicSharedMemorySize, LDS_BYTES) != hipSuccess) { grid = -1; return; }
        if (hipOccupancyMaxActiveBlocksPerMultiprocessor(&per_cu, (const void*)layer_fwd, NWAVES * 64, LDS_BYTES) != hipSuccess || per_cu < 1) { fprintf(stderr, "kernel_launch: occupancy query says %d\n", per_cu); grid = -1; (void)hipGetLastError(); return; }
        (void)hipGetLastError();
        grid = cus;
    }
    if (grid < 0) return;
    if (hipMemsetAsync((char*)d_ws + WS_CTL, 0, CTL_ZERO_BYTES, stream) != hipSuccess) return;
    Args a{};
    for (int i = 0; i < 16; ++i) a.in[i] = (const float*)d_in[i];
    a.out = (float*)d_out; a.ws = (unsigned char*)d_ws;
    for (int li = 0; li < N_LAUNCHES; ++li) {
        a.ph_lo = (N_LAUNCHES == 1) ? 0 : li; a.ph_hi = (N_LAUNCHES == 1) ? N_PHASES : li + 1; a.li = li;
        hipLaunchKernelGGL(layer_fwd, dim3(grid), dim3(NWAVES * 64), LDS_BYTES, stream, a);
    }
}
```

```cpp
#include <hip/hip_runtime.h>
#include <cstdio>
#include <cstdint>
#include <type_traits>
namespace pg8 {
#define PG8_LAS __attribute__((address_space(3)))
typedef unsigned short bf16_t;
typedef short bf16x8 __attribute__((ext_vector_type(8)));
typedef float f32x4 __attribute__((ext_vector_type(4)));
typedef unsigned u32x4 __attribute__((ext_vector_type(4)));
constexpr int BM = 256, BK = 64, HALF = 128, HTB = HALF * BK * 2  , STAGE_BYTES = 8 * HTB, NXCD = 8, WGM = 8;

__host__ __device__ __forceinline__ int lds_byte(int r, int c) { const int st = (r >> 4) * 2 + (c >> 5), rr = r & 15, cc = c & 31, ob = rr * 64 + cc * 2; return st * 1024 + (ob ^ (((ob >> 9) & 1) << 5)); }
__host__ __device__ __forceinline__ void stage_rc(int b, int& R, int& C) { const int st = b / 1024, sb = b % 1024, swz = sb ^ (((sb >> 9) & 1) << 5); R = (st >> 1) * 16 + swz / 64; C = (st & 1) * 32 + (swz % 64) / 2; }
__host__ __device__ __forceinline__ int perm32(int rho) { const int n = rho >> 4, i = rho & 15; return 8 * (i >> 2) + 4 * n + (i & 3); }

struct Unit { int pm, pn; };
struct Gemm { const bf16_t* A; const bf16_t* Bt; int M, N, K; };

struct StaticOrder {
    int nM, nN, nwg, G, c;
    __host__ __device__ void init(int M, int N, int G_, int c_) { nM = M / BM; nN = N / BM; nwg = nM * nN; G = G_; c = c_; }
    __host__ __device__ bool next(int i, Unit& u) const {
        const long L = (long)i * G + c; if (L >= nwg) return false;
        int wgid = (int)L; { const int q = nwg / NXCD, r = nwg % NXCD, xcd = wgid % NXCD, off = wgid / NXCD; wgid = (xcd < r ? xcd * (q + 1) : r * (q + 1) + (xcd - r) * q) + off; }
        const int nig = WGM * nN, gid = wgid / nig, fm = gid * WGM, gsz = (nM - fm) < WGM ? (nM - fm) : WGM;
        u.pm = fm + ((wgid % nig) % gsz); u.pn = (wgid % nig) / gsz; return true;
    }
    __device__ __forceinline__ void a_ready(const Unit&) const {}
    __device__ __forceinline__ void done(const Unit&) const {}
};

__device__ __forceinline__ unsigned cvt_pk_bf16(float lo, float hi) { unsigned r; asm volatile("v_cvt_pk_bf16_f32 %0, %1, %2" : "=v"(r) : "v"(lo), "v"(hi)); return r; }
typedef int i32x4 __attribute__((ext_vector_type(4)));
__device__ __forceinline__ f32x4 mma16(bf16x8 a, bf16x8 b, f32x4 c) { return __builtin_amdgcn_mfma_f32_16x16x32_bf16(a, b, c, 0, 0, 0); }
__device__ __forceinline__ i32x4 mma16(bf16x8 a, bf16x8 b, i32x4 c) { return __builtin_amdgcn_mfma_i32_16x16x64_i8(__builtin_bit_cast(i32x4, a), __builtin_bit_cast(i32x4, b), c, 0, 0, 0); }
template <class Epi, class Sched, bool ALIGN_EPI = false, bool SP2 = false, bool TILED = false, bool I8 = false>
__device__ __forceinline__ void gemm_phase(PG8_LAS unsigned char* lds, const Gemm g, const Sched& S, const Epi& E) {
    const int tid = threadIdx.x, wid = __builtin_amdgcn_readfirstlane(tid >> 6), lane = tid & 63, wr = wid >> 2, wc = wid & 3, fr = lane & 15, fq = lane >> 4;
    const int K = g.K, nt = K / BK;
    unsigned voffA[2], voffB[2];
#pragma unroll
    for (int i = 0; i < 2; ++i) { int R, C; stage_rc(tid * 16 + i * 8192, R, C); const int Rb = Epi::PERM ? ((R & ~31) + perm32(R & 31)) : R;
        voffA[i] = TILED ? (unsigned)(R * BK + C) * 2u : (unsigned)(R * K + C) * 2u; voffB[i] = TILED ? (unsigned)(Rb * BK + C) * 2u : (unsigned)(Rb * K + C) * 2u; }
    const size_t kstep = TILED ? (size_t)(BM * BK * 2) : (size_t)(BK * 2);
    const size_t hstep = TILED ? (size_t)(HALF * BK * 2) : (size_t)HALF * K * 2;
    const size_t tstep = TILED ? (size_t)K * BM * 2 : 2 * hstep;
    const unsigned ldsw = (unsigned)wid * 1024u;
    const int aoff = lds_byte(wr * 64 + fr, fq * 8), boff = lds_byte(wc * 32 + fr, fq * 8);
#define PG8_SA(b, h) (((b) * 2 + (h)) * HTB)
#define PG8_SB(b, h) ((4 + (b) * 2 + (h)) * HTB)
#define PG8_STAGE(bufoff, gbase, voff) do { _Pragma("unroll") for (int _i = 0; _i < 2; ++_i) \
        __builtin_amdgcn_global_load_lds((const unsigned*)((const char*)(gbase) + (voff)[_i]), (PG8_LAS unsigned*)(lds + (bufoff) + ldsw + _i * 8192), 16, 0, 0); } while (0)
#define PG8_LDA(dst, b, h) do { _Pragma("unroll") for (int m = 0; m < 4; ++m) _Pragma("unroll") for (int k = 0; k < 2; ++k) dst[m][k] = *(const PG8_LAS bf16x8*)(lds + PG8_SA(b, h) + aoff + m * 2048 + k * 1024); } while (0)
#define PG8_LDB(dst, b, h) do { _Pragma("unroll") for (int n = 0; n < 2; ++n) _Pragma("unroll") for (int k = 0; k < 2; ++k) dst[n][k] = *(const PG8_LAS bf16x8*)(lds + PG8_SB(b, h) + boff + n * 2048 + k * 1024); } while (0)
#define PG8_MMA(ai, bj, At, Bt) do { __builtin_amdgcn_s_setprio(1); _Pragma("unroll") for (int m = 0; m < 4; ++m) _Pragma("unroll") for (int n = 0; n < 2; ++n) _Pragma("unroll") for (int k = 0; k < 2; ++k) \
        acc[ai][bj][m][n] = mma16(Bt[n][k], At[m][k], acc[ai][bj][m][n]); __builtin_amdgcn_s_setprio(0); } while (0)
#define PG8_WAIT_V(n) asm volatile("s_waitcnt vmcnt(" #n ")" ::: "memory")
#define PG8_WAIT_L(n) asm volatile("s_waitcnt lgkmcnt(" #n ")" ::: "memory")
#define PG8_BAR __builtin_amdgcn_s_barrier()
#define PG8_SCHED __builtin_amdgcn_sched_barrier(0)
    Unit cur, nxt; int ui = 0;
    if (!S.next(0, cur)) return;
    typedef typename std::conditional<I8, i32x4, f32x4>::type acc_t;
    acc_t acc[2][2][4][2];
#pragma unroll
    for (int a = 0; a < 2; ++a)
#pragma unroll
        for (int b = 0; b < 2; ++b)
#pragma unroll
            for (int m = 0; m < 4; ++m)
#pragma unroll
                for (int n = 0; n < 2; ++n) acc[a][b][m][n] = acc_t{};
    bf16x8 At[4][2], B0[2][2], B1[2][2];
    const char* cA = (const char*)g.A + (size_t)cur.pm * tstep; const char* cB = (const char*)g.Bt + (size_t)cur.pn * tstep;
    S.a_ready(cur);
    if constexpr (SP2) {
        PG8_STAGE(PG8_SB(0, 0), cB, voffB); PG8_STAGE(PG8_SB(0, 1), cB + hstep, voffB); PG8_STAGE(PG8_SA(0, 0), cA, voffA); PG8_STAGE(PG8_SA(0, 1), cA + hstep, voffA);
        if (wr == 1) PG8_BAR;
        PG8_WAIT_V(2); PG8_BAR;
        PG8_STAGE(PG8_SB(1, 0), cB + kstep, voffB); PG8_STAGE(PG8_SA(1, 0), cA + kstep, voffA); PG8_STAGE(PG8_SB(1, 1), cB + hstep + kstep, voffB);
        PG8_WAIT_V(6); PG8_BAR;
    } else {
        PG8_STAGE(PG8_SB(0, 0), cB, voffB); PG8_STAGE(PG8_SA(0, 0), cA, voffA); PG8_STAGE(PG8_SB(0, 1), cB + hstep, voffB); PG8_STAGE(PG8_SA(0, 1), cA + hstep, voffA);
        if (wr == 1) PG8_BAR;
        PG8_WAIT_V(4); PG8_BAR;
        PG8_STAGE(PG8_SB(1, 0), cB + kstep, voffB); PG8_STAGE(PG8_SA(1, 0), cA + kstep, voffA); PG8_STAGE(PG8_SB(1, 1), cB + hstep + kstep, voffB);
        PG8_WAIT_V(6); PG8_BAR;
    }
    for (;;) {
        const bool has_next = S.next(ui + 1, nxt);
        const char* nA = has_next ? (const char*)g.A + (size_t)nxt.pm * tstep : cA; const char* nB = has_next ? (const char*)g.Bt + (size_t)nxt.pn * tstep : cB;
        for (int t = 0; t < nt; t += 2) {
            const bool last = (t == nt - 2);
            const char* a1 = cA + (size_t)(t + 1) * kstep;
            const char* a2 = last ? nA : cA + (size_t)(t + 2) * kstep; const char* b2 = last ? nB : cB + (size_t)(t + 2) * kstep;
            const char* a3 = a2 + kstep; const char* b3 = b2 + kstep;
            if (last && has_next) S.a_ready(nxt);
            if constexpr (SP2) {
            PG8_LDB(B0, 0, 0); PG8_LDB(B1, 0, 1); PG8_SCHED; PG8_LDA(At, 0, 0); PG8_STAGE(PG8_SA(1, 1), a1 + hstep, voffA);
            PG8_WAIT_V(8); PG8_WAIT_L(0); PG8_BAR; PG8_MMA(0, 0, At, B0); PG8_MMA(0, 1, At, B1); PG8_BAR; PG8_SCHED;
            PG8_LDA(At, 0, 1); PG8_STAGE(PG8_SB(0, 0), b2, voffB); PG8_STAGE(PG8_SB(0, 1), b2 + hstep, voffB); PG8_STAGE(PG8_SA(0, 0), a2, voffA);
            PG8_WAIT_V(8); PG8_WAIT_L(0); PG8_BAR; PG8_MMA(1, 0, At, B0); PG8_MMA(1, 1, At, B1); PG8_BAR; PG8_SCHED;
            PG8_LDB(B0, 1, 0); PG8_LDB(B1, 1, 1); PG8_SCHED; PG8_LDA(At, 1, 0); PG8_STAGE(PG8_SA(0, 1), a2 + hstep, voffA);
            PG8_WAIT_V(8); PG8_WAIT_L(0); PG8_BAR; PG8_MMA(0, 0, At, B0); PG8_MMA(0, 1, At, B1); PG8_BAR; PG8_SCHED;
            PG8_LDA(At, 1, 1); PG8_STAGE(PG8_SB(1, 0), b3, voffB); PG8_STAGE(PG8_SB(1, 1), b3 + hstep, voffB); PG8_STAGE(PG8_SA(1, 0), a3, voffA);
            PG8_WAIT_V(8); PG8_WAIT_L(0); PG8_BAR; PG8_MMA(1, 0, At, B0); PG8_MMA(1, 1, At, B1); PG8_BAR; PG8_SCHED;
            } else {
            PG8_LDB(B0, 0, 0); PG8_SCHED; PG8_LDA(At, 0, 0); PG8_STAGE(PG8_SA(1, 1), a1 + hstep, voffA);
            PG8_WAIT_L(8); PG8_BAR; PG8_WAIT_L(0); PG8_MMA(0, 0, At, B0); PG8_BAR; PG8_SCHED;
            PG8_LDB(B1, 0, 1); PG8_STAGE(PG8_SB(0, 0), b2, voffB);
            PG8_BAR; PG8_WAIT_L(0); PG8_MMA(0, 1, At, B1); PG8_BAR;
            PG8_LDA(At, 0, 1); PG8_STAGE(PG8_SA(0, 0), a2, voffA);
            PG8_BAR; PG8_WAIT_L(0); PG8_MMA(1, 0, At, B0); PG8_BAR; PG8_SCHED;
            PG8_STAGE(PG8_SB(0, 1), b2 + hstep, voffB);
            PG8_WAIT_V(6); PG8_BAR; PG8_MMA(1, 1, At, B1); PG8_BAR;
            PG8_LDB(B0, 1, 0); PG8_SCHED; PG8_LDA(At, 1, 0); PG8_STAGE(PG8_SA(0, 1), a2 + hstep, voffA);
            PG8_WAIT_L(8); PG8_BAR; PG8_WAIT_L(0); PG8_MMA(0, 0, At, B0); PG8_BAR; PG8_SCHED;
            PG8_LDB(B1, 1, 1); PG8_STAGE(PG8_SB(1, 0), b3, voffB);
            PG8_BAR; PG8_WAIT_L(0); PG8_MMA(0, 1, At, B1); PG8_BAR;
            PG8_LDA(At, 1, 1); PG8_STAGE(PG8_SA(1, 0), a3, voffA);
            PG8_BAR; PG8_WAIT_L(0); PG8_MMA(1, 0, At, B0); PG8_BAR; PG8_SCHED;
            PG8_STAGE(PG8_SB(1, 1), b3 + hstep, voffB);
            PG8_WAIT_V(6); PG8_BAR; PG8_MMA(1, 1, At, B1); PG8_BAR;
            }
        }
        if constexpr (ALIGN_EPI) { if (wr == 0) PG8_BAR; }
        if constexpr (!Epi::AFTER_DRAIN) { E(acc, cur, wr, wc, fr, fq); S.done(cur); }
        if (!has_next) break;
#pragma unroll
        for (int a = 0; a < 2; ++a)
#pragma unroll
            for (int b = 0; b < 2; ++b)
#pragma unroll
                for (int m = 0; m < 4; ++m)
#pragma unroll
                    for (int n = 0; n < 2; ++n) acc[a][b][m][n] = acc_t{};
        cur = nxt; cA = nA; cB = nB; ++ui;
        if constexpr (ALIGN_EPI) { if (wr == 1) PG8_BAR; }
    }
    PG8_WAIT_V(0);
    if constexpr (!ALIGN_EPI) { if (wr == 0) PG8_BAR; }
    PG8_BAR;
    if constexpr (Epi::AFTER_DRAIN) { E.fused(acc, cur, wr, wc, fr, fq, lds, wid, lane); S.done(cur); }
#undef PG8_SA
#undef PG8_SB
#undef PG8_STAGE
#undef PG8_LDA
#undef PG8_LDB
#undef PG8_MMA
#undef PG8_WAIT_V
#undef PG8_WAIT_L
#undef PG8_BAR
#undef PG8_SCHED
}
}

namespace pg8 {
__device__ __forceinline__ float bf2f_(unsigned short u) { return __builtin_bit_cast(float, (unsigned)u << 16); }
__device__ __forceinline__ float sigmoid_(float x) { return 1.0f / (1.0f + __expf(-x)); }
struct EpiProj {
    static constexpr bool PERM = true, AFTER_DRAIN = false;
    bf16_t* base;
    unsigned long long* ssq;
    const float* rtab;
    __device__ __forceinline__ void operator()(const f32x4 (&acc)[2][2][4][2], const Unit& u, int wr, int wc, int fr, int fq) const {
        constexpr size_t MT = 8192;
        int colt = u.pn * BM; int width, act = 0; size_t off;
        if (colt < 1024)       { width = 1024; off = 0; }
        else if (colt < 2048)  { colt -= 1024; width = 1024; off = MT * 1024; }
        else if (colt < 4096)  { colt -= 2048; width = 2048; off = MT * 2048; }
        else if (colt < 6144)  { colt -= 4096; width = 2048; off = MT * 4096; act = 1; }
        else if (colt < 9216)  { colt -= 6144; width = 3072; off = MT * 6144; act = 3; }
        else if (colt < 12288) { colt -= 9216; width = 3072; off = MT * 9216; act = 4; }
        else if (colt < 15360) { colt -= 12288; width = 3072; off = MT * 12288; }
        else if (colt < 17408) { colt -= 15360; width = 2048; off = MT * 15360; act = 2; }
        else                   { colt -= 17408; width = 2048; off = MT * 17408; act = 2; }
        const int row0 = u.pm * BM + wr * 64 + fr, col0 = colt + wc * 32 + 8 * fq;
        const bool rot = (u.pn * BM) < 2048; const float rsc = ((u.pn * BM) >= 1024) ? 0.08838834764831845f : 1.0f;
        bf16_t* O = base + off;
#pragma unroll
        for (int ai = 0; ai < 2; ++ai)
#pragma unroll
            for (int m = 0; m < 4; ++m) { bf16_t* rowp = O + (size_t)(row0 + ai * HALF + m * 16) * width + col0;
#pragma unroll
                for (int bj = 0; bj < 2; ++bj) { f32x4 v0 = acc[ai][bj][m][0], v1 = acc[ai][bj][m][1];
                    if (rot) { const int pos = (row0 + ai * HALF + m * 16) & 4095; const float* tp = rtab + ((size_t)pos * 64 + 16 * wc + 4 * fq) * 2;
                        const f32x4 c0 = *(const f32x4*)tp, c1 = *(const f32x4*)(tp + 4);
                        const float a0 = v0[0] * c0[0] - v0[1] * c0[1], b0 = v0[1] * c0[0] + v0[0] * c0[1], a1 = v0[2] * c0[2] - v0[3] * c0[3], b1 = v0[3] * c0[2] + v0[2] * c0[3];
                        const float a2 = v1[0] * c1[0] - v1[1] * c1[1], b2 = v1[1] * c1[0] + v1[0] * c1[1], a3 = v1[2] * c1[2] - v1[3] * c1[3], b3 = v1[3] * c1[2] + v1[2] * c1[3];
                        v0[0] = a0 * rsc; v0[1] = b0 * rsc; v0[2] = a1 * rsc; v0[3] = b1 * rsc; v1[0] = a2 * rsc; v1[1] = b2 * rsc; v1[2] = a3 * rsc; v1[3] = b3 * rsc; }
                    if (act >= 3) {
                        float ss = (v0[0] * v0[0] + v0[1] * v0[1]) + (v0[2] * v0[2] + v0[3] * v0[3]) + (v1[0] * v1[0] + v1[1] * v1[1]) + (v1[2] * v1[2] + v1[3] * v1[3]);
                        { auto r1 = __builtin_amdgcn_permlane16_swap(__float_as_uint(ss), __float_as_uint(ss), false, false); ss = __uint_as_float(r1[0]) + __uint_as_float(r1[1]); }
                        { auto r2 = __builtin_amdgcn_permlane32_swap(__float_as_uint(ss), __float_as_uint(ss), false, false); ss = __uint_as_float(r2[0]) + __uint_as_float(r2[1]); }
                        if (fq == 0) atomicAdd(ssq + ((size_t)(act - 3) * MT + (row0 + ai * HALF + m * 16)) * 24 + (colt >> 7) + bj, (unsigned long long)(ss * 16777216.0f + 0.5f)); }
                    if (act == 1) {
#pragma unroll
                        for (int e = 0; e < 4; ++e) { v0[e] = v0[e] * sigmoid_(v0[e]); v1[e] = v1[e] * sigmoid_(v1[e]); } }
                    else if (act == 2) {
#pragma unroll
                        for (int e = 0; e < 4; ++e) { v0[e] = sigmoid_(v0[e]); v1[e] = sigmoid_(v1[e]); } }
                    u32x4 w; w.x = cvt_pk_bf16(v0[0], v0[1]); w.y = cvt_pk_bf16(v0[2], v0[3]); w.z = cvt_pk_bf16(v1[0], v1[1]); w.w = cvt_pk_bf16(v1[2], v1[3]);
                    __builtin_nontemporal_store(w, (u32x4*)(rowp + bj * HALF)); } }
    }
};
struct EpiProj8 {
    static constexpr bool PERM = true, AFTER_DRAIN = false;
    bf16_t* base;
    unsigned long long* ssq;
    const float* rtab;
    const float* sx; const unsigned* cmx;
    __device__ __forceinline__ void operator()(const i32x4 (&acc)[2][2][4][2], const Unit& u, int wr, int wc, int fr, int fq) const {
        constexpr size_t MT = 8192; const int gcol0 = u.pn * BM + wc * 32 + 8 * fq;
        f32x4 cw[2][2];
#pragma unroll
        for (int bj = 0; bj < 2; ++bj)
#pragma unroll
            for (int n = 0; n < 2; ++n) { const u32x4 cb = *(const u32x4*)(cmx + gcol0 + bj * HALF + 4 * n); cw[bj][n] = (f32x4){__uint_as_float(cb.x), __uint_as_float(cb.y), __uint_as_float(cb.z), __uint_as_float(cb.w)} * (1.0f / 127.0f); }
        int colt = u.pn * BM; int width, act = 0; size_t off;
        if (colt < 1024)       { width = 1024; off = 0; }
        else if (colt < 2048)  { colt -= 1024; width = 1024; off = MT * 1024; }
        else if (colt < 4096)  { colt -= 2048; width = 2048; off = MT * 2048; }
        else if (colt < 6144)  { colt -= 4096; width = 2048; off = MT * 4096; act = 1; }
        else if (colt < 9216)  { colt -= 6144; width = 3072; off = MT * 6144; act = 3; }
        else if (colt < 12288) { colt -= 9216; width = 3072; off = MT * 9216; act = 4; }
        else if (colt < 15360) { colt -= 12288; width = 3072; off = MT * 12288; }
        else if (colt < 17408) { colt -= 15360; width = 2048; off = MT * 15360; act = 2; }
        else                   { colt -= 17408; width = 2048; off = MT * 17408; act = 2; }
        const int row0 = u.pm * BM + wr * 64 + fr, col0 = colt + wc * 32 + 8 * fq;
        const bool rot = (u.pn * BM) < 2048; const float rsc = ((u.pn * BM) >= 1024) ? 0.08838834764831845f : 1.0f;
        bf16_t* O = base + off;
#pragma unroll
        for (int ai = 0; ai < 2; ++ai)
#pragma unroll
            for (int m = 0; m < 4; ++m) { bf16_t* rowp = O + (size_t)(row0 + ai * HALF + m * 16) * width + col0;
#pragma unroll
                for (int bj = 0; bj < 2; ++bj) { const float sr = sx[row0 + ai * HALF + m * 16]; const i32x4 a0 = acc[ai][bj][m][0], a1 = acc[ai][bj][m][1];
                    f32x4 v0 = (f32x4){(float)a0[0], (float)a0[1], (float)a0[2], (float)a0[3]} * cw[bj][0] * sr, v1 = (f32x4){(float)a1[0], (float)a1[1], (float)a1[2], (float)a1[3]} * cw[bj][1] * sr;
                    if (rot) { const int pos = (row0 + ai * HALF + m * 16) & 4095; const float* tp = rtab + ((size_t)pos * 64 + 16 * wc + 4 * fq) * 2;
                        const f32x4 c0 = *(const f32x4*)tp, c1 = *(const f32x4*)(tp + 4);
                        const float a0 = v0[0] * c0[0] - v0[1] * c0[1], b0 = v0[1] * c0[0] + v0[0] * c0[1], a1 = v0[2] * c0[2] - v0[3] * c0[3], b1 = v0[3] * c0[2] + v0[2] * c0[3];
                        const float a2 = v1[0] * c1[0] - v1[1] * c1[1], b2 = v1[1] * c1[0] + v1[0] * c1[1], a3 = v1[2] * c1[2] - v1[3] * c1[3], b3 = v1[3] * c1[2] + v1[2] * c1[3];
                        v0[0] = a0 * rsc; v0[1] = b0 * rsc; v0[2] = a1 * rsc; v0[3] = b1 * rsc; v1[0] = a2 * rsc; v1[1] = b2 * rsc; v1[2] = a3 * rsc; v1[3] = b3 * rsc; }
                    if (act >= 3) {
                        float ss = (v0[0] * v0[0] + v0[1] * v0[1]) + (v0[2] * v0[2] + v0[3] * v0[3]) + (v1[0] * v1[0] + v1[1] * v1[1]) + (v1[2] * v1[2] + v1[3] * v1[3]);
                        { auto r1 = __builtin_amdgcn_permlane16_swap(__float_as_uint(ss), __float_as_uint(ss), false, false); ss = __uint_as_float(r1[0]) + __uint_as_float(r1[1]); }
                        { auto r2 = __builtin_amdgcn_permlane32_swap(__float_as_uint(ss), __float_as_uint(ss), false, false); ss = __uint_as_float(r2[0]) + __uint_as_float(r2[1]); }
                        if (fq == 0) atomicAdd(ssq + ((size_t)(act - 3) * MT + (row0 + ai * HALF + m * 16)) * 24 + (colt >> 7) + bj, (unsigned long long)(ss * 16777216.0f + 0.5f)); }
                    if (act == 1) {
#pragma unroll
                        for (int e = 0; e < 4; ++e) { v0[e] = v0[e] * sigmoid_(v0[e]); v1[e] = v1[e] * sigmoid_(v1[e]); } }
                    else if (act == 2) {
#pragma unroll
                        for (int e = 0; e < 4; ++e) { v0[e] = sigmoid_(v0[e]); v1[e] = sigmoid_(v1[e]); } }
                    u32x4 w; w.x = cvt_pk_bf16(v0[0], v0[1]); w.y = cvt_pk_bf16(v0[2], v0[3]); w.z = cvt_pk_bf16(v1[0], v1[1]); w.w = cvt_pk_bf16(v1[2], v1[3]);
                    __builtin_nontemporal_store(w, (u32x4*)(rowp + bj * HALF)); } }
    }
};
struct EpiGateF32 {
    static constexpr bool PERM = false, AFTER_DRAIN = false;
    float* C; const bf16_t* gate; int ldc;
    __device__ __forceinline__ void operator()(const f32x4 (&acc)[2][2][4][2], const Unit& u, int wr, int wc, int fr, int fq) const {
        const int row0 = u.pm * BM + wr * 64 + fr, col0 = u.pn * BM + wc * 32 + 4 * fq;
#pragma unroll
        for (int ai = 0; ai < 2; ++ai)
#pragma unroll
            for (int m = 0; m < 4; ++m) { const size_t ro = (size_t)(row0 + ai * HALF + m * 16) * ldc + col0;
#pragma unroll
                for (int bj = 0; bj < 2; ++bj)
#pragma unroll
                    for (int n = 0; n < 2; ++n) { const size_t o = ro + bj * HALF + n * 16; const unsigned long long gb = *(const unsigned long long*)(gate + o);
                        f32x4 g; g[0] = bf2f_((unsigned short)gb); g[1] = bf2f_((unsigned short)(gb >> 16)); g[2] = bf2f_((unsigned short)(gb >> 32)); g[3] = bf2f_((unsigned short)(gb >> 48));
                        *(f32x4*)(C + o) = acc[ai][bj][m][n] * g; } }
    }
};
struct EpiGateAddBf16 {
    static constexpr bool PERM = false, AFTER_DRAIN = false;
    bf16_t* O; const float* prev; const bf16_t* gate; int ldc;
    __device__ __forceinline__ void operator()(const f32x4 (&acc)[2][2][4][2], const Unit& u, int wr, int wc, int fr, int fq) const {
        const int row0 = u.pm * BM + wr * 64 + fr, col0 = u.pn * BM + wc * 32 + 4 * fq;
#pragma unroll
        for (int ai = 0; ai < 2; ++ai)
#pragma unroll
            for (int m = 0; m < 4; ++m) { const size_t ro = (size_t)(row0 + ai * HALF + m * 16) * ldc + col0;
#pragma unroll
                for (int bj = 0; bj < 2; ++bj)
#pragma unroll
                    for (int n = 0; n < 2; ++n) { const size_t o = ro + bj * HALF + n * 16; const unsigned long long gb = *(const unsigned long long*)(gate + o);
                        f32x4 g; g[0] = bf2f_((unsigned short)gb); g[1] = bf2f_((unsigned short)(gb >> 16)); g[2] = bf2f_((unsigned short)(gb >> 32)); g[3] = bf2f_((unsigned short)(gb >> 48));
                        const f32x4 r = *(const f32x4*)(prev + o) + acc[ai][bj][m][n] * g;
                        unsigned long long w = (unsigned long long)cvt_pk_bf16(r[0], r[1]) | ((unsigned long long)cvt_pk_bf16(r[2], r[3]) << 32);
                        *(unsigned long long*)(O + o) = w; } }
    }
};
struct EpiResNorm {
    static constexpr bool PERM = false, AFTER_DRAIN = false;
    float* C; const float* res; bf16_t* H2u; const float* g; unsigned long long* RSQ; unsigned* RMX; int ldc;
    __device__ __forceinline__ void operator()(const f32x4 (&acc)[2][2][4][2], const Unit& u, int wr, int wc, int fr, int fq) const {
        const int row0 = u.pm * BM + wr * 64 + fr, col0 = u.pn * BM + wc * 32 + 4 * fq;
        f32x4 gv[2][2];
#pragma unroll
        for (int bj = 0; bj < 2; ++bj)
#pragma unroll
            for (int n = 0; n < 2; ++n) gv[bj][n] = *(const f32x4*)(g + col0 + bj * HALF + n * 16);
#pragma unroll
        for (int ai = 0; ai < 2; ++ai)
#pragma unroll
            for (int m = 0; m < 4; ++m) { const int row = row0 + ai * HALF + m * 16; const size_t ro = (size_t)row * ldc + col0; float ss = 0.f, mx = 0.f;
#pragma unroll
                for (int bj = 0; bj < 2; ++bj)
#pragma unroll
                    for (int n = 0; n < 2; ++n) { const size_t o = ro + bj * HALF + n * 16;
                        const f32x4 r = acc[ai][bj][m][n] + *(const f32x4*)(res + o);
                        *(f32x4*)(C + o) = r; ss += (r[0] * r[0] + r[1] * r[1]) + (r[2] * r[2] + r[3] * r[3]);
                        const f32x4 h = r * gv[bj][n]; mx = fmaxf(fmaxf(mx, fmaxf(fabsf(h[0]), fabsf(h[1]))), fmaxf(fabsf(h[2]), fabsf(h[3])));
                        *(unsigned long long*)(H2u + o) = (unsigned long long)cvt_pk_bf16(h[0], h[1]) | ((unsigned long long)cvt_pk_bf16(h[2], h[3]) << 32); }
                { auto r1 = __builtin_amdgcn_permlane16_swap(__float_as_uint(ss), __float_as_uint(ss), false, false); ss = __uint_as_float(r1[0]) + __uint_as_float(r1[1]); }
                { auto r2 = __builtin_amdgcn_permlane32_swap(__float_as_uint(ss), __float_as_uint(ss), false, false); ss = __uint_as_float(r2[0]) + __uint_as_float(r2[1]); }
                { auto r1 = __builtin_amdgcn_permlane16_swap(__float_as_uint(mx), __float_as_uint(mx), false, false); mx = fmaxf(__uint_as_float(r1[0]), __uint_as_float(r1[1])); }
                { auto r2 = __builtin_amdgcn_permlane32_swap(__float_as_uint(mx), __float_as_uint(mx), false, false); mx = fmaxf(__uint_as_float(r2[0]), __uint_as_float(r2[1])); }
                if (fq == 0) { atomicAdd(RSQ + row, (unsigned long long)(ss * 16777216.0f + 0.5f)); atomicMax(RMX + row, __float_as_uint(mx)); } }
    }
};
struct EpiHiLoScaled {
    static constexpr bool PERM = true, AFTER_DRAIN = false;
    bf16_t* H; bf16_t* L; const unsigned long long* RSQ; int ldc; float inv_n, eps;
    __device__ __forceinline__ void operator()(const f32x4 (&acc)[2][2][4][2], const Unit& u, int wr, int wc, int fr, int fq) const {
        const int row0 = u.pm * BM + wr * 64 + fr, col0 = u.pn * BM + wc * 32 + 8 * fq;
#pragma unroll
        for (int ai = 0; ai < 2; ++ai)
#pragma unroll
            for (int m = 0; m < 4; ++m) { const int row = row0 + ai * HALF + m * 16; const size_t ro = (size_t)row * ldc + col0;
                const float rs = 1.0f / sqrtf((float)RSQ[row] * (inv_n * (1.0f / 16777216.0f)) + eps);
#pragma unroll
                for (int bj = 0; bj < 2; ++bj) { const f32x4 v0 = acc[ai][bj][m][0] * rs, v1 = acc[ai][bj][m][1] * rs;
                    u32x4 wh; wh.x = cvt_pk_bf16(v0[0], v0[1]); wh.y = cvt_pk_bf16(v0[2], v0[3]); wh.z = cvt_pk_bf16(v1[0], v1[1]); wh.w = cvt_pk_bf16(v1[2], v1[3]);
                    u32x4 wl;
                    wl.x = cvt_pk_bf16(v0[0] - __builtin_bit_cast(float, wh.x << 16), v0[1] - __builtin_bit_cast(float, wh.x & 0xffff0000u));
                    wl.y = cvt_pk_bf16(v0[2] - __builtin_bit_cast(float, wh.y << 16), v0[3] - __builtin_bit_cast(float, wh.y & 0xffff0000u));
                    wl.z = cvt_pk_bf16(v1[0] - __builtin_bit_cast(float, wh.z << 16), v1[1] - __builtin_bit_cast(float, wh.z & 0xffff0000u));
                    wl.w = cvt_pk_bf16(v1[2] - __builtin_bit_cast(float, wh.w << 16), v1[3] - __builtin_bit_cast(float, wh.w & 0xffff0000u));
                    *(u32x4*)(H + ro + bj * HALF) = wh; *(u32x4*)(L + ro + bj * HALF) = wl; } }
    }
};
}
#ifndef PG8_SP2
#define PG8_SP2 true
#endif
#ifndef PG8_ALIGN
#define PG8_ALIGN true
#endif

constexpr int NWAVES = 8;
constexpr int NTOK = 8192, SEQ = 4096, DM = 2048, INW = 19456;
constexpr int NEXP = 16384;
constexpr float EPS = 1e-6f;
#ifndef MK_N_LAUNCHES
#define MK_N_LAUNCHES 1
#endif
constexpr int N_PHASES = 15;
constexpr int N_LAUNCHES = MK_N_LAUNCHES;

constexpr size_t MiB = 1u << 20;
constexpr size_t WS_CTL = 0, CTL_ZERO_BYTES = 114688;
constexpr size_t WS_WINT = 1 * MiB;
constexpr size_t WS_WRET = 77 * MiB;
constexpr size_t WS_WATT = 85 * MiB;
constexpr size_t WS_WOUT = 89 * MiB;
constexpr size_t WS_WQ   = 97 * MiB;
constexpr size_t WS_XN   = 105 * MiB;
constexpr size_t WS_PROJ = 137 * MiB;
constexpr size_t WS_UBF  = 441 * MiB;
constexpr size_t WS_VBF  = 505 * MiB;
constexpr size_t WS_ATT  = 569 * MiB;
constexpr size_t WS_EIDX = 585 * MiB;
constexpr size_t WS_GATE = 589 * MiB;
constexpr size_t WS_RTAB = 593 * MiB;
constexpr size_t WS_ATAB = 595 * MiB;
constexpr size_t WS_SKH  = 596 * MiB;
constexpr size_t WS_SKL  = 596 * MiB + 512 * 1024;
constexpr size_t WS_SU   = 597 * MiB;
constexpr size_t WS_END  = 598 * MiB;
constexpr size_t PO_RQ = 0, PO_RK = (size_t)NTOK * 1024, PO_RV = (size_t)NTOK * 2048, PO_RG = (size_t)NTOK * 4096, PO_AQ = (size_t)NTOK * 6144,
                 PO_AK = (size_t)NTOK * 9216, PO_AV = (size_t)NTOK * 12288, PO_GR = (size_t)NTOK * 15360, PO_GA = (size_t)NTOK * 17408;
constexpr int CW_BAR = 4096;

constexpr int RING_OFF = 0, RING_BYTES = 131072;
constexpr int LDSCTL_OFF = RING_BYTES, MISC_OFF = LDSCTL_OFF + 320;
constexpr int LDS_BYTES = 147456;

#define GAS __attribute__((address_space(1)))
#define LAS __attribute__((address_space(3)))
typedef unsigned short bf16;
typedef unsigned v4u __attribute__((ext_vector_type(4)));
typedef unsigned v2u __attribute__((ext_vector_type(2)));
typedef float f32x4 __attribute__((ext_vector_type(4)));
typedef float f32x2 __attribute__((ext_vector_type(2)));
typedef GAS unsigned gu32;
#define RLX_AGENT __ATOMIC_RELAXED, __HIP_MEMORY_SCOPE_AGENT
#define LDS_WAIT() asm volatile("s_waitcnt lgkmcnt(0)" ::: "memory")
#define VM_WAIT() asm volatile("s_waitcnt vmcnt(0)" ::: "memory")
__device__ __forceinline__ unsigned f2bf(float f) { unsigned u = __builtin_bit_cast(unsigned, f); return (u + 0x7fffu + ((u >> 16) & 1u)) >> 16; }
__device__ __forceinline__ unsigned pk2(float lo, float hi) { unsigned r; asm("v_cvt_pk_bf16_f32 %0, %1, %2" : "=v"(r) : "v"(lo), "v"(hi)); return r; }
__device__ __forceinline__ float bf2f(unsigned u16) { return __builtin_bit_cast(float, u16 << 16); }
__device__ __forceinline__ float bflo(unsigned w) { return __builtin_bit_cast(float, w << 16); }
__device__ __forceinline__ float bfhi(unsigned w) { return __builtin_bit_cast(float, w & 0xffff0000u); }
__device__ __forceinline__ float wave_sum(float v) {
#pragma unroll
    for (int o = 1; o < 64; o <<= 1) v += __shfl_xor(v, o);
    return v;
}
__device__ __forceinline__ float wave_max(float v) {
#pragma unroll
    for (int o = 1; o < 64; o <<= 1) v = fmaxf(v, __shfl_xor(v, o));
    return v;
}
#define XB_TMO      128
#define XB_XCNT(j)  (256  + 64 * (j))
#define XB_XSUB(j)  (1280 + 64 * (j))
#define XB_XGEN(j)  (2304 + 64 * (j))
#define XB_TOP      3328
#define XB_TOPGEN   3392
#define XCD_BAR_WORDS 3456
#define XB_SPIN_CAP (1u << 24)

__device__ __forceinline__ unsigned xb_ld(unsigned* p)              { return __hip_atomic_load(p, __ATOMIC_RELAXED, __HIP_MEMORY_SCOPE_AGENT); }
__device__ __forceinline__ unsigned xb_add(unsigned* p, unsigned v) { return __hip_atomic_fetch_add(p, v, __ATOMIC_RELAXED, __HIP_MEMORY_SCOPE_AGENT); }
__device__ __forceinline__ unsigned xb_xcc_id() { return (unsigned)__builtin_amdgcn_s_getreg((3 << 11) | 20) & 0xFu; }
#define XB_SPIN(cond, bar) do { unsigned _sp = 0; while (cond) { __builtin_amdgcn_s_sleep(1); \
    if ((++_sp & 255u) == 0u) { if (xb_ld(&(bar)[XB_TMO])) break; if (_sp > XB_SPIN_CAP) { atomicAdd(&(bar)[XB_TMO], 1u); break; } } } } while (0)

struct XcdBarrier {
    unsigned* bar; unsigned x;
    volatile LAS unsigned* st;
};

__device__ __forceinline__ XcdBarrier xcd_barrier_post(unsigned* bar, volatile LAS unsigned* st) {
    XcdBarrier b; b.bar = bar; b.x = xb_xcc_id(); b.st = st;
    if (threadIdx.x == 0) (void)xb_add(&bar[XB_XCNT(b.x)], 1u);
    return b;
}
__device__ __forceinline__ void xcd_barrier_complete(unsigned* bar, unsigned x, unsigned& nloc, unsigned& nx) {
    const unsigned G = gridDim.x * gridDim.y * gridDim.z;
    unsigned sum, cnt, mine, sp = 0u;
    for (;;) {
        sum = 0u; cnt = 0u; mine = 0u;
#pragma unroll
        for (unsigned j = 0; j < 16; ++j) { const unsigned c = xb_ld(&bar[XB_XCNT(j)]); sum += c; cnt += (c > 0u) ? 1u : 0u; mine = (j == x) ? c : mine; }
        if (sum == G) break;
        __builtin_amdgcn_s_sleep(1);
        if ((++sp & 255u) == 0u) { if (xb_ld(&bar[XB_TMO])) break; if (sp > XB_SPIN_CAP) { atomicAdd(&bar[XB_TMO], 1u); break; } }
    }
    nloc = mine > 0u ? mine : 1u; nx = cnt > 0u ? cnt : 1u;
}

__device__ __forceinline__ void xcd_barrier(const XcdBarrier& b) {
    asm volatile("s_waitcnt vmcnt(0)" ::: "memory");
    __syncthreads();
    if (threadIdx.x == 0) {
        unsigned* bar = b.bar;
        __builtin_amdgcn_s_waitcnt(0);
        unsigned nloc = b.st[0], nx = b.st[1];
        if (nloc == 0u) { xcd_barrier_complete(bar, b.x, nloc, nx); b.st[0] = nloc; b.st[1] = nx; }
        const unsigned old = xb_add(&bar[XB_XSUB(b.x)], 1u);
        const unsigned gen = old / nloc;
        if (old + 1u == (gen + 1u) * nloc) {
            __builtin_amdgcn_fence(__ATOMIC_RELEASE, "agent");
            asm volatile("s_waitcnt vmcnt(0)" ::: "memory");
            const unsigned og = xb_add(&bar[XB_TOP], 1u);
            const unsigned tg = og / nx;
            if (og + 1u == (tg + 1u) * nx) xb_add(&bar[XB_TOPGEN], 1u);
            else XB_SPIN(xb_ld(&bar[XB_TOPGEN]) == tg, bar);
            __builtin_amdgcn_fence(__ATOMIC_ACQUIRE, "agent");
            xb_add(&bar[XB_XGEN(b.x)], 1u);
            asm volatile("s_waitcnt vmcnt(0)" ::: "memory");
        } else {
            XB_SPIN(xb_ld(&bar[XB_XGEN(b.x)]) == gen, bar);
            __builtin_amdgcn_fence(__ATOMIC_ACQUIRE, "agent");
            asm volatile("s_waitcnt vmcnt(0)" ::: "memory");
        }
    }
    __syncthreads();
}

struct Frame {
    LAS unsigned char* lds;
    volatile LAS unsigned* MISC;
    gu32* ctl;
    int tid, lane, wave;
    int vcu, G;
    const float *x, *mix_g, *w_in, *dec_f, *dec_b, *gn_g, *w_ret, *qn_g, *kn_g, *w_att, *w_out, *ffn_g, *w_pq, *subk, *pu, *pv;
    float* out;
    bf16 *WinT, *WretT, *WattT, *WoutT, *WqT, *XN, *PROJ, *Ubf, *Vbf, *ATT;
    int* EIDX; float* GATE; f32x2* RTAB; f32x2* ATAB; bf16 *SKH, *SKL;
};

template <bool ROTP = false> __device__ __forceinline__ void p0_transpose_item(const float* W, int K, int N, bf16* WT, LAS float* scr, int item, int lane) {
    const int nblk = N / 32, kb = item / nblk, nb = item % nblk, k0 = 64 * kb, n0 = 32 * nb;
    int ncol = n0 + (lane & 31);
    if (ROTP && ncol < 2048) { const int cp = ncol & 127; ncol = (ncol & ~127) + (cp >> 1) + 64 * (cp & 1); }
#pragma unroll 8
    for (int i = 0; i < 32; ++i) { const int kk = 2 * i + (lane >> 5); scr[kk * 33 + (lane & 31)] = __builtin_nontemporal_load(W + (size_t)(k0 + kk) * N + ncol); }
    LDS_WAIT(); asm volatile("" ::: "memory");
    const int c = lane & 7;
#pragma unroll
    for (int j = 0; j < 4; ++j) { const int n = (lane >> 3) + 8 * j; const LAS float* s = scr + (8 * c) * 33 + n;
        v4u o; o.x = pk2(s[0 * 33], s[1 * 33]); o.y = pk2(s[2 * 33], s[3 * 33]); o.z = pk2(s[4 * 33], s[5 * 33]); o.w = pk2(s[6 * 33], s[7 * 33]);
        if (ROTP) *(v4u*)(WT + ((size_t)((n0 + n) >> 8) * (K >> 6) + (k0 >> 6)) * 16384 + ((n0 + n) & 255) * 64 + 8 * c) = o;
        else *(v4u*)(WT + (size_t)(n0 + n) * K + k0 + 8 * c) = o; }
    LDS_WAIT(); asm volatile("" ::: "memory");
}
__device__ __forceinline__ void rms_row_to_bf16_tiled(const float* xrow, const float* g, bf16* obase, int m, int lane) {
    const f32x4* xr = (const f32x4*)xrow + lane; const f32x4* gr = (const f32x4*)g + lane;
    f32x4 v[8]; float s = 0.f;
#pragma unroll
    for (int j = 0; j < 8; ++j) { v[j] = __builtin_nontemporal_load(xr + 64 * j); s += (v[j].x * v[j].x + v[j].y * v[j].y) + (v[j].z * v[j].z + v[j].w * v[j].w); }
    const float rstd = 1.0f / sqrtf(wave_sum(s) * (1.f / DM) + EPS);
#pragma unroll
    for (int j = 0; j < 8; ++j) { const f32x4 gg = gr[64 * j]; const int k = 256 * j + 4 * lane;
        unsigned long long* o8 = (unsigned long long*)(obase + ((size_t)(m >> 8) * (DM >> 6) + (k >> 6)) * 16384 + (m & 255) * 64 + (k & 63));
        *o8 = (unsigned long long)pk2(v[j].x * rstd * gg.x, v[j].y * rstd * gg.y) | ((unsigned long long)pk2(v[j].z * rstd * gg.z, v[j].w * rstd * gg.w) << 32); }
}
__device__ __forceinline__ int rot_dst(int src) { if (src >= 2048) return src; const int cp = src & 127; return (src & ~127) + 2 * (cp & 63) + (cp >> 6); }
__device__ __forceinline__ void p0a_colmax_item(const float* W, unsigned* CMX, int item, int lane) {
    const int nb = item % (INW / 256), kb = item / (INW / 256); const f32x4* p = (const f32x4*)(W + (size_t)(64 * kb) * INW + 256 * nb) + lane; f32x4 m = {0.f, 0.f, 0.f, 0.f};
#pragma unroll 8
    for (int kk = 0; kk < 64; ++kk) { const f32x4 v = __builtin_nontemporal_load(p + (size_t)kk * (INW / 4)); m.x = fmaxf(m.x, fabsf(v.x)); m.y = fmaxf(m.y, fabsf(v.y)); m.z = fmaxf(m.z, fabsf(v.z)); m.w = fmaxf(m.w, fabsf(v.w)); }
    const int n = 256 * nb + 4 * lane;
    atomicMax(CMX + rot_dst(n), __float_as_uint(m.x)); atomicMax(CMX + rot_dst(n + 1), __float_as_uint(m.y)); atomicMax(CMX + rot_dst(n + 2), __float_as_uint(m.z)); atomicMax(CMX + rot_dst(n + 3), __float_as_uint(m.w));
}
__device__ __forceinline__ unsigned q4b(f32x4 v, float inv) {
    const int a = (int)rintf(v.x * inv), b = (int)rintf(v.y * inv), c = (int)rintf(v.z * inv), d = (int)rintf(v.w * inv);
    return (unsigned)(a & 255) | ((unsigned)(b & 255) << 8) | ((unsigned)(c & 255) << 16) | ((unsigned)(d & 255) << 24);
}
__device__ __forceinline__ void rms_row_to_i8_tiled(const float* xrow, const float* g, unsigned char* obase, float* SX, int m, int lane) {
    const f32x4* xr = (const f32x4*)xrow + lane; const f32x4* gr = (const f32x4*)g + lane;
    f32x4 v[8]; float s = 0.f;
#pragma unroll
    for (int j = 0; j < 8; ++j) { v[j] = __builtin_nontemporal_load(xr + 64 * j); s += (v[j].x * v[j].x + v[j].y * v[j].y) + (v[j].z * v[j].z + v[j].w * v[j].w); }
    const float rstd = 1.0f / sqrtf(wave_sum(s) * (1.f / DM) + EPS); float mx = 0.f;
#pragma unroll
    for (int j = 0; j < 8; ++j) { const f32x4 gg = gr[64 * j]; v[j].x *= rstd * gg.x; v[j].y *= rstd * gg.y; v[j].z *= rstd * gg.z; v[j].w *= rstd * gg.w;
        mx = fmaxf(mx, fmaxf(fmaxf(fabsf(v[j].x), fabsf(v[j].y)), fmaxf(fabsf(v[j].z), fabsf(v[j].w)))); }
    mx = wave_max(mx); const float sc = (mx > 0.f) ? mx * (1.0f / 127.0f) : 1.0f, inv = 1.0f / sc;
#pragma unroll
    for (int j = 0; j < 8; ++j) { const int k = 256 * j + 4 * lane; *(unsigned*)(obase + ((size_t)(m >> 8) * (DM >> 7) + (k >> 7)) * 32768 + (m & 255) * 128 + (k & 127)) = q4b(v[j], inv); }
    if (lane == 0) SX[m] = sc;
}
__device__ __forceinline__ void p0b_transpose_q8_item(const float* W, const unsigned* CMX, unsigned char* WT8, LAS float* scr, int item, int lane) {
    constexpr int K = DM, N = INW; const int nblk = N / 32, kb = item / nblk, nb = item % nblk, k0 = 64 * kb, n0 = 32 * nb;
    int ncol = n0 + (lane & 31);
    if (ncol < 2048) { const int cp = ncol & 127; ncol = (ncol & ~127) + (cp >> 1) + 64 * (cp & 1); }
#pragma unroll 8
    for (int i = 0; i < 32; ++i) { const int kk = 2 * i + (lane >> 5); scr[kk * 33 + (lane & 31)] = __builtin_nontemporal_load(W + (size_t)(k0 + kk) * N + ncol); }
    LDS_WAIT(); asm volatile("" ::: "memory");
    const int c = lane & 7;
#pragma unroll
    for (int j = 0; j < 4; ++j) { const int nn = (lane >> 3) + 8 * j, n = n0 + nn; const LAS float* s = scr + (8 * c) * 33 + nn; const float cm = __uint_as_float(CMX[n]), inv = (cm > 0.f) ? 127.0f / cm : 0.f;
        v2u o; o.x = q4b((f32x4){s[0 * 33], s[1 * 33], s[2 * 33], s[3 * 33]}, inv); o.y = q4b((f32x4){s[4 * 33], s[5 * 33], s[6 * 33], s[7 * 33]}, inv);
        *(v2u*)(WT8 + ((size_t)(n >> 8) * (K >> 7) + (k0 >> 7)) * 32768 + (n & 255) * 128 + (k0 & 127) + 8 * c) = o; }
    LDS_WAIT(); asm volatile("" ::: "memory");
}
__device__ __forceinline__ void p0_prologue(Frame& F, int pass, unsigned* CMX, float* SX) {
    LAS float* scr = (LAS float*)(F.lds + RING_OFF + F.wave * 16384);
    const int gw = F.vcu * NWAVES + F.wave, NGW = F.G * NWAVES;
    constexpr int I_IN = (DM / 64) * (INW / 32), I_SQ = (DM / 64) * (DM / 32), I_AT = (1024 / 64) * (DM / 32);
    constexpr int NITEMS = I_IN + 3 * I_SQ + I_AT;
    for (int it = gw; it < NITEMS; it += NGW) {
        int r = it;
        if (r < I_IN) { if (pass == 1) p0b_transpose_q8_item(F.w_in, CMX, (unsigned char*)F.WinT, scr, r, F.lane); continue; } r -= I_IN;
        if (pass == 1) continue;
        if (r < I_SQ) { p0_transpose_item(F.w_ret, DM, DM, F.WretT, scr, r, F.lane); continue; } r -= I_SQ;
        if (r < I_SQ) { p0_transpose_item(F.w_out, DM, DM, F.WoutT, scr, r, F.lane); continue; } r -= I_SQ;
        if (r < I_SQ) { p0_transpose_item(F.w_pq, DM, DM, F.WqT, scr, r, F.lane); continue; } r -= I_SQ;
        p0_transpose_item(F.w_att, 1024, DM, F.WattT, scr, r, F.lane);
    }
    if (pass == 1) return;
    for (int it = gw; it < (DM / 64) * (INW / 256); it += NGW) p0a_colmax_item(F.w_in, CMX, it, F.lane);
    for (int m = gw; m < NTOK; m += NGW) rms_row_to_i8_tiled(F.x + (size_t)m * DM, F.mix_g, (unsigned char*)F.XN, SX, m, F.lane);
    for (int idx = gw * 64 + F.lane; idx < 8 * 2 * 128 * 128 / 2; idx += NGW * 64) { const f32x2 v = *(const f32x2*)(F.subk + 2 * idx);
        const unsigned hi = pk2(v.x, v.y); const unsigned lo = pk2(v.x - bflo(hi), v.y - bfhi(hi)); ((unsigned*)F.SKH)[idx] = hi; ((unsigned*)F.SKL)[idx] = lo; }
    for (int idx = gw * 64 + F.lane; idx < SEQ * 64; idx += NGW * 64) { const int pos = idx >> 6, i = idx & 63;
        const float freq = powf(10000.0f, -(float)i / 64.0f), ang = (float)pos * freq; f32x2 cs; cs.x = cosf(ang); cs.y = sinf(ang); F.RTAB[idx] = cs; }
    for (int idx = gw * 64 + F.lane; idx < SEQ * 16; idx += NGW * 64) { const int pos = idx >> 4, i = idx & 15;
        const float freq = powf(500000.0f, -(float)i / 16.0f), ang = (float)pos * freq; f32x2 cs; cs.x = cosf(ang); cs.y = sinf(ang); F.ATAB[idx] = cs; }
}

template <int CTRL> __device__ __forceinline__ float dpp_f(float x) { return __builtin_bit_cast(float, __builtin_amdgcn_mov_dpp(__builtin_bit_cast(int, x), CTRL, 0xf, 0xf, true)); }

typedef short bf16x8 __attribute__((ext_vector_type(8)));
typedef float f32x16 __attribute__((ext_vector_type(16)));
#define MFMA32(a, b, c) __builtin_amdgcn_mfma_f32_32x32x16_bf16((a), (b), (c), 0, 0, 0)
__device__ __forceinline__ unsigned cvtpk(float lo, float hi) { unsigned r; asm volatile("v_cvt_pk_bf16_f32 %0, %1, %2" : "=v"(r) : "v"(lo), "v"(hi)); return r; }

__device__ __forceinline__ void ret_phaseB(Frame& F, bf16* UF, bf16* UB) {
    for (int task = F.vcu * 512 + F.tid; task < 131072; task += F.G * 512) {
        const int piece = task & 4095, bh = (task >> 12) & 15, dir = task >> 16, b = bh >> 3, h = bh & 7;
        const float cd = expf(-expf(dir ? F.dec_b[h] : F.dec_f[h]) * 128.0f);
        bf16* base = (dir ? UB : UF) + (size_t)piece * 8;
        float s[8];
#pragma unroll
        for (int i = 0; i < 8; ++i) s[i] = 0.f;
        const size_t cstride = (size_t)8 * 32768;
        bf16* p0 = base + (size_t)(b * 32 * 8 + h) * 32768;
        v4u wv[32];
#pragma unroll
        for (int cc = 0; cc < 32; ++cc) { const int c = dir ? 31 - cc : cc; wv[cc] = *(const v4u*)(p0 + c * cstride); }
#pragma unroll
        for (int cc = 0; cc < 32; ++cc) { const int c = dir ? 31 - cc : cc; const v4u w = wv[cc];
            v4u o; o.x = pk2(s[0], s[1]); o.y = pk2(s[2], s[3]); o.z = pk2(s[4], s[5]); o.w = pk2(s[6], s[7]); *(v4u*)(p0 + c * cstride) = o;
            s[0] = s[0] * cd + bflo(w.x); s[1] = s[1] * cd + bfhi(w.x); s[2] = s[2] * cd + bflo(w.y); s[3] = s[3] * cd + bfhi(w.y);
            s[4] = s[4] * cd + bflo(w.z); s[5] = s[5] * cd + bfhi(w.z); s[6] = s[6] * cd + bflo(w.w); s[7] = s[7] * cd + bfhi(w.w); }
    }
}


constexpr int LROW = 272;
template <int NI> __device__ __forceinline__ void tile_ld(v4u (&g)[NI], const bf16* src, size_t src_stride, int tid) {
    const bf16* p = src + (size_t)(tid >> 4) * src_stride + (tid & 15) * 8;
#pragma unroll
    for (int i = 0; i < NI; ++i) g[i] = *(const v4u*)(p + (size_t)(32 * i) * src_stride);
}
template <int NI> __device__ __forceinline__ void tile_st(const v4u (&g)[NI], LAS unsigned char* dst, int tid) {
    LAS unsigned char* p = dst + (tid >> 4) * LROW + (tid & 15) * 16;
#pragma unroll
    for (int i = 0; i < NI; ++i) *(LAS v4u*)(p + 32 * i * LROW) = g[i];
}
#define BLK_SYNC() do { asm volatile("s_waitcnt lgkmcnt(0)" ::: "memory"); __builtin_amdgcn_s_barrier(); asm volatile("" ::: "memory"); } while (0)


template <int NI> __device__ __forceinline__ void tile_out(bf16* dst, const LAS unsigned char* srcl, int tid) {
    const LAS unsigned char* p = srcl + (tid >> 4) * LROW + (tid & 15) * 16; bf16* d = dst + (size_t)(tid >> 4) * 128 + (tid & 15) * 8;
#pragma unroll
    for (int i = 0; i < NI; ++i) *(v4u*)(d + (size_t)(32 * i) * 128) = *(const LAS v4u*)(p + 32 * i * LROW);
}

__device__ __forceinline__ void att_merge(Frame& F, const bf16* OGN, const float* LSE) {
#pragma unroll 4
    for (int task = F.vcu * 512 + F.tid; task < NTOK * 128; task += F.G * 512) {
        const int m = task >> 7, c8 = (task & 127) * 8, hh = c8 >> 7;
        const float l0 = LSE[(size_t)m * 8 + hh], l1 = LSE[(size_t)NTOK * 8 + (size_t)m * 8 + hh], l2 = LSE[(size_t)2 * NTOK * 8 + (size_t)m * 8 + hh];
        const float mx = fmaxf(l0, fmaxf(l1, l2)); float w0 = __expf(l0 - mx), w1 = __expf(l1 - mx), w2 = __expf(l2 - mx); const float inv = 1.0f / (w0 + w1 + w2); w0 *= inv; w1 *= inv; w2 *= inv;
        const size_t o = (size_t)m * 1024 + c8;
        const v4u a = *(const v4u*)(OGN + o), bq = *(const v4u*)(OGN + (size_t)NTOK * 1024 + o), c = *(const v4u*)(OGN + (size_t)2 * NTOK * 1024 + o);
        v4u res;
        res.x = pk2(w0 * bflo(a.x) + w1 * bflo(bq.x) + w2 * bflo(c.x), w0 * bfhi(a.x) + w1 * bfhi(bq.x) + w2 * bfhi(c.x));
        res.y = pk2(w0 * bflo(a.y) + w1 * bflo(bq.y) + w2 * bflo(c.y), w0 * bfhi(a.y) + w1 * bfhi(bq.y) + w2 * bfhi(c.y));
        res.z = pk2(w0 * bflo(a.z) + w1 * bflo(bq.z) + w2 * bflo(c.z), w0 * bfhi(a.z) + w1 * bfhi(bq.z) + w2 * bfhi(c.z));
        res.w = pk2(w0 * bflo(a.w) + w1 * bflo(bq.w) + w2 * bflo(c.w), w0 * bfhi(a.w) + w1 * bfhi(bq.w) + w2 * bfhi(c.w));
        *(v4u*)(F.ATT + o) = res;
    }
}

typedef short trv4 __attribute__((ext_vector_type(4)));
constexpr int VROW = 320;
__device__ __forceinline__ void att_phase3(Frame& F, bf16* OGN, float* LSE, const unsigned long long* SSQ) {
    const bf16* AQ = F.PROJ + PO_AQ; const bf16* AK = F.PROJ + PO_AK; const bf16* AV = F.PROJ + PO_AV;
    LAS unsigned char* Lk = F.lds + RING_OFF;
    const int tid = F.tid, lane = F.lane, r = lane & 31, lh = lane >> 5, w = F.wave;
    for (int unit = F.vcu; unit < 2 * 24 * 16; unit += F.G) {
        int blk = unit & 15; asm volatile("" : "+v"(blk));
        int ts = tid; asm volatile("" : "+v"(ts));
        const int bh = unit >> 4, head = bh % 24, b = bh / 24, g = head >> 3, hh = head & 7, sh = 2 * g, dil = 1 << sh, L = SEQ >> sh;
        const int nb = L >> 8, p = blk / nb, l0 = (blk % nb) * 256, lq = l0 + 32 * w + r;
        const size_t mq = (size_t)b * SEQ + (size_t)lq * dil + p;
        __syncthreads();
        { const int ch = ts & 15, c8 = ch * 8; const float* kg_ = F.kn_g; asm volatile("" : "+s"(kg_));
          const f32x4 g0 = *(const f32x4*)(kg_ + c8), g1 = *(const f32x4*)(kg_ + c8 + 4);
          const float gg[8] = {g0.x, g0.y, g0.z, g0.w, g1.x, g1.y, g1.z, g1.w};
#pragma unroll 1
          for (int ib = 0; ib < 12; ib += 6) {
              v4u wr_[6]; unsigned long long sq_[6];
#pragma unroll
              for (int i = 0; i < 6; ++i) { const int slot = 32 * (ib + i) + (ts >> 4), l = l0 - 64 + slot; const bool ok = (l >= 0 && l < L); const int pos = ok ? l * dil + p : 0; const size_t mk = (size_t)b * SEQ + pos;
                  wr_[i] = *(const v4u*)(AK + mk * 3072 + head * 128 + c8); sq_[i] = SSQ[((size_t)NTOK + mk) * 24 + head]; }
#pragma unroll
              for (int i = 0; i < 6; ++i) { const int slot = 32 * (ib + i) + (ts >> 4), l = l0 - 64 + slot; const bool ok = (l >= 0 && l < L); const int pos = ok ? l * dil + p : 0;
                  const v4u w_ = wr_[i]; const float rstd = 1.0f / sqrtf((float)sq_[i] * (1.f / (128.f * 16777216.0f)) + EPS);
                  float x[8] = {bflo(w_.x), bfhi(w_.x), bflo(w_.y), bfhi(w_.y), bflo(w_.z), bfhi(w_.z), bflo(w_.w), bfhi(w_.w)};
#pragma unroll
                  for (int j = 0; j < 8; ++j) x[j] = x[j] * rstd * gg[j];
                  float oth[8];
#pragma unroll
                  for (int j = 0; j < 8; ++j) oth[j] = dpp_f<0x4E>(x[j]);
                  if (ch < 4) { const f32x2* tab = F.ATAB + pos * 16 + 8 * (ch & 1);
#pragma unroll
                      for (int j = 0; j < 8; ++j) { const f32x2 cs = tab[j]; x[j] = (ch < 2) ? (x[j] * cs.x - oth[j] * cs.y) : (x[j] * cs.x + oth[j] * cs.y); } }
                  v4u v; v.x = pk2(x[0], x[1]); v.y = pk2(x[2], x[3]); v.z = pk2(x[4], x[5]); v.w = pk2(x[6], x[7]);
                  if (!ok) v = (v4u){0u, 0u, 0u, 0u};
                  *(LAS v4u*)(Lk + slot * LROW + 2 * c8) = v; } } }
        bf16x8 qf[8];
        { const bf16* qp = AQ + mq * 3072 + head * 128 + 8 * lh; const float rstd = 1.0f / sqrtf((float)SSQ[mq * 24 + head] * (1.f / (128.f * 16777216.0f)) + EPS); const int posq = lq * dil + p;
          const float* qg_ = F.qn_g; asm volatile("" : "+s"(qg_));
          float y0[8], y1[8];
#pragma unroll
          for (int ks = 0; ks < 8; ++ks) { const v4u w_ = *(const v4u*)(qp + 16 * ks); const f32x4 g0 = *(const f32x4*)(qg_ + 16 * ks + 8 * lh), g1 = *(const f32x4*)(qg_ + 16 * ks + 8 * lh + 4);
              float x[8] = {bflo(w_.x) * rstd * g0.x, bfhi(w_.x) * rstd * g0.y, bflo(w_.y) * rstd * g0.z, bfhi(w_.y) * rstd * g0.w, bflo(w_.z) * rstd * g1.x, bfhi(w_.z) * rstd * g1.y, bflo(w_.w) * rstd * g1.z, bfhi(w_.w) * rstd * g1.w};
              if (ks == 0) {
#pragma unroll
                  for (int j = 0; j < 8; ++j) y0[j] = x[j]; }
              else if (ks == 1) {
#pragma unroll
                  for (int j = 0; j < 8; ++j) y1[j] = x[j];
                  const f32x2* tab = F.ATAB + posq * 16 + 8 * lh; float a0[8], a1[8];
#pragma unroll
                  for (int j = 0; j < 8; ++j) { const f32x2 cs = tab[j]; a0[j] = y0[j] * cs.x - y1[j] * cs.y; a1[j] = y1[j] * cs.x + y0[j] * cs.y; }
                  v4u q0; q0.x = pk2(a0[0], a0[1]); q0.y = pk2(a0[2], a0[3]); q0.z = pk2(a0[4], a0[5]); q0.w = pk2(a0[6], a0[7]); qf[0] = __builtin_bit_cast(bf16x8, q0);
                  v4u q1; q1.x = pk2(a1[0], a1[1]); q1.y = pk2(a1[2], a1[3]); q1.z = pk2(a1[4], a1[5]); q1.w = pk2(a1[6], a1[7]); qf[1] = __builtin_bit_cast(bf16x8, q1); }
              else { v4u qq; qq.x = pk2(x[0], x[1]); qq.y = pk2(x[2], x[3]); qq.z = pk2(x[4], x[5]); qq.w = pk2(x[6], x[7]); qf[ks] = __builtin_bit_cast(bf16x8, qq); } } }
#pragma unroll
        for (int ks = 0; ks < 8; ++ks) asm volatile("" : "+v"(qf[ks]));
        __syncthreads();
        v4u vv[12];
        { const int c8 = (ts & 15) * 8;
#pragma unroll
          for (int i = 0; i < 12; ++i) { const int slot = 32 * i + (ts >> 4), l = l0 - 64 + slot; vv[i] = (v4u){0u, 0u, 0u, 0u};
              if (l >= 0 && l < L) vv[i] = *(const v4u*)(AV + ((size_t)b * SEQ + (size_t)l * dil + p) * 3072 + head * 128 + c8); } }
        f32x16 st[5];
#pragma unroll
        for (int kt = 0; kt < 5; ++kt) { const LAS unsigned char* kp = Lk + (32 * w + 32 * kt + r) * LROW + 16 * lh; f32x16 a = (f32x16){0};
#pragma unroll
            for (int ks = 0; ks < 8; ++ks) { const bf16x8 kf = *(const LAS bf16x8*)(kp + 32 * ks); a = MFMA32(kf, qf[ks], a); }
            st[kt] = a; asm volatile("" ::: "memory"); }
        __syncthreads();
        { const int c8 = (ts & 15) * 8;
#pragma unroll
          for (int i = 0; i < 12; ++i) { const int slot = 32 * i + (ts >> 4); *(LAS v4u*)(Lk + slot * VROW + 2 * c8) = vv[i]; } }
        float mx = -1e30f;
#pragma unroll
        for (int kt = 0; kt < 5; ++kt)
#pragma unroll
            for (int reg = 0; reg < 16; ++reg) { const int lk = l0 + 32 * w - 64 + 32 * kt + (reg & 3) + 8 * (reg >> 2) + 4 * lh; const int rel = lk - lq;
                const bool ok = (lk >= 0) && (lk < L) && (rel <= 64) && (rel >= -64);
                const float s = ok ? st[kt][reg] * 0.08838834764831845f : -1e30f; st[kt][reg] = s; mx = fmaxf(mx, s); }
        mx = fmaxf(mx, __shfl_xor(mx, 32));
        float sum = 0.f;
#pragma unroll
        for (int kt = 0; kt < 5; ++kt)
#pragma unroll
            for (int reg = 0; reg < 16; ++reg) { const float pv = __expf(st[kt][reg] - mx); st[kt][reg] = pv; sum += pv; }
        sum += __shfl_xor(sum, 32);
        bf16x8 pb[5][2];
#pragma unroll
        for (int kt = 0; kt < 5; ++kt)
#pragma unroll
            for (int s = 0; s < 2; ++s) { v4u pk; pk.x = cvtpk(st[kt][8 * s], st[kt][8 * s + 1]); pk.y = cvtpk(st[kt][8 * s + 2], st[kt][8 * s + 3]); pk.z = cvtpk(st[kt][8 * s + 4], st[kt][8 * s + 5]); pk.w = cvtpk(st[kt][8 * s + 6], st[kt][8 * s + 7]);
                pb[kt][s] = __builtin_bit_cast(bf16x8, pk); }
        __syncthreads();
        f32x16 acc[4];
#pragma unroll
        for (int dt = 0; dt < 4; ++dt) acc[dt] = (f32x16){0};
        const LAS unsigned char* vtr = Lk + (32 * w + 4 * lh + ((lane & 15) >> 2)) * VROW + (16 * ((lane >> 4) & 1) + 4 * (lane & 3)) * 2;
#pragma unroll
        for (int kt = 0; kt < 5; ++kt)
#pragma unroll
            for (int s = 0; s < 2; ++s) { asm volatile("" ::: "memory");
#pragma unroll
                for (int dt = 0; dt < 4; ++dt) { const LAS unsigned char* vp = vtr + (32 * kt + 16 * s) * VROW + 64 * dt;
                    const trv4 lo = __builtin_amdgcn_ds_read_tr16_b64_v4i16((LAS trv4*)vp), hi = __builtin_amdgcn_ds_read_tr16_b64_v4i16((LAS trv4*)(vp + 8 * VROW));
                    const bf16x8 av = (bf16x8){lo[0], lo[1], lo[2], lo[3], hi[0], hi[1], hi[2], hi[3]}; acc[dt] = MFMA32(av, pb[kt][s], acc[dt]); } }
        const float inv = 1.0f / sum;
        __syncthreads();
        { LAS unsigned char* ot = Lk + w * (32 * LROW); LAS unsigned char* op = ot + r * LROW + 8 * lh;
#pragma unroll
          for (int dt = 0; dt < 4; ++dt)
#pragma unroll
              for (int q = 0; q < 4; ++q) { v2u o; o.x = cvtpk(acc[dt][4 * q] * inv, acc[dt][4 * q + 1] * inv); o.y = cvtpk(acc[dt][4 * q + 2] * inv, acc[dt][4 * q + 3] * inv); *(LAS v2u*)(op + 64 * dt + 16 * q) = o; }
          LDS_WAIT(); asm volatile("" ::: "memory");
#pragma unroll
          for (int i4 = 0; i4 < 8; ++i4) { const int qr = 4 * i4 + (lane >> 4); const size_t mrow = (size_t)b * SEQ + (size_t)(l0 + 32 * w + qr) * dil + p;
              *(v4u*)(OGN + (size_t)g * NTOK * 1024 + mrow * 1024 + hh * 128 + (lane & 15) * 8) = *(const LAS v4u*)(ot + qr * LROW + (lane & 15) * 16); } }
        if (lh == 0) LSE[(size_t)g * NTOK * 8 + mq * 8 + hh] = mx + __logf(sum);
    }
}

constexpr int KROW = 320;
constexpr int VROW2 = 576;
__device__ __forceinline__ bf16x8 tr_frag(const LAS unsigned char* p, int step_bytes) {
    const trv4 lo = __builtin_amdgcn_ds_read_tr16_b64_v4i16((LAS trv4*)p), hi = __builtin_amdgcn_ds_read_tr16_b64_v4i16((LAS trv4*)(p + step_bytes));
    return (bf16x8){lo[0], lo[1], lo[2], lo[3], hi[0], hi[1], hi[2], hi[3]};
}
__device__ __forceinline__ void ret_phaseA3(Frame& F, bf16* UF, bf16* UB) {
    const bf16* RK = F.PROJ + PO_RK; const bf16* RV = F.PROJ + PO_RV;
    LAS unsigned char* Lv = F.lds + RING_OFF;
    LAS unsigned char* Lk2 = Lv + 128 * VROW2;
    const int tid = F.tid, lane = F.lane, r = lane & 31, lh = lane >> 5, w = F.wave;
    const int ar = (lane & 15) >> 2, ac = 16 * ((lane >> 4) & 1) + 4 * (lane & 3);
    for (int u = F.vcu; u < 512; u += F.G) {
        const int h = u & 7, m0 = (u >> 3) * 128; const float lgf = -expf(F.dec_f[h]), lgb = -expf(F.dec_b[h]);
        v4u gk[4], gv[8];
        { const bf16* kp = RK + (size_t)(m0 + (tid >> 4)) * 1024 + h * 128 + (tid & 15) * 8;
#pragma unroll
          for (int i = 0; i < 4; ++i) gk[i] = *(const v4u*)(kp + (size_t)(32 * i) * 1024);
          const bf16* vp = RV + (size_t)(m0 + (tid >> 5)) * 2048 + h * 256 + (tid & 31) * 8;
#pragma unroll
          for (int i = 0; i < 8; ++i) gv[i] = *(const v4u*)(vp + (size_t)(16 * i) * 2048); }
        BLK_SYNC();
#pragma unroll
        for (int i = 0; i < 8; ++i) *(LAS v4u*)(Lv + ((tid >> 5) + 16 * i) * VROW2 + (tid & 31) * 16) = gv[i];
        f32x16 af[4], ab[4];
#pragma unroll
        for (int dir = 0; dir < 2; ++dir) {
            if (dir) BLK_SYNC();
#pragma unroll
            for (int i = 0; i < 4; ++i) { const int j = (tid >> 4) + 32 * i; const float dc = dir ? __expf(lgb * (float)j) : __expf(lgf * (float)(127 - j)); v4u o;
                o.x = pk2(bflo(gk[i].x) * dc, bfhi(gk[i].x) * dc); o.y = pk2(bflo(gk[i].y) * dc, bfhi(gk[i].y) * dc); o.z = pk2(bflo(gk[i].z) * dc, bfhi(gk[i].z) * dc); o.w = pk2(bflo(gk[i].w) * dc, bfhi(gk[i].w) * dc);
                *(LAS v4u*)(Lk2 + j * KROW + (tid & 15) * 16) = o; }
            BLK_SYNC();
            f32x16 acc[4];
#pragma unroll
            for (int mt = 0; mt < 4; ++mt) acc[mt] = (f32x16){0};
            const LAS unsigned char* kb = Lk2 + (8 * lh + ar) * KROW + ac * 2; const LAS unsigned char* vb = Lv + (8 * lh + ar) * VROW2 + (32 * w + ac) * 2;
#pragma unroll
            for (int ks = 0; ks < 8; ++ks) { const bf16x8 bv = tr_frag(vb + 16 * ks * VROW2, 4 * VROW2);
#pragma unroll
                for (int mt = 0; mt < 4; ++mt) { const bf16x8 a = tr_frag(kb + 16 * ks * KROW + 64 * mt, 4 * KROW); acc[mt] = MFMA32(a, bv, acc[mt]); } }
#pragma unroll
            for (int mt = 0; mt < 4; ++mt) { if (dir) ab[mt] = acc[mt]; else af[mt] = acc[mt]; }
        }
        BLK_SYNC();
        LAS unsigned char* op = Lv + (32 * w + r) * LROW + 8 * lh;
#pragma unroll
        for (int mt = 0; mt < 4; ++mt)
#pragma unroll
            for (int g = 0; g < 4; ++g) { v2u o; o.x = cvtpk(af[mt][4 * g], af[mt][4 * g + 1]); o.y = cvtpk(af[mt][4 * g + 2], af[mt][4 * g + 3]); *(LAS v2u*)(op + 64 * mt + 16 * g) = o; }
        BLK_SYNC();
        tile_out<8>(UF + (size_t)u * 32768, Lv, tid);
        BLK_SYNC();
#pragma unroll
        for (int mt = 0; mt < 4; ++mt)
#pragma unroll
            for (int g = 0; g < 4; ++g) { v2u o; o.x = cvtpk(ab[mt][4 * g], ab[mt][4 * g + 1]); o.y = cvtpk(ab[mt][4 * g + 2], ab[mt][4 * g + 3]); *(LAS v2u*)(op + 64 * mt + 16 * g) = o; }
        BLK_SYNC();
        tile_out<8>(UB + (size_t)u * 32768, Lv, tid);
    }
}

__device__ __forceinline__ void ret_phaseC3(Frame& F, const bf16* SF, const bf16* SB, bf16* RETO) {
    const bf16* QR = F.PROJ + PO_RQ; const bf16* KR = F.PROJ + PO_RK; const bf16* RG = F.PROJ + PO_RG; const bf16* RV = F.PROJ + PO_RV;
    LAS unsigned char* Lq = F.lds + RING_OFF;
    LAS unsigned char* Lx = Lq + 128 * LROW;
    LAS float* red = (LAS float*)(Lx + 128 * VROW2);
    const int tid = F.tid, lane = F.lane, r = lane & 31, lh = lane >> 5, w = F.wave, it = w & 3, eh = w >> 2;
    v4u g[8];
    int u = F.vcu;
    for (; u < 512; u += F.G) {
        const int h = u & 7, m0 = (u >> 3) * 128;
        const float lgf = -expf(F.dec_f[h]), lgb = -expf(F.dec_b[h]);
        int i = 32 * it + r; asm volatile("" : "+v"(i));
        { v4u gq[4], gk[4]; tile_ld<4>(gq, QR + (size_t)m0 * 1024 + h * 128, 1024, tid); tile_ld<4>(gk, KR + (size_t)m0 * 1024 + h * 128, 1024, tid);
          tile_st<4>(gq, Lq, tid); tile_st<4>(gk, Lx, tid); }
        BLK_SYNC();
        tile_ld<8>(g, SF + (size_t)u * 32768, 128, tid);
        const LAS unsigned char* qp = Lq + i * LROW + 16 * lh;
        bf16x8 pb[4][2];
#pragma unroll
        for (int jt = 0; jt < 4; ++jt) { f32x16 st = (f32x16){0}; const LAS unsigned char* kp = Lx + (32 * jt + r) * LROW + 16 * lh;
#pragma unroll
            for (int ks = 0; ks < 8; ++ks) { const bf16x8 kf = *(const LAS bf16x8*)(kp + 32 * ks), qv = *(const LAS bf16x8*)(qp + 32 * ks); st = MFMA32(kf, qv, st); }
#pragma unroll
            for (int reg = 0; reg < 16; ++reg) { const int j = 32 * jt + (reg & 3) + 8 * (reg >> 2) + 4 * lh; const int dd = i - j;
                st[reg] *= __expf(dd >= 0 ? lgf * (float)dd : lgb * (float)(-dd)); }
#pragma unroll
            for (int s = 0; s < 2; ++s) { v4u pk; pk.x = cvtpk(st[8 * s], st[8 * s + 1]); pk.y = cvtpk(st[8 * s + 2], st[8 * s + 3]); pk.z = cvtpk(st[8 * s + 4], st[8 * s + 5]); pk.w = cvtpk(st[8 * s + 6], st[8 * s + 7]);
                pb[jt][s] = __builtin_bit_cast(bf16x8, pk); }
            asm volatile("" ::: "memory"); }
        BLK_SYNC();
        tile_st<8>(g, Lx, tid);
        BLK_SYNC();
        tile_ld<8>(g, SB + (size_t)u * 32768, 128, tid);
        f32x16 acc[4];
#pragma unroll
        for (int et = 0; et < 4; ++et) acc[et] = (f32x16){0};
        const float sfi = __expf(lgf * (float)(i + 1)), sbi = __expf(lgb * (float)(128 - i));
        const LAS unsigned char* xp = Lx + (128 * eh + r) * LROW + 16 * lh;
#pragma unroll
        for (int ks = 0; ks < 8; ++ks) {
            if ((ks & 1) == 0) asm volatile("" ::: "memory");
            const bf16x8 qv = *(const LAS bf16x8*)(qp + 32 * ks);
#pragma unroll
            for (int et = 0; et < 4; ++et) { const bf16x8 a = *(const LAS bf16x8*)(xp + et * 32 * LROW + 32 * ks); acc[et] = MFMA32(a, qv, acc[et]); } }
        { const float rt = sfi / sbi;
#pragma unroll
          for (int et = 0; et < 4; ++et) acc[et] *= rt; }
        BLK_SYNC();
        tile_st<8>(g, Lx, tid);
        BLK_SYNC();
        { const bf16* vp = RV + (size_t)(m0 + (tid >> 5)) * 2048 + h * 256 + (tid & 31) * 8;
#pragma unroll
          for (int x = 0; x < 8; ++x) g[x] = *(const v4u*)(vp + (size_t)(16 * x) * 2048); }
#pragma unroll
        for (int ks = 0; ks < 8; ++ks) {
            if ((ks & 1) == 0) asm volatile("" ::: "memory");
            const bf16x8 qv = *(const LAS bf16x8*)(qp + 32 * ks);
#pragma unroll
            for (int et = 0; et < 4; ++et) { const bf16x8 a = *(const LAS bf16x8*)(xp + et * 32 * LROW + 32 * ks); acc[et] = MFMA32(a, qv, acc[et]); } }
#pragma unroll
        for (int et = 0; et < 4; ++et) acc[et] *= sbi;
        BLK_SYNC();
#pragma unroll
        for (int x = 0; x < 8; ++x) *(LAS v4u*)(Lx + ((tid >> 5) + 16 * x) * VROW2 + (tid & 31) * 16) = g[x];
        BLK_SYNC();
        { const LAS unsigned char* vp = Lx + (4 * lh + ((lane & 15) >> 2)) * VROW2 + (128 * eh + 16 * ((lane >> 4) & 1) + 4 * (lane & 3)) * 2;
#pragma unroll
          for (int jt = 0; jt < 4; ++jt)
#pragma unroll
              for (int s = 0; s < 2; ++s) {
                  asm volatile("" ::: "memory");
#pragma unroll
                  for (int et = 0; et < 4; ++et) { const bf16x8 av = tr_frag(vp + (32 * jt + 16 * s) * VROW2 + 64 * et, 8 * VROW2); acc[et] = MFMA32(av, pb[jt][s], acc[et]); } } }
        float s1 = 0.f, s2 = 0.f;
#pragma unroll
        for (int et = 0; et < 4; ++et)
#pragma unroll
            for (int reg = 0; reg < 16; ++reg) { const float v = acc[et][reg]; s1 += v; s2 += v * v; }
        s1 += __shfl_xor(s1, 32); s2 += __shfl_xor(s2, 32);
        if (lh == 0) { red[(w * 32 + r) * 2] = s1; red[(w * 32 + r) * 2 + 1] = s2; }
        BLK_SYNC();
        { const int ow = w ^ 4; s1 += red[(ow * 32 + r) * 2]; s2 += red[(ow * 32 + r) * 2 + 1]; }
        const float mu = s1 * (1.f / 256.f), var = fmaxf(s2 * (1.f / 256.f) - mu * mu, 0.f), rstd = 1.0f / sqrtf(var + EPS);
        { LAS unsigned char* op = Lx + i * 528 + (128 * eh + 4 * lh) * 2;
#pragma unroll
          for (int et = 0; et < 4; ++et)
#pragma unroll
              for (int gq4 = 0; gq4 < 4; ++gq4) { v2u o; o.x = cvtpk((acc[et][4 * gq4] - mu) * rstd, (acc[et][4 * gq4 + 1] - mu) * rstd); o.y = cvtpk((acc[et][4 * gq4 + 2] - mu) * rstd, (acc[et][4 * gq4 + 3] - mu) * rstd);
                  *(LAS v2u*)(op + (32 * et + 8 * gq4) * 2) = o; } }
        BLK_SYNC();
        { const int c8 = (tid & 31) * 8; const f32x4 g0 = *(const f32x4*)(F.gn_g + h * 256 + c8), g1 = *(const f32x4*)(F.gn_g + h * 256 + c8 + 4);
#pragma unroll
          for (int p8 = 0; p8 < 8; ++p8) { const int row = 16 * p8 + (tid >> 5); const size_t go = (size_t)(m0 + row) * 2048 + h * 256 + c8;
              const v4u x = *(const LAS v4u*)(Lx + row * 528 + c8 * 2), rg = *(const v4u*)(RG + go); v4u o;
              o.x = pk2(bflo(x.x) * g0.x * bflo(rg.x), bfhi(x.x) * g0.y * bfhi(rg.x)); o.y = pk2(bflo(x.y) * g0.z * bflo(rg.y), bfhi(x.y) * g0.w * bfhi(rg.y));
              o.z = pk2(bflo(x.z) * g1.x * bflo(rg.z), bfhi(x.z) * g1.y * bfhi(rg.z)); o.w = pk2(bflo(x.w) * g1.z * bflo(rg.w), bfhi(x.w) * g1.w * bfhi(rg.w));
              *(v4u*)(RETO + go) = o; } }
        BLK_SYNC();
    }
}

typedef int v4i __attribute__((ext_vector_type(4)));
typedef int v16i __attribute__((ext_vector_type(16)));
__device__ __forceinline__ unsigned q4(f32x4 v, float inv, int zp) {
    const int a = (int)rintf(v.x * inv) + zp, b = (int)rintf(v.y * inv) + zp, c = (int)rintf(v.z * inv) + zp, d = (int)rintf(v.w * inv) + zp;
    return (unsigned)(a & 255) | ((unsigned)(b & 255) << 8) | ((unsigned)(c & 255) << 16) | ((unsigned)(d & 255) << 24);
}
__device__ __forceinline__ void conv_tab8(const float* srcT, unsigned char* dst, float* SC, int wv, int nw, int lane) {
#pragma unroll 2
    for (int e = wv; e < NEXP; e += nw) { const f32x4* src = (const f32x4*)(srcT + (size_t)e * DM) + lane;
        f32x4 v[8]; float m = 0.f;
#pragma unroll
        for (int j = 0; j < 8; ++j) { v[j] = __builtin_nontemporal_load(src + 64 * j); m = fmaxf(m, fmaxf(fmaxf(fabsf(v[j].x), fabsf(v[j].y)), fmaxf(fabsf(v[j].z), fabsf(v[j].w)))); }
        m = wave_max(m); const float sc = (m > 0.f) ? m * (1.0f / 127.0f) : 1.0f, inv = 1.0f / sc;
#pragma unroll
        for (int j = 0; j < 8; ++j) *(unsigned*)(dst + ((size_t)j * NEXP + e) * 256 + 4 * lane) = q4(v[j], inv, 0);
        if (lane == 0) SC[e] = sc; }
}
__device__ __forceinline__ int mbcnt64(unsigned long long m) { return __builtin_amdgcn_mbcnt_hi((unsigned)(m >> 32), __builtin_amdgcn_mbcnt_lo((unsigned)m, 0u)); }
__device__ __forceinline__ void peer_sort_pos(int elo, int ehi, int& plo, int& phi) {
    int off = 0, pl = 0, ph = 0; const int rl = elo >> 12, rh = ehi >> 12;
#pragma unroll
    for (int r = 0; r < 4; ++r) { const unsigned long long ml = __ballot(rl == r), mh = __ballot(rh == r);
        const int cl = __builtin_popcountll(ml), ch = __builtin_popcountll(mh); const int bl = off + mbcnt64(ml), bh = off + cl + mbcnt64(mh);
        pl = (rl == r) ? bl : pl; ph = (rh == r) ? bh : ph; off += cl + ch; }
    plo = pl; phi = ph;
}

template <int CTRL> __device__ __forceinline__ int dppi(int x) { return __builtin_amdgcn_mov_dpp(x, CTRL, 0xf, 0xf, true); }
__device__ __forceinline__ int row_sum16(int x) { x += dppi<0xB1>(x); x += dppi<0x4E>(x); x += dppi<0x141>(x); x += dppi<0x128>(x); return x; }

__device__ __forceinline__ void peerUv_fetch(v4u (&ld)[8], float& su, int& kk, const LAS int* sl, const unsigned char* Us, const float* SU, int c, int sub) {
#pragma unroll
    for (int i = 0; i < 8; ++i) { const int e = sl[4 * i + sub] & 16383; ld[i] = *(const v4u*)(Us + (size_t)e * 256 + 16 * c); }
    const int ent = sl[4 * (c & 7) + sub]; kk = ent >> 14; su = SU[ent & 16383];
}
__device__ __forceinline__ void peerUv_consume(const v4u (&ld)[8], const v4u h, float su, int kk, float sh, float* prow, int c) {
    int res = 0;
#pragma unroll
    for (int i = 0; i < 8; ++i) { int d = __builtin_amdgcn_sdot4((int)ld[i].x, (int)h.x, 0, false); d = __builtin_amdgcn_sdot4((int)ld[i].y, (int)h.y, d, false);
        d = __builtin_amdgcn_sdot4((int)ld[i].z, (int)h.z, d, false); d = __builtin_amdgcn_sdot4((int)ld[i].w, (int)h.w, d, false);
        d = row_sum16(d); res = (c == i) ? d : res; }
    if (c < 8) prow[kk] = (float)res * su * sh;
}
__device__ __forceinline__ void peer_U8v(Frame& F, const bf16* H2u, const unsigned long long* RSQ, const unsigned* RMX, const unsigned char* U8, const float* SU, float* PART) {
    const int s = blockIdx.x & 7, rho = blockIdx.x >> 3, nrho = F.G >> 3, TPW = NTOK / nrho, rounds = TPW / 64;
    const int lane = F.lane, c = lane & 15, sub = lane >> 4;
    const unsigned char* Us = U8 + (size_t)s * NEXP * 256; float* PARTs = PART + (size_t)s * NTOK * 128;
    LAS int* slist = (LAS int*)(F.lds + RING_OFF) + F.wave * 1024;
    for (int rd = 0; rd < rounds; ++rd) {
        const int tb = rho * TPW + rd * 64 + F.wave * 8;
        v4u hq[8]; float sh[8];
#pragma unroll
        for (int tt = 0; tt < 8; ++tt) { const size_t o = (size_t)(tb + tt) * 128 + lane; const int elo = F.EIDX[o], ehi = F.EIDX[o + 64]; int plo, phi; peer_sort_pos(elo, ehi, plo, phi);
            slist[tt * 128 + plo] = elo | (lane << 14); slist[tt * 128 + phi] = ehi | ((64 + lane) << 14);
            { const float rmx = __uint_as_float(RMX[tb + tt]), sc = (rmx > 0.f) ? rmx * (1.0f / 127.0f) : 1.0f, inv = 1.0f / sc;
              const bf16* hp = H2u + (size_t)(tb + tt) * DM + 256 * s + 16 * c; const v4u w0 = *(const v4u*)hp, w1 = *(const v4u*)(hp + 8);
              f32x4 f0 = {bflo(w0.x), bfhi(w0.x), bflo(w0.y), bfhi(w0.y)}, f1 = {bflo(w0.z), bfhi(w0.z), bflo(w0.w), bfhi(w0.w)}, f2 = {bflo(w1.x), bfhi(w1.x), bflo(w1.y), bfhi(w1.y)}, f3 = {bflo(w1.z), bfhi(w1.z), bflo(w1.w), bfhi(w1.w)};
              v4u hv; hv.x = q4(f0, inv, 0); hv.y = q4(f1, inv, 0); hv.z = q4(f2, inv, 0); hv.w = q4(f3, inv, 0); hq[tt] = hv;
              sh[tt] = sc / sqrtf((float)RSQ[tb + tt] * (1.0f / (2048.0f * 16777216.0f)) + EPS); } }
        LDS_WAIT(); asm volatile("" ::: "memory");
        const int qx = (rd & 1) ? 3 : 0;
        v4u lA[8], lB[8]; float suA, suB; int kA, kB;
#define PU_F(L, S_, K_, qq_, tt_) peerUv_fetch(L, S_, K_, slist + (tt_) * 128 + 32 * (((qq_) & 3) ^ qx), Us, SU, c, sub)
#define PU_C(L, S_, K_, tt_) peerUv_consume(L, hq[tt_], S_, K_, sh[tt_], PARTs + (size_t)(tb + (tt_)) * 128, c)
        PU_F(lA, suA, kA, 0, 0);
#pragma unroll 1
        for (int qq = 0; qq < 4; ++qq) {
            PU_F(lB, suB, kB, qq, 1); PU_C(lA, suA, kA, 0);
            PU_F(lA, suA, kA, qq, 2); PU_C(lB, suB, kB, 1);
            PU_F(lB, suB, kB, qq, 3); PU_C(lA, suA, kA, 2);
            PU_F(lA, suA, kA, qq, 4); PU_C(lB, suB, kB, 3);
            PU_F(lB, suB, kB, qq, 5); PU_C(lA, suA, kA, 4);
            PU_F(lA, suA, kA, qq, 6); PU_C(lB, suB, kB, 5);
            PU_F(lB, suB, kB, qq, 7); PU_C(lA, suA, kA, 6);
            PU_F(lA, suA, kA, qq + 1, 0); PU_C(lB, suB, kB, 7);
        }
#undef PU_F
#undef PU_C
        LDS_WAIT(); asm volatile("" ::: "memory");
    }
}

__device__ __forceinline__ void tr4(unsigned a, unsigned b, unsigned c, unsigned d, unsigned& o0, unsigned& o1, unsigned& o2, unsigned& o3) {
    const unsigned t0 = __builtin_amdgcn_perm(a, b, 0x01050004u), t1 = __builtin_amdgcn_perm(a, b, 0x03070206u);
    const unsigned t2 = __builtin_amdgcn_perm(c, d, 0x01050004u), t3 = __builtin_amdgcn_perm(c, d, 0x03070206u);
    o0 = __builtin_amdgcn_perm(t0, t2, 0x01000504u); o1 = __builtin_amdgcn_perm(t0, t2, 0x03020706u);
    o2 = __builtin_amdgcn_perm(t1, t3, 0x01000504u); o3 = __builtin_amdgcn_perm(t1, t3, 0x03020706u);
}
__device__ __forceinline__ void peerVd_consume(int (&acc)[16], const v4u (&ld)[8], const unsigned (&wq)[2]) {
#pragma unroll
    for (int blk = 0; blk < 2; ++blk) { const int w = (int)wq[blk]; unsigned t[4];
        tr4(ld[4 * blk].x, ld[4 * blk + 1].x, ld[4 * blk + 2].x, ld[4 * blk + 3].x, t[0], t[1], t[2], t[3]);
#pragma unroll
        for (int j = 0; j < 4; ++j) acc[j] = __builtin_amdgcn_sdot4((int)t[j], w, acc[j], false);
        tr4(ld[4 * blk].y, ld[4 * blk + 1].y, ld[4 * blk + 2].y, ld[4 * blk + 3].y, t[0], t[1], t[2], t[3]);
#pragma unroll
        for (int j = 0; j < 4; ++j) acc[4 + j] = __builtin_amdgcn_sdot4((int)t[j], w, acc[4 + j], false);
        tr4(ld[4 * blk].z, ld[4 * blk + 1].z, ld[4 * blk + 2].z, ld[4 * blk + 3].z, t[0], t[1], t[2], t[3]);
#pragma unroll
        for (int j = 0; j < 4; ++j) acc[8 + j] = __builtin_amdgcn_sdot4((int)t[j], w, acc[8 + j], false);
        tr4(ld[4 * blk].w, ld[4 * blk + 1].w, ld[4 * blk + 2].w, ld[4 * blk + 3].w, t[0], t[1], t[2], t[3]);
#pragma unroll
        for (int j = 0; j < 4; ++j) acc[12 + j] = __builtin_amdgcn_sdot4((int)t[j], w, acc[12 + j], false); }
}
__device__ __forceinline__ void peer_actw(Frame& F, const float* PART, const float* SV, unsigned short* SE16, unsigned char* SWB, float* SWT) {
    const int gw = F.vcu * NWAVES + F.wave, NGW = F.G * NWAVES, lane = F.lane;
#pragma unroll 2
    for (int t = gw; t < NTOK; t += NGW) { const size_t o = (size_t)t * 128 + lane; const int elo = F.EIDX[o], ehi = F.EIDX[o + 64];
        float a0 = 0.f, a1 = 0.f;
#pragma unroll
        for (int sp = 0; sp < 8; ++sp) { a0 += PART[(size_t)sp * NTOK * 128 + o]; a1 += PART[(size_t)sp * NTOK * 128 + o + 64]; }
        a0 = 0.5f * a0 * (1.0f + erff(a0 * 0.70710678118654752f)) * F.GATE[o] * SV[elo]; a1 = 0.5f * a1 * (1.0f + erff(a1 * 0.70710678118654752f)) * F.GATE[o + 64] * SV[ehi];
        const float wm = wave_max(fmaxf(fabsf(a0), fabsf(a1))); const float sc = (wm > 0.f) ? wm * (1.0f / 127.0f) : 1.0f, inv = 1.0f / sc;
        const int q0 = (int)rintf(a0 * inv), q1 = (int)rintf(a1 * inv);
        int plo, phi; peer_sort_pos(elo, ehi, plo, phi);
        SE16[(size_t)t * 128 + plo] = (unsigned short)elo; SE16[(size_t)t * 128 + phi] = (unsigned short)ehi;
        SWB[(size_t)t * 128 + (plo >> 4) * 16 + (plo & 3) * 4 + ((plo >> 2) & 3)] = (unsigned char)q0; SWB[(size_t)t * 128 + (phi >> 4) * 16 + (phi & 3) * 4 + ((phi >> 2) & 3)] = (unsigned char)q1;
        if (lane == 0) SWT[t] = sc; }
}
__device__ __forceinline__ float xsum4(float x) {
    { auto r = __builtin_amdgcn_permlane16_swap(__float_as_uint(x), __float_as_uint(x), false, false); x = __uint_as_float(r[0]) + __uint_as_float(r[1]); }
    { auto r = __builtin_amdgcn_permlane32_swap(__float_as_uint(x), __float_as_uint(x), false, false); x = __uint_as_float(r[0]) + __uint_as_float(r[1]); }
    return x;
}
__device__ __forceinline__ void peerVe_fetch(v4u (&ld)[8], unsigned (&wq)[2], const LAS unsigned short* se, const LAS unsigned* swq, const unsigned char* Vs, int c, int sub) {
#pragma unroll
    for (int i = 0; i < 8; ++i) { const int e = se[4 * i + sub]; ld[i] = *(const v4u*)(Vs + (size_t)e * 256 + 16 * c); }
    wq[0] = swq[sub]; wq[1] = swq[4 + sub];
}
__device__ __forceinline__ void peer_V8d(Frame& F, const float* X1, const unsigned char* V8, const unsigned short* SE16, const unsigned char* SWB, const float* SWT) {
    const int s = blockIdx.x & 7, rho = blockIdx.x >> 3, nrho = F.G >> 3, TPW = NTOK / nrho, rounds = TPW / 32;
    const int lane = F.lane, c = lane & 15, sub = lane >> 4;
    const unsigned char* Vs = V8 + (size_t)s * NEXP * 256;
    LAS unsigned short* sle = (LAS unsigned short*)(F.lds + RING_OFF + F.wave * 1536);
    LAS unsigned char* swb = (LAS unsigned char*)(sle + 512);
    for (int rd = 0; rd < rounds; ++rd) {
        const int tb = rho * TPW + rd * 32 + F.wave * 4;
        int acc[4][16]; float swt[4];
#pragma unroll
        for (int tt = 0; tt < 4; ++tt) { *(LAS unsigned*)(sle + tt * 128 + 2 * lane) = *(const unsigned*)(SE16 + (size_t)(tb + tt) * 128 + 2 * lane);
            if (lane < 32) *(LAS unsigned*)(swb + tt * 128 + 4 * lane) = *(const unsigned*)(SWB + (size_t)(tb + tt) * 128 + 4 * lane);
            swt[tt] = SWT[tb + tt];
#pragma unroll
            for (int k = 0; k < 16; ++k) acc[tt][k] = 0; }
        LDS_WAIT(); asm volatile("" ::: "memory");
        const int qx = (rd & 1) ? 3 : 0;
        v4u lA[8], lB[8]; unsigned wA[2], wB[2];
#define PV_F(L, Wt, qq_, tt_) peerVe_fetch(L, Wt, sle + (tt_) * 128 + 32 * (((qq_) & 3) ^ qx), (const LAS unsigned*)(swb + (tt_) * 128 + 32 * (((qq_) & 3) ^ qx)), Vs, c, sub)
        PV_F(lA, wA, 0, 0);
#pragma unroll 1
        for (int qq = 0; qq < 4; ++qq) {
            PV_F(lB, wB, qq, 1); peerVd_consume(acc[0], lA, wA);
            PV_F(lA, wA, qq, 2); peerVd_consume(acc[1], lB, wB);
            PV_F(lB, wB, qq, 3); peerVd_consume(acc[2], lA, wA);
            PV_F(lA, wA, qq + 1, 0); peerVd_consume(acc[3], lB, wB);
        }
#undef PV_F
#pragma unroll
        for (int tt = 0; tt < 4; ++tt) { float f[16];
#pragma unroll
            for (int k = 0; k < 16; ++k) f[k] = xsum4((float)acc[tt][k] * swt[tt]);
            if (sub == 0) { const size_t oo = (size_t)(tb + tt) * DM + 256 * s + 16 * c;
#pragma unroll
                for (int k4 = 0; k4 < 4; ++k4) { f32x4 o = *(const f32x4*)(X1 + oo + 4 * k4); o.x += f[4 * k4]; o.y += f[4 * k4 + 1]; o.z += f[4 * k4 + 2]; o.w += f[4 * k4 + 3]; *(f32x4*)(F.out + oo + 4 * k4) = o; } } }
        LDS_WAIT(); asm volatile("" ::: "memory");
    }
}


__device__ __forceinline__ int ord_i(float x) { const int b = __builtin_bit_cast(int, x); return b ^ ((b >> 31) & 0x7fffffff); }
__device__ __forceinline__ float ord_f(int k) { return __builtin_bit_cast(float, k ^ ((k >> 31) & 0x7fffffff)); }
__device__ __forceinline__ int imax3(int a, int b, int c) { int r; asm("v_max3_i32 %0, %1, %2, %3" : "=v"(r) : "v"(a), "v"(b), "v"(c)); return r; }
constexpr int TK_MIN = (int)0x80000000;
__device__ __forceinline__ void topk_phase(Frame& F, const bf16* QH, const bf16* QL, const bf16* SKH, const bf16* SKL) {
    const int tid = F.tid, lane = F.lane, r = lane & 31, lh = lane >> 5;
    LAS unsigned char* Lkh = F.lds + RING_OFF;
    LAS unsigned char* Lkl = Lkh + 128 * LROW;
    LAS int* top = (LAS int*)(Lkl + 128 * LROW) + F.wave * 1536;
    LAS int* best = top + 1024;
    for (int task = F.vcu; task < 8 * (NTOK / 256); task += F.G) {
        const int h = task & 7, t0 = ((task >> 3) * 8 + F.wave) * 32;
#pragma unroll 1
        for (int hf = 0; hf < 2; ++hf) {
            __syncthreads();
            { v4u gh[4], gl[4]; tile_ld<4>(gh, SKH + (size_t)(h * 2 + hf) * 16384, 128, tid); tile_ld<4>(gl, SKL + (size_t)(h * 2 + hf) * 16384, 128, tid); tile_st<4>(gh, Lkh, tid); tile_st<4>(gl, Lkl, tid); }
            bf16x8 qh[8], ql[8];
            { const size_t o = (size_t)(t0 + r) * DM + h * 256 + hf * 128 + 8 * lh;
#pragma unroll
              for (int ks = 0; ks < 8; ++ks) { qh[ks] = *(const bf16x8*)(QH + o + 16 * ks); ql[ks] = *(const bf16x8*)(QL + o + 16 * ks); } }
            __syncthreads();
            int pk[64];
#pragma unroll
            for (int kt = 0; kt < 4; ++kt) { f32x16 a = (f32x16){0}; const int ko = (32 * kt + r) * LROW + 16 * lh;
#pragma unroll
                for (int ks = 0; ks < 8; ++ks) { const bf16x8 kh = *(const LAS bf16x8*)(Lkh + ko + 32 * ks), kl = *(const LAS bf16x8*)(Lkl + ko + 32 * ks);
                    a = MFMA32(kl, qh[ks], a); a = MFMA32(kh, ql[ks], a); a = MFMA32(kh, qh[ks], a); }
#pragma unroll
                for (int reg = 0; reg < 16; ++reg) { const int key = 32 * kt + (reg & 3) + 8 * (reg >> 2) + 4 * lh; pk[16 * kt + reg] = (ord_i(a[reg]) & ~127) | (127 - key); }
                asm volatile("" ::: "memory"); }
#pragma unroll 1
            for (int it = 0; it < 16; ++it) {
                int m = imax3(pk[0], pk[1], pk[2]);
#pragma unroll
                for (int i = 3; i < 63; i += 2) m = imax3(m, pk[i], pk[i + 1]);
                m = max(m, pk[63]);
                const int o = __shfl_xor(m, 32); const int W = max(m, o);
                if (lh == 0) top[(hf * 16 + it) * 32 + r] = W;
#pragma unroll
                for (int i = 0; i < 64; ++i) pk[i] = (pk[i] == W) ? TK_MIN : pk[i];
            }
        }
        LDS_WAIT(); asm volatile("" ::: "memory");
        float v1[16], v2[16];
#pragma unroll
        for (int a = 0; a < 16; ++a) { v1[a] = ord_f(top[a * 32 + r] & ~127); v2[a] = ord_f(top[(16 + a) * 32 + r] & ~127); }
        int cp[25];
        { const float s0 = v1[0] + v2[0], s1 = v1[0] + v2[1]; const int c0 = (ord_i(s0) & ~255) | 255, c1 = (ord_i(s1) & ~255) | 254; cp[0] = lh ? c1 : c0; }
        { const float s0 = v1[0] + v2[2], s1 = v1[0] + v2[3]; const int c0 = (ord_i(s0) & ~255) | 253, c1 = (ord_i(s1) & ~255) | 252; cp[1] = lh ? c1 : c0; }
        { const float s0 = v1[0] + v2[4], s1 = v1[0] + v2[5]; const int c0 = (ord_i(s0) & ~255) | 251, c1 = (ord_i(s1) & ~255) | 250; cp[2] = lh ? c1 : c0; }
        { const float s0 = v1[0] + v2[6], s1 = v1[0] + v2[7]; const int c0 = (ord_i(s0) & ~255) | 249, c1 = (ord_i(s1) & ~255) | 248; cp[3] = lh ? c1 : c0; }
        { const float s0 = v1[0] + v2[8], s1 = v1[0] + v2[9]; const int c0 = (ord_i(s0) & ~255) | 247, c1 = (ord_i(s1) & ~255) | 246; cp[4] = lh ? c1 : c0; }
        { const float s0 = v1[0] + v2[10], s1 = v1[0] + v2[11]; const int c0 = (ord_i(s0) & ~255) | 245, c1 = (ord_i(s1) & ~255) | 244; cp[5] = lh ? c1 : c0; }
        { const float s0 = v1[0] + v2[12], s1 = v1[0] + v2[13]; const int c0 = (ord_i(s0) & ~255) | 243, c1 = (ord_i(s1) & ~255) | 242; cp[6] = lh ? c1 : c0; }
        { const float s0 = v1[0] + v2[14], s1 = v1[0] + v2[15]; const int c0 = (ord_i(s0) & ~255) | 241, c1 = (ord_i(s1) & ~255) | 240; cp[7] = lh ? c1 : c0; }
        { const float s0 = v1[1] + v2[0], s1 = v1[1] + v2[1]; const int c0 = (ord_i(s0) & ~255) | 239, c1 = (ord_i(s1) & ~255) | 238; cp[8] = lh ? c1 : c0; }
        { const float s0 = v1[1] + v2[2], s1 = v1[1] + v2[3]; const int c0 = (ord_i(s0) & ~255) | 237, c1 = (ord_i(s1) & ~255) | 236; cp[9] = lh ? c1 : c0; }
        { const float s0 = v1[1] + v2[4], s1 = v1[1] + v2[5]; const int c0 = (ord_i(s0) & ~255) | 235, c1 = (ord_i(s1) & ~255) | 234; cp[10] = lh ? c1 : c0; }
        { const float s0 = v1[1] + v2[6], s1 = v1[1] + v2[7]; const int c0 = (ord_i(s0) & ~255) | 233, c1 = (ord_i(s1) & ~255) | 232; cp[11] = lh ? c1 : c0; }
        { const float s0 = v1[2] + v2[0], s1 = v1[2] + v2[1]; const int c0 = (ord_i(s0) & ~255) | 223, c1 = (ord_i(s1) & ~255) | 222; cp[12] = lh ? c1 : c0; }
        { const float s0 = v1[2] + v2[2], s1 = v1[2] + v2[3]; const int c0 = (ord_i(s0) & ~255) | 221, c1 = (ord_i(s1) & ~255) | 220; cp[13] = lh ? c1 : c0; }
        { const float s0 = v1[2] + v2[4], s1 = v1[3] + v2[0]; const int c0 = (ord_i(s0) & ~255) | 219, c1 = (ord_i(s1) & ~255) | 207; cp[14] = lh ? c1 : c0; }
        { const float s0 = v1[3] + v2[1], s1 = v1[3] + v2[2]; const int c0 = (ord_i(s0) & ~255) | 206, c1 = (ord_i(s1) & ~255) | 205; cp[15] = lh ? c1 : c0; }
        { const float s0 = v1[3] + v2[3], s1 = v1[4] + v2[0]; const int c0 = (ord_i(s0) & ~255) | 204, c1 = (ord_i(s1) & ~255) | 191; cp[16] = lh ? c1 : c0; }
        { const float s0 = v1[4] + v2[1], s1 = v1[4] + v2[2]; const int c0 = (ord_i(s0) & ~255) | 190, c1 = (ord_i(s1) & ~255) | 189; cp[17] = lh ? c1 : c0; }
        { const float s0 = v1[5] + v2[0], s1 = v1[5] + v2[1]; const int c0 = (ord_i(s0) & ~255) | 175, c1 = (ord_i(s1) & ~255) | 174; cp[18] = lh ? c1 : c0; }
        { const float s0 = v1[6] + v2[0], s1 = v1[6] + v2[1]; const int c0 = (ord_i(s0) & ~255) | 159, c1 = (ord_i(s1) & ~255) | 158; cp[19] = lh ? c1 : c0; }
        { const float s0 = v1[7] + v2[0], s1 = v1[7] + v2[1]; const int c0 = (ord_i(s0) & ~255) | 143, c1 = (ord_i(s1) & ~255) | 142; cp[20] = lh ? c1 : c0; }
        { const float s0 = v1[8] + v2[0], s1 = v1[9] + v2[0]; const int c0 = (ord_i(s0) & ~255) | 127, c1 = (ord_i(s1) & ~255) | 111; cp[21] = lh ? c1 : c0; }
        { const float s0 = v1[10] + v2[0], s1 = v1[11] + v2[0]; const int c0 = (ord_i(s0) & ~255) | 95, c1 = (ord_i(s1) & ~255) | 79; cp[22] = lh ? c1 : c0; }
        { const float s0 = v1[12] + v2[0], s1 = v1[13] + v2[0]; const int c0 = (ord_i(s0) & ~255) | 63, c1 = (ord_i(s1) & ~255) | 47; cp[23] = lh ? c1 : c0; }
        { const float s0 = v1[14] + v2[0], s1 = v1[15] + v2[0]; const int c0 = (ord_i(s0) & ~255) | 31, c1 = (ord_i(s1) & ~255) | 15; cp[24] = lh ? c1 : c0; }
#pragma unroll 1
        for (int it = 0; it < 16; ++it) {
            int m = imax3(cp[0], cp[1], cp[2]);
#pragma unroll
            for (int i = 3; i < 25; i += 2) m = imax3(m, cp[i], cp[i + 1]);
            const int o = __shfl_xor(m, 32); const int W = max(m, o);
            if (lh == 0) best[it * 32 + r] = W;
#pragma unroll
            for (int i = 0; i < 25; ++i) cp[i] = (cp[i] == W) ? TK_MIN : cp[i];
        }
        LDS_WAIT(); asm volatile("" ::: "memory");
        float bv[16]; int bp[16];
#pragma unroll
        for (int it = 0; it < 16; ++it) { const int W = best[it * 32 + r]; bv[it] = ord_f(W & ~255); bp[it] = 255 - (W & 255); }
        float den = 0.f, ex[16];
#pragma unroll
        for (int it = 0; it < 16; ++it) { ex[it] = __expf(bv[it] - bv[0]); den += ex[it]; }
        const float inv = 1.0f / den;
        int* ei = F.EIDX + (size_t)(t0 + r) * 128 + h * 16 + 8 * lh; float* go = F.GATE + (size_t)(t0 + r) * 128 + h * 16 + 8 * lh;
        int eo[8]; float gv[8];
#pragma unroll
        for (int j = 0; j < 8; ++j) { const int pA = bp[j], pB = bp[8 + j]; const int p = lh ? pB : pA;
            const int e1 = 127 - (top[(p >> 4) * 32 + r] & 127), e2 = 127 - (top[(16 + (p & 15)) * 32 + r] & 127);
            eo[j] = e1 * 128 + e2; gv[j] = (lh ? ex[8 + j] : ex[j]) * inv; }
        { v4u w; w.x = eo[0]; w.y = eo[1]; w.z = eo[2]; w.w = eo[3]; *(v4u*)ei = w; w.x = eo[4]; w.y = eo[5]; w.z = eo[6]; w.w = eo[7]; *(v4u*)(ei + 4) = w;
          f32x4 g; g.x = gv[0]; g.y = gv[1]; g.z = gv[2]; g.w = gv[3]; *(f32x4*)go = g; g.x = gv[4]; g.y = gv[5]; g.z = gv[6]; g.w = gv[7]; *(f32x4*)(go + 4) = g; }
        LDS_WAIT(); asm volatile("" ::: "memory");
    }
}
struct Args { const float* in[16]; float* out; unsigned char* ws; int ph_lo, ph_hi, li, pad; };
__global__ void __launch_bounds__(NWAVES * 64, 2) layer_fwd(Args args) {
    extern __shared__ __attribute__((aligned(16))) unsigned char lds[];
    Frame F;
    F.lds = (LAS unsigned char*)lds;
    F.MISC = (volatile LAS unsigned*)(F.lds + MISC_OFF);
    F.tid = threadIdx.x; F.lane = F.tid & 63; F.wave = __builtin_amdgcn_readfirstlane(F.tid >> 6);
    F.G = gridDim.x; { const int bx = blockIdx.x; F.vcu = (F.G % 8 == 0) ? (bx % 8) * (F.G / 8) + bx / 8 : bx; }
    unsigned char* ws = args.ws;
    F.ctl = (gu32*)(ws + WS_CTL);
    F.x = args.in[0]; F.mix_g = args.in[1]; F.w_in = args.in[2]; F.dec_f = args.in[3]; F.dec_b = args.in[4]; F.gn_g = args.in[5]; F.w_ret = args.in[6]; F.qn_g = args.in[7];
    F.kn_g = args.in[8]; F.w_att = args.in[9]; F.w_out = args.in[10]; F.ffn_g = args.in[11]; F.w_pq = args.in[12]; F.subk = args.in[13]; F.pu = args.in[14]; F.pv = args.in[15];
    F.out = args.out;
    F.WinT = (bf16*)(ws + WS_WINT); F.WretT = (bf16*)(ws + WS_WRET); F.WattT = (bf16*)(ws + WS_WATT); F.WoutT = (bf16*)(ws + WS_WOUT); F.WqT = (bf16*)(ws + WS_WQ);
    F.XN = (bf16*)(ws + WS_XN); F.PROJ = (bf16*)(ws + WS_PROJ); F.Ubf = (bf16*)(ws + WS_UBF); F.Vbf = (bf16*)(ws + WS_VBF); F.ATT = (bf16*)(ws + WS_ATT);
    F.EIDX = (int*)(ws + WS_EIDX); F.GATE = (float*)(ws + WS_GATE); F.RTAB = (f32x2*)(ws + WS_RTAB); F.ATAB = (f32x2*)(ws + WS_ATAB); F.SKH = (bf16*)(ws + WS_SKH); F.SKL = (bf16*)(ws + WS_SKL);
    bf16* KDF = (bf16*)(ws + WS_WINT); bf16* KDB = KDF + (size_t)512 * 16384; bf16* VT = (bf16*)(ws + WS_WINT + 32 * MiB);
    bf16* UF = F.XN; bf16* UB = (bf16*)(ws + WS_WINT + 32 * MiB);
    bf16* OGN = (bf16*)(ws + WS_UBF + 64 * MiB); float* LSE = (float*)(ws + WS_WINT + 64 * MiB);
    bf16* RETO = KDF;
    bf16* MERGED = F.PROJ + PO_RQ;
    bf16* H2 = F.PROJ + PO_RV;
    float* TMP = (float*)(F.PROJ + PO_AK);
    bf16* QH = (bf16*)TMP; bf16* QL = QH + (size_t)NTOK * DM;
    float* X1 = (float*)(F.PROJ + PO_GR);
    unsigned char* U8 = ws + WS_UBF; unsigned char* V8 = ws + WS_UBF + 32 * MiB; float* SU = (float*)(ws + WS_SU); float* SV = SU + NEXP;
    unsigned long long* RSQ = (unsigned long long*)(SV + NEXP); unsigned* RMX = (unsigned*)(RSQ + NTOK); float* SX = (float*)(RMX + NTOK); unsigned* CMX = (unsigned*)(ws + WS_CTL + 32768);
    unsigned short* SE16 = (unsigned short*)(ws + WS_WINT); unsigned char* SWB = ws + WS_WINT + 2 * MiB; float* SWT = (float*)(ws + WS_WINT + 3 * MiB);
    unsigned long long* SSQ = (unsigned long long*)(ws + WS_UBF + 112 * MiB);
    float* PART = (float*)(ws + WS_WINT + 32 * MiB);
    for (int u = F.tid; u < (LDS_BYTES - LDSCTL_OFF) / 4; u += NWAVES * 64) ((LAS unsigned*)(F.lds + LDSCTL_OFF))[u] = 0u;
    __syncthreads();
    XcdBarrier bar; bar.bar = (unsigned*)(F.ctl + CW_BAR); bar.x = 0; bar.st = nullptr;
    if (N_LAUNCHES == 1) bar = xcd_barrier_post((unsigned*)(F.ctl + CW_BAR), F.MISC + 8);
#define GRID_BAR() do { if (N_LAUNCHES == 1) xcd_barrier(bar); } while (0)
    const int lo = args.ph_lo, hi = args.ph_hi;
#define IN(k) (lo <= (k) && (k) < hi)
#define BOTH(k) (IN(k) && IN((k) + 1))
    if (IN(0)) { { for (int z_ = F.vcu * 512 + F.tid; z_ < 2 * NTOK * 24; z_ += F.G * 512) SSQ[z_] = 0ull; for (int z_ = F.vcu * 512 + F.tid; z_ < NTOK; z_ += F.G * 512) { RSQ[z_] = 0ull; RMX[z_] = 0u; } p0_prologue(F, 0, CMX, SX); VM_WAIT(); __syncthreads(); GRID_BAR(); p0_prologue(F, 1, CMX, SX); VM_WAIT(); __syncthreads(); } if (BOTH(0)) GRID_BAR(); }
    if (IN(1)) { { pg8::Gemm g{F.XN, F.WinT, NTOK, INW, DM / 2}; pg8::StaticOrder S; S.init(NTOK, INW, F.G, (int)blockIdx.x);
        pg8::EpiProj8 E{F.PROJ, SSQ, (const float*)F.RTAB, SX, CMX};
        pg8::gemm_phase<pg8::EpiProj8, pg8::StaticOrder, PG8_ALIGN, PG8_SP2, true, true>(F.lds + RING_OFF, g, S, E);
        { const int nfull = (NTOK / 256) * (INW / 256) % F.G; int wv = F.vcu * NWAVES + F.wave, nw = F.G * NWAVES; bool go = (nfull == 0);
          if (nfull > 0 && (int)blockIdx.x >= nfull) { wv = ((int)blockIdx.x - nfull) * NWAVES + F.wave; nw = (F.G - nfull) * NWAVES; go = true; }
          if (go) { conv_tab8(F.pu, U8, SU, wv, nw, F.lane); conv_tab8(F.pv, V8, SV, wv, nw, F.lane); } }
        } if (BOTH(1)) GRID_BAR(); }
    if (IN(3)) { { ret_phaseA3(F, UF, UB); att_phase3(F, OGN, LSE, SSQ); } if (BOTH(3)) GRID_BAR(); }
    if (IN(4)) { { ret_phaseB(F, UF, UB); att_merge(F, OGN, LSE); } if (BOTH(4)) GRID_BAR(); }
    if (IN(5)) { { ret_phaseC3(F, UF, UB, RETO); } if (BOTH(5)) GRID_BAR(); }
    if (IN(6)) { { pg8::Gemm g{RETO, F.WretT, NTOK, DM, DM}; pg8::StaticOrder S; S.init(NTOK, DM, F.G, (int)blockIdx.x);
        pg8::EpiGateF32 E{TMP, F.PROJ + PO_GR, DM};
        pg8::gemm_phase<pg8::EpiGateF32, pg8::StaticOrder, PG8_ALIGN, PG8_SP2>(F.lds + RING_OFF, g, S, E);
        } VM_WAIT(); __syncthreads(); }
    if (IN(7)) { { pg8::Gemm g{F.ATT, F.WattT, NTOK, DM, 1024}; pg8::StaticOrder S; S.init(NTOK, DM, F.G, (int)blockIdx.x);
        pg8::EpiGateAddBf16 E{MERGED, TMP, F.PROJ + PO_GA, DM};
        pg8::gemm_phase<pg8::EpiGateAddBf16, pg8::StaticOrder, PG8_ALIGN, PG8_SP2>(F.lds + RING_OFF, g, S, E);
        } if (BOTH(7)) GRID_BAR(); }
    if (IN(8)) { { pg8::Gemm g{MERGED, F.WoutT, NTOK, DM, DM}; pg8::StaticOrder S; S.init(NTOK, DM, F.G, (int)blockIdx.x);
        pg8::EpiResNorm E{X1, F.x, H2, F.ffn_g, RSQ, RMX, DM};
        pg8::gemm_phase<pg8::EpiResNorm, pg8::StaticOrder, PG8_ALIGN, PG8_SP2>(F.lds + RING_OFF, g, S, E);
        } if (BOTH(8)) GRID_BAR(); }
    if (IN(10)) { { pg8::Gemm g{H2, F.WqT, NTOK, DM, DM}; pg8::StaticOrder S; S.init(NTOK, DM, F.G, (int)blockIdx.x);
        pg8::EpiHiLoScaled E{QH, QL, RSQ, DM, 1.0f / DM, EPS};
        pg8::gemm_phase<pg8::EpiHiLoScaled, pg8::StaticOrder, PG8_ALIGN, PG8_SP2>(F.lds + RING_OFF, g, S, E);
        } if (BOTH(10)) GRID_BAR(); }
    if (IN(11)) { { topk_phase(F, QH, QL, F.SKH, F.SKL); } if (BOTH(11)) GRID_BAR(); }
    if (IN(12)) { { peer_U8v(F, H2, RSQ, RMX, U8, SU, PART); } if (BOTH(12)) GRID_BAR(); }
    if (IN(13)) { { peer_actw(F, PART, SV, SE16, SWB, SWT); } if (BOTH(13)) GRID_BAR(); }
    if (IN(14)) { { peer_V8d(F, X1, V8, SE16, SWB, SWT); } }
#undef IN
#undef BOTH
}

extern "C" void kernel_launch(void* const* d_in, const int* in_sizes, int n_in, void* d_out, int out_size, void* d_ws, size_t ws_size, hipStream_t stream) {
    static int grid = 0;
    if (grid == 0) {
        if (n_in != 16 || in_sizes[0] != NTOK * DM || out_size != NTOK * DM || ws_size < WS_END) { fprintf(stderr, "kernel_launch: unexpected shapes / workspace (%d inputs, ws %zu)\n", n_in, ws_size); grid = -1; return; }
        int dev = 0, cus = 0, per_cu = 0;
        if (hipGetDevice(&dev) != hipSuccess || hipDeviceGetAttribute(&cus, hipDeviceAttributeMultiprocessorCount, dev) != hipSuccess) { grid = -1; return; }
        if (hipFuncSetAttribute((const void*)layer_fwd, hipFuncAttributeMaxDynamicSharedMemorySize, LDS_BYTES) != hipSuccess) { grid = -1; return; }
        if (hipOccupancyMaxActiveBlocksPerMultiprocessor(&per_cu, (const void*)layer_fwd, NWAVES * 64, LDS_BYTES) != hipSuccess || per_cu < 1) { fprintf(stderr, "kernel_launch: occupancy query says %d\n", per_cu); grid = -1; (void)hipGetLastError(); return; }
        (void)hipGetLastError();
        grid = cus;
    }
    if (grid < 0) return;
    if (hipMemsetAsync((char*)d_ws + WS_CTL, 0, CTL_ZERO_BYTES, stream) != hipSuccess) return;
    Args a{};
    for (int i = 0; i < 16; ++i) a.in[i] = (const float*)d_in[i];
    a.out = (float*)d_out; a.ws = (unsigned char*)d_ws;
    for (int li = 0; li < N_LAUNCHES; ++li) {
        a.ph_lo = (N_LAUNCHES == 1) ? 0 : li; a.ph_hi = (N_LAUNCHES == 1) ? N_PHASES : li + 1; a.li = li;
        hipLaunchKernelGGL(layer_fwd, dim3(grid), dim3(NWAVES * 64), LDS_BYTES, stream, a);
    }
}
```

```cpp
#include <hip/hip_runtime.h>
#include <cstdio>
#include <cstdint>
#include <type_traits>
namespace pg8 {
#define PG8_LAS __attribute__((address_space(3)))
typedef unsigned short bf16_t;
typedef short bf16x8 __attribute__((ext_vector_type(8)));
typedef float f32x4 __attribute__((ext_vector_type(4)));
typedef unsigned u32x4 __attribute__((ext_vector_type(4)));
constexpr int BM = 256, BK = 64, HALF = 128, HTB = HALF * BK * 2  , STAGE_BYTES = 8 * HTB, NXCD = 8, WGM = 8;

__host__ __device__ __forceinline__ int lds_byte(int r, int c) { const int st = (r >> 4) * 2 + (c >> 5), rr = r & 15, cc = c & 31, ob = rr * 64 + cc * 2; return st * 1024 + (ob ^ (((ob >> 9) & 1) << 5)); }
__host__ __device__ __forceinline__ void stage_rc(int b, int& R, int& C) { const int st = b / 1024, sb = b % 1024, swz = sb ^ (((sb >> 9) & 1) << 5); R = (st >> 1) * 16 + swz / 64; C = (st & 1) * 32 + (swz % 64) / 2; }
__host__ __device__ __forceinline__ int perm32(int rho) { const int n = rho >> 4, i = rho & 15; return 8 * (i >> 2) + 4 * n + (i & 3); }

struct Unit { int pm, pn; };
struct Gemm { const bf16_t* A; const bf16_t* Bt; int M, N, K; };

struct StaticOrder {
    int nM, nN, nwg, G, c;
    __host__ __device__ void init(int M, int N, int G_, int c_) { nM = M / BM; nN = N / BM; nwg = nM * nN; G = G_; c = c_; }
    __host__ __device__ bool next(int i, Unit& u) const {
        const long L = (long)i * G + c; if (L >= nwg) return false;
        int wgid = (int)L; { const int q = nwg / NXCD, r = nwg % NXCD, xcd = wgid % NXCD, off = wgid / NXCD; wgid = (xcd < r ? xcd * (q + 1) : r * (q + 1) + (xcd - r) * q) + off; }
        const int nig = WGM * nN, gid = wgid / nig, fm = gid * WGM, gsz = (nM - fm) < WGM ? (nM - fm) : WGM;
        u.pm = fm + ((wgid % nig) % gsz); u.pn = (wgid % nig) / gsz; return true;
    }
    __device__ __forceinline__ void a_ready(const Unit&) const {}
    __device__ __forceinline__ void done(const Unit&) const {}
};

__device__ __forceinline__ unsigned cvt_pk_bf16(float lo, float hi) { unsigned r; asm volatile("v_cvt_pk_bf16_f32 %0, %1, %2" : "=v"(r) : "v"(lo), "v"(hi)); return r; }
typedef int i32x4 __attribute__((ext_vector_type(4)));
__device__ __forceinline__ f32x4 mma16(bf16x8 a, bf16x8 b, f32x4 c) { return __builtin_amdgcn_mfma_f32_16x16x32_bf16(a, b, c, 0, 0, 0); }
__device__ __forceinline__ i32x4 mma16(bf16x8 a, bf16x8 b, i32x4 c) { return __builtin_amdgcn_mfma_i32_16x16x64_i8(__builtin_bit_cast(i32x4, a), __builtin_bit_cast(i32x4, b), c, 0, 0, 0); }
template <class Epi, class Sched, bool ALIGN_EPI = false, bool SP2 = false, bool TILED = false, bool I8 = false>
__device__ __forceinline__ void gemm_phase(PG8_LAS unsigned char* lds, const Gemm g, const Sched& S, const Epi& E) {
    const int tid = threadIdx.x, wid = __builtin_amdgcn_readfirstlane(tid >> 6), lane = tid & 63, wr = wid >> 2, wc = wid & 3, fr = lane & 15, fq = lane >> 4;
    const int K = g.K, nt = K / BK;
    unsigned voffA[2], voffB[2];
#pragma unroll
    for (int i = 0; i < 2; ++i) { int R, C; stage_rc(tid * 16 + i * 8192, R, C); const int Rb = Epi::PERM ? ((R & ~31) + perm32(R & 31)) : R;
        voffA[i] = TILED ? (unsigned)(R * BK + C) * 2u : (unsigned)(R * K + C) * 2u; voffB[i] = TILED ? (unsigned)(Rb * BK + C) * 2u : (unsigned)(Rb * K + C) * 2u; }
    const size_t kstep = TILED ? (size_t)(BM * BK * 2) : (size_t)(BK * 2);
    const size_t hstep = TILED ? (size_t)(HALF * BK * 2) : (size_t)HALF * K * 2;
    const size_t tstep = TILED ? (size_t)K * BM * 2 : 2 * hstep;
    const unsigned ldsw = (unsigned)wid * 1024u;
    const int aoff = lds_byte(wr * 64 + fr, fq * 8), boff = lds_byte(wc * 32 + fr, fq * 8);
#define PG8_SA(b, h) (((b) * 2 + (h)) * HTB)
#define PG8_SB(b, h) ((4 + (b) * 2 + (h)) * HTB)
#define PG8_STAGE(bufoff, gbase, voff) do { _Pragma("unroll") for (int _i = 0; _i < 2; ++_i) \
        __builtin_amdgcn_global_load_lds((const unsigned*)((const char*)(gbase) + (voff)[_i]), (PG8_LAS unsigned*)(lds + (bufoff) + ldsw + _i * 8192), 16, 0, 0); } while (0)
#define PG8_LDA(dst, b, h) do { _Pragma("unroll") for (int m = 0; m < 4; ++m) _Pragma("unroll") for (int k = 0; k < 2; ++k) dst[m][k] = *(const PG8_LAS bf16x8*)(lds + PG8_SA(b, h) + aoff + m * 2048 + k * 1024); } while (0)
#define PG8_LDB(dst, b, h) do { _Pragma("unroll") for (int n = 0; n < 2; ++n) _Pragma("unroll") for (int k = 0; k < 2; ++k) dst[n][k] = *(const PG8_LAS bf16x8*)(lds + PG8_SB(b, h) + boff + n * 2048 + k * 1024); } while (0)
#define PG8_MMA(ai, bj, At, Bt) do { __builtin_amdgcn_s_setprio(1); _Pragma("unroll") for (int m = 0; m < 4; ++m) _Pragma("unroll") for (int n = 0; n < 2; ++n) _Pragma("unroll") for (int k = 0; k < 2; ++k) \
        acc[ai][bj][m][n] = mma16(Bt[n][k], At[m][k], acc[ai][bj][m][n]); __builtin_amdgcn_s_setprio(0); } while (0)
#define PG8_WAIT_V(n) asm volatile("s_waitcnt vmcnt(" #n ")" ::: "memory")
#define PG8_WAIT_L(n) asm volatile("s_waitcnt lgkmcnt(" #n ")" ::: "memory")
#define PG8_BAR __builtin_amdgcn_s_barrier()
#define PG8_SCHED __builtin_amdgcn_sched_barrier(0)
    Unit cur, nxt; int ui = 0;
    if (!S.next(0, cur)) return;
    typedef typename std::conditional<I8, i32x4, f32x4>::type acc_t;
    acc_t acc[2][2][4][2];
#pragma unroll
    for (int a = 0; a < 2; ++a)
#pragma unroll
        for (int b = 0; b < 2; ++b)
#pragma unroll
            for (int m = 0; m < 4; ++m)
#pragma unroll
                for (int n = 0; n < 2; ++n) acc[a][b][m][n] = acc_t{};
    bf16x8 At[4][2], B0[2][2], B1[2][2];
    const char* cA = (const char*)g.A + (size_t)cur.pm * tstep; const char* cB = (const char*)g.Bt + (size_t)cur.pn * tstep;
    S.a_ready(cur);
    if constexpr (SP2) {
        PG8_STAGE(PG8_SB(0, 0), cB, voffB); PG8_STAGE(PG8_SB(0, 1), cB + hstep, voffB); PG8_STAGE(PG8_SA(0, 0), cA, voffA); PG8_STAGE(PG8_SA(0, 1), cA + hstep, voffA);
        if (wr == 1) PG8_BAR;
        PG8_WAIT_V(2); PG8_BAR;
        PG8_STAGE(PG8_SB(1, 0), cB + kstep, voffB); PG8_STAGE(PG8_SA(1, 0), cA + kstep, voffA); PG8_STAGE(PG8_SB(1, 1), cB + hstep + kstep, voffB);
        PG8_WAIT_V(6); PG8_BAR;
    } else {
        PG8_STAGE(PG8_SB(0, 0), cB, voffB); PG8_STAGE(PG8_SA(0, 0), cA, voffA); PG8_STAGE(PG8_SB(0, 1), cB + hstep, voffB); PG8_STAGE(PG8_SA(0, 1), cA + hstep, voffA);
        if (wr == 1) PG8_BAR;
        PG8_WAIT_V(4); PG8_BAR;
        PG8_STAGE(PG8_SB(1, 0), cB + kstep, voffB); PG8_STAGE(PG8_SA(1, 0), cA + kstep, voffA); PG8_STAGE(PG8_SB(1, 1), cB + hstep + kstep, voffB);
        PG8_WAIT_V(6); PG8_BAR;
    }
    for (;;) {
        const bool has_next = S.next(ui + 1, nxt);
        const char* nA = has_next ? (const char*)g.A + (size_t)nxt.pm * tstep : cA; const char* nB = has_next ? (const char*)g.Bt + (size_t)nxt.pn * tstep : cB;
        for (int t = 0; t < nt; t += 2) {
            const bool last = (t == nt - 2);
            const char* a1 = cA + (size_t)(t + 1) * kstep;
            const char* a2 = last ? nA : cA + (size_t)(t + 2) * kstep; const char* b2 = last ? nB : cB + (size_t)(t + 2) * kstep;
            const char* a3 = a2 + kstep; const char* b3 = b2 + kstep;
            if (last && has_next) S.a_ready(nxt);
            if constexpr (SP2) {
            PG8_LDB(B0, 0, 0); PG8_LDB(B1, 0, 1); PG8_SCHED; PG8_LDA(At, 0, 0); PG8_STAGE(PG8_SA(1, 1), a1 + hstep, voffA);
            PG8_WAIT_V(8); PG8_WAIT_L(0); PG8_BAR; PG8_MMA(0, 0, At, B0); PG8_MMA(0, 1, At, B1); PG8_BAR; PG8_SCHED;
            PG8_LDA(At, 0, 1); PG8_STAGE(PG8_SB(0, 0), b2, voffB); PG8_STAGE(PG8_SB(0, 1), b2 + hstep, voffB); PG8_STAGE(PG8_SA(0, 0), a2, voffA);
            PG8_WAIT_V(8); PG8_WAIT_L(0); PG8_BAR; PG8_MMA(1, 0, At, B0); PG8_MMA(1, 1, At, B1); PG8_BAR; PG8_SCHED;
            PG8_LDB(B0, 1, 0); PG8_LDB(B1, 1, 1); PG8_SCHED; PG8_LDA(At, 1, 0); PG8_STAGE(PG8_SA(0, 1), a2 + hstep, voffA);
            PG8_WAIT_V(8); PG8_WAIT_L(0); PG8_BAR; PG8_MMA(0, 0, At, B0); PG8_MMA(0, 1, At, B1); PG8_BAR; PG8_SCHED;
            PG8_LDA(At, 1, 1); PG8_STAGE(PG8_SB(1, 0), b3, voffB); PG8_STAGE(PG8_SB(1, 1), b3 + hstep, voffB); PG8_STAGE(PG8_SA(1, 0), a3, voffA);
            PG8_WAIT_V(8); PG8_WAIT_L(0); PG8_BAR; PG8_MMA(1, 0, At, B0); PG8_MMA(1, 1, At, B1); PG8_BAR; PG8_SCHED;
            } else {
            PG8_LDB(B0, 0, 0); PG8_SCHED; PG8_LDA(At, 0, 0); PG8_STAGE(PG8_SA(1, 1), a1 + hstep, voffA);
            PG8_WAIT_L(8); PG8_BAR; PG8_WAIT_L(0); PG8_MMA(0, 0, At, B0); PG8_BAR; PG8_SCHED;
            PG8_LDB(B1, 0, 1); PG8_STAGE(PG8_SB(0, 0), b2, voffB);
            PG8_BAR; PG8_WAIT_L(0); PG8_MMA(0, 1, At, B1); PG8_BAR;
            PG8_LDA(At, 0, 1); PG8_STAGE(PG8_SA(0, 0), a2, voffA);
            PG8_BAR; PG8_WAIT_L(0); PG8_MMA(1, 0, At, B0); PG8_BAR; PG8_SCHED;
            PG8_STAGE(PG8_SB(0, 1), b2 + hstep, voffB);
            PG8_WAIT_V(6); PG8_BAR; PG8_MMA(1, 1, At, B1); PG8_BAR;
            PG8_LDB(B0, 1, 0); PG8_SCHED; PG8_LDA(At, 1, 0); PG8_STAGE(PG8_SA(0, 1), a2 + hstep, voffA);
            PG8_WAIT_L(8); PG8_BAR; PG8_WAIT_L(0); PG8_MMA(0, 0, At, B0); PG8_BAR; PG8_SCHED;
            PG8_LDB(B1, 1, 1); PG8_STAGE(PG8_SB(1, 0), b3, voffB);
            PG8_BAR; PG8_WAIT_L(0); PG8_MMA(0, 1, At, B1); PG8_BAR;
            PG8_LDA(At, 1, 1); PG8_STAGE(PG8_SA(1, 0), a3, voffA);
            PG8_BAR; PG8_WAIT_L(0); PG8_MMA(1, 0, At, B0); PG8_BAR; PG8_SCHED;
            PG8_STAGE(PG8_SB(1, 1), b3 + hstep, voffB);
            PG8_WAIT_V(6); PG8_BAR; PG8_MMA(1, 1, At, B1); PG8_BAR;
            }
        }
        if constexpr (ALIGN_EPI) { if (wr == 0) PG8_BAR; }
        if constexpr (!Epi::AFTER_DRAIN) { E(acc, cur, wr, wc, fr, fq); S.done(cur); }
        if (!has_next) break;
#pragma unroll
        for (int a = 0; a < 2; ++a)
#pragma unroll
            for (int b = 0; b < 2; ++b)
#pragma unroll
                for (int m = 0; m < 4; ++m)
#pragma unroll
                    for (int n = 0; n < 2; ++n) acc[a][b][m][n] = acc_t{};
        cur = nxt; cA = nA; cB = nB; ++ui;
        if constexpr (ALIGN_EPI) { if (wr == 1) PG8_BAR; }
    }
    PG8_WAIT_V(0);
    if constexpr (!ALIGN_EPI) { if (wr == 0) PG8_BAR; }
    PG8_BAR;
    if constexpr (Epi::AFTER_DRAIN) { E.fused(acc, cur, wr, wc, fr, fq, lds, wid, lane); S.done(cur); }
#undef PG8_SA
#undef PG8_SB
#undef PG8_STAGE
#undef PG8_LDA
#undef PG8_LDB
#undef PG8_MMA
#undef PG8_WAIT_V
#undef PG8_WAIT_L
#undef PG8_BAR
#undef PG8_SCHED
}
}

namespace pg8 {
__device__ __forceinline__ float bf2f_(unsigned short u) { return __builtin_bit_cast(float, (unsigned)u << 16); }
__device__ __forceinline__ float sigmoid_(float x) { return __builtin_amdgcn_rcpf(1.0f + __builtin_amdgcn_exp2f(x * -1.4426950408889634f)); }
struct EpiProj {
    static constexpr bool PERM = true, AFTER_DRAIN = false;
    bf16_t* base;
    unsigned long long* ssq;
    const float* rtab;
    __device__ __forceinline__ void operator()(const f32x4 (&acc)[2][2][4][2], const Unit& u, int wr, int wc, int fr, int fq) const {
        constexpr size_t MT = 8192;
        int colt = u.pn * BM; int width, act = 0; size_t off;
        if (colt < 1024)       { width = 1024; off = 0; }
        else if (colt < 2048)  { colt -= 1024; width = 1024; off = MT * 1024; }
        else if (colt < 4096)  { colt -= 2048; width = 2048; off = MT * 2048; }
        else if (colt < 6144)  { colt -= 4096; width = 2048; off = MT * 4096; act = 1; }
        else if (colt < 9216)  { colt -= 6144; width = 3072; off = MT * 6144; act = 3; }
        else if (colt < 12288) { colt -= 9216; width = 3072; off = MT * 9216; act = 4; }
        else if (colt < 15360) { colt -= 12288; width = 3072; off = MT * 12288; }
        else if (colt < 17408) { colt -= 15360; width = 2048; off = MT * 15360; act = 2; }
        else                   { colt -= 17408; width = 2048; off = MT * 17408; act = 2; }
        const int row0 = u.pm * BM + wr * 64 + fr, col0 = colt + wc * 32 + 8 * fq;
        const bool rot = (u.pn * BM) < 2048; const float rsc = ((u.pn * BM) >= 1024) ? 0.08838834764831845f : 1.0f;
        bf16_t* O = base + off;
#pragma unroll
        for (int ai = 0; ai < 2; ++ai)
#pragma unroll
            for (int m = 0; m < 4; ++m) { bf16_t* rowp = O + (size_t)(row0 + ai * HALF + m * 16) * width + col0;
#pragma unroll
                for (int bj = 0; bj < 2; ++bj) { f32x4 v0 = acc[ai][bj][m][0], v1 = acc[ai][bj][m][1];
                    if (rot) { const int pos = (row0 + ai * HALF + m * 16) & 4095; const float* tp = rtab + ((size_t)pos * 64 + 16 * wc + 4 * fq) * 2;
                        const f32x4 c0 = *(const f32x4*)tp, c1 = *(const f32x4*)(tp + 4);
                        const float a0 = v0[0] * c0[0] - v0[1] * c0[1], b0 = v0[1] * c0[0] + v0[0] * c0[1], a1 = v0[2] * c0[2] - v0[3] * c0[3], b1 = v0[3] * c0[2] + v0[2] * c0[3];
                        const float a2 = v1[0] * c1[0] - v1[1] * c1[1], b2 = v1[1] * c1[0] + v1[0] * c1[1], a3 = v1[2] * c1[2] - v1[3] * c1[3], b3 = v1[3] * c1[2] + v1[2] * c1[3];
                        v0[0] = a0 * rsc; v0[1] = b0 * rsc; v0[2] = a1 * rsc; v0[3] = b1 * rsc; v1[0] = a2 * rsc; v1[1] = b2 * rsc; v1[2] = a3 * rsc; v1[3] = b3 * rsc; }
                    if (act >= 3) {
                        float ss = (v0[0] * v0[0] + v0[1] * v0[1]) + (v0[2] * v0[2] + v0[3] * v0[3]) + (v1[0] * v1[0] + v1[1] * v1[1]) + (v1[2] * v1[2] + v1[3] * v1[3]);
                        { auto r1 = __builtin_amdgcn_permlane16_swap(__float_as_uint(ss), __float_as_uint(ss), false, false); ss = __uint_as_float(r1[0]) + __uint_as_float(r1[1]); }
                        { auto r2 = __builtin_amdgcn_permlane32_swap(__float_as_uint(ss), __float_as_uint(ss), false, false); ss = __uint_as_float(r2[0]) + __uint_as_float(r2[1]); }
                        if (fq == 0) atomicAdd(ssq + ((size_t)(act - 3) * MT + (row0 + ai * HALF + m * 16)) * 24 + (colt >> 7) + bj, (unsigned long long)(ss * 16777216.0f + 0.5f)); }
                    if (act == 1) {
#pragma unroll
                        for (int e = 0; e < 4; ++e) { v0[e] = v0[e] * sigmoid_(v0[e]); v1[e] = v1[e] * sigmoid_(v1[e]); } }
                    else if (act == 2) {
#pragma unroll
                        for (int e = 0; e < 4; ++e) { v0[e] = sigmoid_(v0[e]); v1[e] = sigmoid_(v1[e]); } }
                    u32x4 w; w.x = cvt_pk_bf16(v0[0], v0[1]); w.y = cvt_pk_bf16(v0[2], v0[3]); w.z = cvt_pk_bf16(v1[0], v1[1]); w.w = cvt_pk_bf16(v1[2], v1[3]);
                    __builtin_nontemporal_store(w, (u32x4*)(rowp + bj * HALF)); } }
    }
};
struct EpiProj8 {
    static constexpr bool PERM = true, AFTER_DRAIN = false;
    bf16_t* base;
    unsigned long long* ssq;
    const float* rtab;
#ifdef PROBE_GEMM
    int mode;
#else
    static constexpr int mode = 0;
#endif
    const float* sx; const unsigned* cmx;
    __device__ __forceinline__ void operator()(const i32x4 (&acc)[2][2][4][2], const Unit& u, int wr, int wc, int fr, int fq) const {
        if (mode == 1) return;
        constexpr size_t MT = 8192; const int gcol0 = u.pn * BM + wc * 32 + 8 * fq;
        int colt = u.pn * BM; int width, act = 0; size_t off;
        if (colt < 1024)       { width = 1024; off = 0; }
        else if (colt < 2048)  { colt -= 1024; width = 1024; off = MT * 1024; }
        else if (colt < 4096)  { colt -= 2048; width = 2048; off = MT * 2048; }
        else if (colt < 6144)  { colt -= 4096; width = 2048; off = MT * 4096; act = 1; }
        else if (colt < 9216)  { colt -= 6144; width = 3072; off = MT * 6144; act = 3; }
        else if (colt < 12288) { colt -= 9216; width = 3072; off = MT * 9216; act = 4; }
        else if (colt < 15360) { colt -= 12288; width = 3072; off = MT * 12288; }
        else if (colt < 17408) { colt -= 15360; width = 2048; off = MT * 15360; act = 2; }
        else                   { colt -= 17408; width = 2048; off = MT * 17408; act = 2; }
        const int row0 = u.pm * BM + wr * 64 + fr, col0 = colt + wc * 32 + 8 * fq;
        const bool rot = (u.pn * BM) < 2048; const float rsc = ((u.pn * BM) >= 1024) ? 0.08838834764831845f : 1.0f;
        bf16_t* O = base + off;
        f32x4 cw[2][2]; float sr[2][4];
#pragma unroll
        for (int bj = 0; bj < 2; ++bj)
#pragma unroll
            for (int n = 0; n < 2; ++n) { const u32x4 cb = *(const u32x4*)(cmx + gcol0 + bj * HALF + 4 * n); cw[bj][n] = (f32x4){__uint_as_float(cb.x), __uint_as_float(cb.y), __uint_as_float(cb.z), __uint_as_float(cb.w)} * (1.0f / 127.0f); }
#pragma unroll
        for (int ai = 0; ai < 2; ++ai)
#pragma unroll
            for (int m = 0; m < 4; ++m) sr[ai][m] = sx[row0 + ai * HALF + m * 16];
#pragma unroll
        for (int ai = 0; ai < 2; ++ai) {
            f32x4 c0[4], c1[4];
            if (rot) {
#pragma unroll
                for (int m = 0; m < 4; ++m) { const int pos = (row0 + ai * HALF + m * 16) & 4095; const float* tp = rtab + ((size_t)pos * 64 + 16 * wc + 4 * fq) * 2;
                    c0[m] = *(const f32x4*)tp; c1[m] = *(const f32x4*)(tp + 4); } }
#pragma unroll
            for (int m = 0; m < 4; ++m) { bf16_t* rowp = O + (size_t)(row0 + ai * HALF + m * 16) * width + col0;
#pragma unroll
                for (int bj = 0; bj < 2; ++bj) { const i32x4 a0 = acc[ai][bj][m][0], a1 = acc[ai][bj][m][1];
                    f32x4 v0 = (f32x4){(float)a0[0], (float)a0[1], (float)a0[2], (float)a0[3]} * cw[bj][0] * sr[ai][m], v1 = (f32x4){(float)a1[0], (float)a1[1], (float)a1[2], (float)a1[3]} * cw[bj][1] * sr[ai][m];
                    if (rot) { const f32x4 d0 = c0[m], d1 = c1[m];
                        const float p0 = v0[0] * d0[0] - v0[1] * d0[1], q0 = v0[1] * d0[0] + v0[0] * d0[1], p1 = v0[2] * d0[2] - v0[3] * d0[3], q1 = v0[3] * d0[2] + v0[2] * d0[3];
                        const float p2 = v1[0] * d1[0] - v1[1] * d1[1], q2 = v1[1] * d1[0] + v1[0] * d1[1], p3 = v1[2] * d1[2] - v1[3] * d1[3], q3 = v1[3] * d1[2] + v1[2] * d1[3];
                        v0[0] = p0 * rsc; v0[1] = q0 * rsc; v0[2] = p1 * rsc; v0[3] = q1 * rsc; v1[0] = p2 * rsc; v1[1] = q2 * rsc; v1[2] = p3 * rsc; v1[3] = q3 * rsc; }
                    if (act >= 3) {
                        float ss = (v0[0] * v0[0] + v0[1] * v0[1]) + (v0[2] * v0[2] + v0[3] * v0[3]) + (v1[0] * v1[0] + v1[1] * v1[1]) + (v1[2] * v1[2] + v1[3] * v1[3]);
                        { auto r1 = __builtin_amdgcn_permlane16_swap(__float_as_uint(ss), __float_as_uint(ss), false, false); ss = __uint_as_float(r1[0]) + __uint_as_float(r1[1]); }
                        { auto r2 = __builtin_amdgcn_permlane32_swap(__float_as_uint(ss), __float_as_uint(ss), false, false); ss = __uint_as_float(r2[0]) + __uint_as_float(r2[1]); }
                        if (fq == 0 && mode == 0) atomicAdd(ssq + ((size_t)(act - 3) * MT + (row0 + ai * HALF + m * 16)) * 24 + (colt >> 7) + bj, (unsigned long long)(ss * 16777216.0f + 0.5f)); }
                    if (act == 1) {
#pragma unroll
                        for (int e = 0; e < 4; ++e) { v0[e] = v0[e] * sigmoid_(v0[e]); v1[e] = v1[e] * sigmoid_(v1[e]); } }
                    else if (act == 2) {
#pragma unroll
                        for (int e = 0; e < 4; ++e) { v0[e] = sigmoid_(v0[e]); v1[e] = sigmoid_(v1[e]); } }
                    u32x4 w; w.x = cvt_pk_bf16(v0[0], v0[1]); w.y = cvt_pk_bf16(v0[2], v0[3]); w.z = cvt_pk_bf16(v1[0], v1[1]); w.w = cvt_pk_bf16(v1[2], v1[3]);
                    if (mode == 4) asm volatile("" :: "v"(w.x), "v"(w.y), "v"(w.z), "v"(w.w)); else
                    __builtin_nontemporal_store(w, (u32x4*)(rowp + bj * HALF)); } } }
    }
};
struct EpiGateF32 {
    static constexpr bool PERM = false, AFTER_DRAIN = false;
    float* C; const bf16_t* gate; int ldc;
    __device__ __forceinline__ void operator()(const f32x4 (&acc)[2][2][4][2], const Unit& u, int wr, int wc, int fr, int fq) const {
        const int row0 = u.pm * BM + wr * 64 + fr, col0 = u.pn * BM + wc * 32 + 4 * fq;
#pragma unroll
        for (int ai = 0; ai < 2; ++ai)
#pragma unroll
            for (int m = 0; m < 4; ++m) { const size_t ro = (size_t)(row0 + ai * HALF + m * 16) * ldc + col0;
#pragma unroll
                for (int bj = 0; bj < 2; ++bj)
#pragma unroll
                    for (int n = 0; n < 2; ++n) { const size_t o = ro + bj * HALF + n * 16; const unsigned long long gb = *(const unsigned long long*)(gate + o);
                        f32x4 g; g[0] = bf2f_((unsigned short)gb); g[1] = bf2f_((unsigned short)(gb >> 16)); g[2] = bf2f_((unsigned short)(gb >> 32)); g[3] = bf2f_((unsigned short)(gb >> 48));
                        *(f32x4*)(C + o) = acc[ai][bj][m][n] * g; } }
    }
};
struct EpiGateAddBf16 {
    static constexpr bool PERM = false, AFTER_DRAIN = false;
    bf16_t* O; const float* prev; const bf16_t* gate; int ldc;
    __device__ __forceinline__ void operator()(const f32x4 (&acc)[2][2][4][2], const Unit& u, int wr, int wc, int fr, int fq) const {
        const int row0 = u.pm * BM + wr * 64 + fr, col0 = u.pn * BM + wc * 32 + 4 * fq;
#pragma unroll
        for (int ai = 0; ai < 2; ++ai)
#pragma unroll
            for (int m = 0; m < 4; ++m) { const size_t ro = (size_t)(row0 + ai * HALF + m * 16) * ldc + col0;
#pragma unroll
                for (int bj = 0; bj < 2; ++bj)
#pragma unroll
                    for (int n = 0; n < 2; ++n) { const size_t o = ro + bj * HALF + n * 16; const unsigned long long gb = *(const unsigned long long*)(gate + o);
                        f32x4 g; g[0] = bf2f_((unsigned short)gb); g[1] = bf2f_((unsigned short)(gb >> 16)); g[2] = bf2f_((unsigned short)(gb >> 32)); g[3] = bf2f_((unsigned short)(gb >> 48));
                        const f32x4 r = *(const f32x4*)(prev + o) + acc[ai][bj][m][n] * g;
                        unsigned long long w = (unsigned long long)cvt_pk_bf16(r[0], r[1]) | ((unsigned long long)cvt_pk_bf16(r[2], r[3]) << 32);
                        *(unsigned long long*)(O + o) = w; } }
    }
};
struct EpiResNorm {
    static constexpr bool PERM = false, AFTER_DRAIN = false;
    float* C; const float* res; bf16_t* H2u; const float* g; unsigned long long* RSQ; unsigned* RMX; int ldc;
    __device__ __forceinline__ void operator()(const f32x4 (&acc)[2][2][4][2], const Unit& u, int wr, int wc, int fr, int fq) const {
        const int row0 = u.pm * BM + wr * 64 + fr, col0 = u.pn * BM + wc * 32 + 4 * fq;
        f32x4 gv[2][2];
#pragma unroll
        for (int bj = 0; bj < 2; ++bj)
#pragma unroll
            for (int n = 0; n < 2; ++n) gv[bj][n] = *(const f32x4*)(g + col0 + bj * HALF + n * 16);
#pragma unroll
        for (int ai = 0; ai < 2; ++ai)
#pragma unroll
            for (int m = 0; m < 4; ++m) { const int row = row0 + ai * HALF + m * 16; const size_t ro = (size_t)row * ldc + col0; float ss = 0.f, mx = 0.f;
#pragma unroll
                for (int bj = 0; bj < 2; ++bj)
#pragma unroll
                    for (int n = 0; n < 2; ++n) { const size_t o = ro + bj * HALF + n * 16;
                        const f32x4 r = acc[ai][bj][m][n] + *(const f32x4*)(res + o);
                        *(f32x4*)(C + o) = r; ss += (r[0] * r[0] + r[1] * r[1]) + (r[2] * r[2] + r[3] * r[3]);
                        const f32x4 h = r * gv[bj][n]; mx = fmaxf(fmaxf(mx, fmaxf(fabsf(h[0]), fabsf(h[1]))), fmaxf(fabsf(h[2]), fabsf(h[3])));
                        *(unsigned long long*)(H2u + o) = (unsigned long long)cvt_pk_bf16(h[0], h[1]) | ((unsigned long long)cvt_pk_bf16(h[2], h[3]) << 32); }
                { auto r1 = __builtin_amdgcn_permlane16_swap(__float_as_uint(ss), __float_as_uint(ss), false, false); ss = __uint_as_float(r1[0]) + __uint_as_float(r1[1]); }
                { auto r2 = __builtin_amdgcn_permlane32_swap(__float_as_uint(ss), __float_as_uint(ss), false, false); ss = __uint_as_float(r2[0]) + __uint_as_float(r2[1]); }
                { auto r1 = __builtin_amdgcn_permlane16_swap(__float_as_uint(mx), __float_as_uint(mx), false, false); mx = fmaxf(__uint_as_float(r1[0]), __uint_as_float(r1[1])); }
                { auto r2 = __builtin_amdgcn_permlane32_swap(__float_as_uint(mx), __float_as_uint(mx), false, false); mx = fmaxf(__uint_as_float(r2[0]), __uint_as_float(r2[1])); }
                if (fq == 0) { atomicAdd(RSQ + row, (unsigned long long)(ss * 16777216.0f + 0.5f)); atomicMax(RMX + row, __float_as_uint(mx)); } }
    }
};
struct EpiHiLoScaled {
    static constexpr bool PERM = true, AFTER_DRAIN = false;
    bf16_t* H; bf16_t* L; const unsigned long long* RSQ; int ldc; float inv_n, eps;
    __device__ __forceinline__ void operator()(const f32x4 (&acc)[2][2][4][2], const Unit& u, int wr, int wc, int fr, int fq) const {
        const int row0 = u.pm * BM + wr * 64 + fr, col0 = u.pn * BM + wc * 32 + 8 * fq;
#pragma unroll
        for (int ai = 0; ai < 2; ++ai)
#pragma unroll
            for (int m = 0; m < 4; ++m) { const int row = row0 + ai * HALF + m * 16; const size_t ro = (size_t)row * ldc + col0;
                const float rs = 1.0f / sqrtf((float)RSQ[row] * (inv_n * (1.0f / 16777216.0f)) + eps);
#pragma unroll
                for (int bj = 0; bj < 2; ++bj) { const f32x4 v0 = acc[ai][bj][m][0] * rs, v1 = acc[ai][bj][m][1] * rs;
                    u32x4 wh; wh.x = cvt_pk_bf16(v0[0], v0[1]); wh.y = cvt_pk_bf16(v0[2], v0[3]); wh.z = cvt_pk_bf16(v1[0], v1[1]); wh.w = cvt_pk_bf16(v1[2], v1[3]);
                    u32x4 wl;
                    wl.x = cvt_pk_bf16(v0[0] - __builtin_bit_cast(float, wh.x << 16), v0[1] - __builtin_bit_cast(float, wh.x & 0xffff0000u));
                    wl.y = cvt_pk_bf16(v0[2] - __builtin_bit_cast(float, wh.y << 16), v0[3] - __builtin_bit_cast(float, wh.y & 0xffff0000u));
                    wl.z = cvt_pk_bf16(v1[0] - __builtin_bit_cast(float, wh.z << 16), v1[1] - __builtin_bit_cast(float, wh.z & 0xffff0000u));
                    wl.w = cvt_pk_bf16(v1[2] - __builtin_bit_cast(float, wh.w << 16), v1[3] - __builtin_bit_cast(float, wh.w & 0xffff0000u));
                    *(u32x4*)(H + ro + bj * HALF) = wh; *(u32x4*)(L + ro + bj * HALF) = wl; } }
    }
};
}
#ifndef PG8_SP2
#define PG8_SP2 true
#endif
#ifndef PG8_ALIGN
#define PG8_ALIGN true
#endif

constexpr int NWAVES = 8;
constexpr int NTOK = 8192, SEQ = 4096, DM = 2048, INW = 19456;
constexpr int NEXP = 16384;
constexpr float EPS = 1e-6f;
#ifndef MK_N_LAUNCHES
#define MK_N_LAUNCHES 1
#endif
constexpr int N_PHASES = 15;
constexpr int N_LAUNCHES = MK_N_LAUNCHES;

constexpr size_t MiB = 1u << 20;
constexpr size_t WS_CTL = 0, CTL_ZERO_BYTES = 114688;
constexpr size_t WS_WINT = 1 * MiB;
constexpr size_t WS_WRET = 77 * MiB;
constexpr size_t WS_WATT = 85 * MiB;
constexpr size_t WS_WOUT = 89 * MiB;
constexpr size_t WS_WQ   = 97 * MiB;
constexpr size_t WS_XN   = 105 * MiB;
constexpr size_t WS_PROJ = 137 * MiB;
constexpr size_t WS_UBF  = 441 * MiB;
constexpr size_t WS_VBF  = 505 * MiB;
constexpr size_t WS_ATT  = 569 * MiB;
constexpr size_t WS_EIDX = 585 * MiB;
constexpr size_t WS_GATE = 589 * MiB;
constexpr size_t WS_RTAB = 593 * MiB;
constexpr size_t WS_ATAB = 595 * MiB;
constexpr size_t WS_SKH  = 596 * MiB;
constexpr size_t WS_SKL  = 596 * MiB + 512 * 1024;
constexpr size_t WS_SU   = 597 * MiB;
constexpr size_t WS_END  = 598 * MiB;
constexpr size_t PO_RQ = 0, PO_RK = (size_t)NTOK * 1024, PO_RV = (size_t)NTOK * 2048, PO_RG = (size_t)NTOK * 4096, PO_AQ = (size_t)NTOK * 6144,
                 PO_AK = (size_t)NTOK * 9216, PO_AV = (size_t)NTOK * 12288, PO_GR = (size_t)NTOK * 15360, PO_GA = (size_t)NTOK * 17408;
constexpr int CW_BAR = 4096;

constexpr int RING_OFF = 0, RING_BYTES = 131072;
constexpr int LDSCTL_OFF = RING_BYTES, MISC_OFF = LDSCTL_OFF + 320;
constexpr int LDS_BYTES = 147456;

#define GAS __attribute__((address_space(1)))
#define LAS __attribute__((address_space(3)))
typedef unsigned short bf16;
typedef unsigned v4u __attribute__((ext_vector_type(4)));
typedef unsigned v2u __attribute__((ext_vector_type(2)));
typedef float f32x4 __attribute__((ext_vector_type(4)));
typedef float f32x2 __attribute__((ext_vector_type(2)));
typedef GAS unsigned gu32;
#define RLX_AGENT __ATOMIC_RELAXED, __HIP_MEMORY_SCOPE_AGENT
#define LDS_WAIT() asm volatile("s_waitcnt lgkmcnt(0)" ::: "memory")
#define VM_WAIT() asm volatile("s_waitcnt vmcnt(0)" ::: "memory")
__device__ __forceinline__ unsigned f2bf(float f) { unsigned u = __builtin_bit_cast(unsigned, f); return (u + 0x7fffu + ((u >> 16) & 1u)) >> 16; }
__device__ __forceinline__ unsigned pk2(float lo, float hi) { unsigned r; asm("v_cvt_pk_bf16_f32 %0, %1, %2" : "=v"(r) : "v"(lo), "v"(hi)); return r; }
__device__ __forceinline__ float bf2f(unsigned u16) { return __builtin_bit_cast(float, u16 << 16); }
__device__ __forceinline__ float bflo(unsigned w) { return __builtin_bit_cast(float, w << 16); }
__device__ __forceinline__ float bfhi(unsigned w) { return __builtin_bit_cast(float, w & 0xffff0000u); }
__device__ __forceinline__ float wave_sum(float v) {
#pragma unroll
    for (int o = 1; o < 64; o <<= 1) v += __shfl_xor(v, o);
    return v;
}
__device__ __forceinline__ float wave_max(float v) {
#pragma unroll
    for (int o = 1; o < 64; o <<= 1) v = fmaxf(v, __shfl_xor(v, o));
    return v;
}

#ifndef CONV_R10
#define CONV_R10 11
#endif
#ifndef CONV_PRE
#define CONV_PRE 1
#endif
#define XB_TMO      128
#define XB_XCNT(j)  (256  + 64 * (j))
#define XB_XSUB(j)  (1280 + 64 * (j))
#define XB_XGEN(j)  (2304 + 64 * (j))
#define XB_TOP      3328
#define XB_TOPGEN   3392
#define XCD_BAR_WORDS 3456
#define XB_SPIN_CAP (1u << 24)

__device__ __forceinline__ unsigned xb_ld(unsigned* p)              { return __hip_atomic_load(p, __ATOMIC_RELAXED, __HIP_MEMORY_SCOPE_AGENT); }
__device__ __forceinline__ unsigned xb_add(unsigned* p, unsigned v) { return __hip_atomic_fetch_add(p, v, __ATOMIC_RELAXED, __HIP_MEMORY_SCOPE_AGENT); }
__device__ __forceinline__ unsigned xb_xcc_id() { return (unsigned)__builtin_amdgcn_s_getreg((3 << 11) | 20) & 0xFu; }
#define XB_SPIN(cond, bar) do { unsigned _sp = 0; while (cond) { __builtin_amdgcn_s_sleep(1); \
    if ((++_sp & 255u) == 0u) { if (xb_ld(&(bar)[XB_TMO])) break; if (_sp > XB_SPIN_CAP) { atomicAdd(&(bar)[XB_TMO], 1u); break; } } } } while (0)

struct XcdBarrier {
    unsigned* bar; unsigned x;
    volatile LAS unsigned* st;
};

__device__ __forceinline__ XcdBarrier xcd_barrier_post(unsigned* bar, volatile LAS unsigned* st) {
    XcdBarrier b; b.bar = bar; b.x = xb_xcc_id(); b.st = st;
    if (threadIdx.x == 0) (void)xb_add(&bar[XB_XCNT(b.x)], 1u);
    return b;
}
__device__ __forceinline__ void xcd_barrier_complete(unsigned* bar, unsigned x, unsigned& nloc, unsigned& nx) {
    const unsigned G = gridDim.x * gridDim.y * gridDim.z;
    unsigned sum, cnt, mine, sp = 0u;
    for (;;) {
        sum = 0u; cnt = 0u; mine = 0u;
#pragma unroll
        for (unsigned j = 0; j < 16; ++j) { const unsigned c = xb_ld(&bar[XB_XCNT(j)]); sum += c; cnt += (c > 0u) ? 1u : 0u; mine = (j == x) ? c : mine; }
        if (sum == G) break;
        __builtin_amdgcn_s_sleep(1);
        if ((++sp & 255u) == 0u) { if (xb_ld(&bar[XB_TMO])) break; if (sp > XB_SPIN_CAP) { atomicAdd(&bar[XB_TMO], 1u); break; } }
    }
    nloc = mine > 0u ? mine : 1u; nx = cnt > 0u ? cnt : 1u;
}

__device__ __forceinline__ void xcd_barrier(const XcdBarrier& b) {
    asm volatile("s_waitcnt vmcnt(0)" ::: "memory");
    __syncthreads();
    if (threadIdx.x == 0) {
        unsigned* bar = b.bar;
        __builtin_amdgcn_s_waitcnt(0);
        unsigned nloc = b.st[0], nx = b.st[1];
        if (nloc == 0u) { xcd_barrier_complete(bar, b.x, nloc, nx); b.st[0] = nloc; b.st[1] = nx; }
        const unsigned old = xb_add(&bar[XB_XSUB(b.x)], 1u);
        const unsigned gen = old / nloc;
        if (old + 1u == (gen + 1u) * nloc) {
            __builtin_amdgcn_fence(__ATOMIC_RELEASE, "agent");
            asm volatile("s_waitcnt vmcnt(0)" ::: "memory");
            const unsigned og = xb_add(&bar[XB_TOP], 1u);
            const unsigned tg = og / nx;
            if (og + 1u == (tg + 1u) * nx) xb_add(&bar[XB_TOPGEN], 1u);
            else XB_SPIN(xb_ld(&bar[XB_TOPGEN]) == tg, bar);
            __builtin_amdgcn_fence(__ATOMIC_ACQUIRE, "agent");
            xb_add(&bar[XB_XGEN(b.x)], 1u);
            asm volatile("s_waitcnt vmcnt(0)" ::: "memory");
        } else {
            XB_SPIN(xb_ld(&bar[XB_XGEN(b.x)]) == gen, bar);
            __builtin_amdgcn_fence(__ATOMIC_ACQUIRE, "agent");
            asm volatile("s_waitcnt vmcnt(0)" ::: "memory");
        }
    }
    __syncthreads();
}

struct Frame {
    LAS unsigned char* lds;
    volatile LAS unsigned* MISC;
    gu32* ctl;
    int tid, lane, wave;
    int vcu, G;
    const float *x, *mix_g, *w_in, *dec_f, *dec_b, *gn_g, *w_ret, *qn_g, *kn_g, *w_att, *w_out, *ffn_g, *w_pq, *subk, *pu, *pv;
    float* out;
    bf16 *WinT, *WretT, *WattT, *WoutT, *WqT, *XN, *PROJ, *Ubf, *Vbf, *ATT;
    int* EIDX; float* GATE; f32x2* RTAB; f32x2* ATAB; bf16 *SKH, *SKL;
};

template <bool ROTP = false> __device__ __forceinline__ void p0_transpose_item(const float* W, int K, int N, bf16* WT, LAS float* scr, int item, int lane) {
    const int nblk = N / 32, kb = item / nblk, nb = item % nblk, k0 = 64 * kb, n0 = 32 * nb;
    int ncol = n0 + (lane & 31);
    if (ROTP && ncol < 2048) { const int cp = ncol & 127; ncol = (ncol & ~127) + (cp >> 1) + 64 * (cp & 1); }
#pragma unroll 8
    for (int i = 0; i < 32; ++i) { const int kk = 2 * i + (lane >> 5); scr[kk * 33 + (lane & 31)] = __builtin_nontemporal_load(W + (size_t)(k0 + kk) * N + ncol); }
    LDS_WAIT(); asm volatile("" ::: "memory");
    const int c = lane & 7;
#pragma unroll
    for (int j = 0; j < 4; ++j) { const int n = (lane >> 3) + 8 * j; const LAS float* s = scr + (8 * c) * 33 + n;
        v4u o; o.x = pk2(s[0 * 33], s[1 * 33]); o.y = pk2(s[2 * 33], s[3 * 33]); o.z = pk2(s[4 * 33], s[5 * 33]); o.w = pk2(s[6 * 33], s[7 * 33]);
        if (ROTP) *(v4u*)(WT + ((size_t)((n0 + n) >> 8) * (K >> 6) + (k0 >> 6)) * 16384 + ((n0 + n) & 255) * 64 + 8 * c) = o;
        else *(v4u*)(WT + (size_t)(n0 + n) * K + k0 + 8 * c) = o; }
    LDS_WAIT(); asm volatile("" ::: "memory");
}
__device__ __forceinline__ void rms_row_to_bf16_tiled(const float* xrow, const float* g, bf16* obase, int m, int lane) {
    const f32x4* xr = (const f32x4*)xrow + lane; const f32x4* gr = (const f32x4*)g + lane;
    f32x4 v[8]; float s = 0.f;
#pragma unroll
    for (int j = 0; j < 8; ++j) { v[j] = __builtin_nontemporal_load(xr + 64 * j); s += (v[j].x * v[j].x + v[j].y * v[j].y) + (v[j].z * v[j].z + v[j].w * v[j].w); }
    const float rstd = 1.0f / sqrtf(wave_sum(s) * (1.f / DM) + EPS);
#pragma unroll
    for (int j = 0; j < 8; ++j) { const f32x4 gg = gr[64 * j]; const int k = 256 * j + 4 * lane;
        unsigned long long* o8 = (unsigned long long*)(obase + ((size_t)(m >> 8) * (DM >> 6) + (k >> 6)) * 16384 + (m & 255) * 64 + (k & 63));
        *o8 = (unsigned long long)pk2(v[j].x * rstd * gg.x, v[j].y * rstd * gg.y) | ((unsigned long long)pk2(v[j].z * rstd * gg.z, v[j].w * rstd * gg.w) << 32); }
}
__device__ __forceinline__ int rot_dst(int src) { if (src >= 2048) return src; const int cp = src & 127; return (src & ~127) + 2 * (cp & 63) + (cp >> 6); }
__device__ __forceinline__ void p0a_colmax_item(const float* W, unsigned* CMX, int item, int lane) {
    const int nb = item % (INW / 256), kb = item / (INW / 256); const f32x4* p = (const f32x4*)(W + (size_t)(64 * kb) * INW + 256 * nb) + lane; f32x4 m = {0.f, 0.f, 0.f, 0.f};
#pragma unroll 8
    for (int kk = 0; kk < 64; ++kk) { const f32x4 v = __builtin_nontemporal_load(p + (size_t)kk * (INW / 4)); m.x = fmaxf(m.x, fabsf(v.x)); m.y = fmaxf(m.y, fabsf(v.y)); m.z = fmaxf(m.z, fabsf(v.z)); m.w = fmaxf(m.w, fabsf(v.w)); }
    const int n = 256 * nb + 4 * lane;
    atomicMax(CMX + rot_dst(n), __float_as_uint(m.x)); atomicMax(CMX + rot_dst(n + 1), __float_as_uint(m.y)); atomicMax(CMX + rot_dst(n + 2), __float_as_uint(m.z)); atomicMax(CMX + rot_dst(n + 3), __float_as_uint(m.w));
}
__device__ __forceinline__ unsigned q4b(f32x4 v, float inv) {
    const int a = (int)rintf(v.x * inv), b = (int)rintf(v.y * inv), c = (int)rintf(v.z * inv), d = (int)rintf(v.w * inv);
    return (unsigned)(a & 255) | ((unsigned)(b & 255) << 8) | ((unsigned)(c & 255) << 16) | ((unsigned)(d & 255) << 24);
}
__device__ __forceinline__ void rms_row_to_i8_tiled(const float* xrow, const float* g, unsigned char* obase, float* SX, int m, int lane) {
    const f32x4* xr = (const f32x4*)xrow + lane; const f32x4* gr = (const f32x4*)g + lane;
    f32x4 v[8]; float s = 0.f;
#pragma unroll
    for (int j = 0; j < 8; ++j) { v[j] = __builtin_nontemporal_load(xr + 64 * j); s += (v[j].x * v[j].x + v[j].y * v[j].y) + (v[j].z * v[j].z + v[j].w * v[j].w); }
    const float rstd = 1.0f / sqrtf(wave_sum(s) * (1.f / DM) + EPS); float mx = 0.f;
#pragma unroll
    for (int j = 0; j < 8; ++j) { const f32x4 gg = gr[64 * j]; v[j].x *= rstd * gg.x; v[j].y *= rstd * gg.y; v[j].z *= rstd * gg.z; v[j].w *= rstd * gg.w;
        mx = fmaxf(mx, fmaxf(fmaxf(fabsf(v[j].x), fabsf(v[j].y)), fmaxf(fabsf(v[j].z), fabsf(v[j].w)))); }
    mx = wave_max(mx); const float sc = (mx > 0.f) ? mx * (1.0f / 127.0f) : 1.0f, inv = 1.0f / sc;
#pragma unroll
    for (int j = 0; j < 8; ++j) { const int k = 256 * j + 4 * lane; *(unsigned*)(obase + ((size_t)(m >> 8) * (DM >> 7) + (k >> 7)) * 32768 + (m & 255) * 128 + (k & 127)) = q4b(v[j], inv); }
    if (lane == 0) SX[m] = sc;
}
__device__ __forceinline__ void p0b_transpose_q8_item(const float* W, const unsigned* CMX, unsigned char* WT8, LAS float* scr, int item, int lane) {
    constexpr int K = DM, N = INW; const int nblk = N / 32, kb = item / nblk, nb = item % nblk, k0 = 64 * kb, n0 = 32 * nb;
    int ncol = n0 + (lane & 31);
    if (ncol < 2048) { const int cp = ncol & 127; ncol = (ncol & ~127) + (cp >> 1) + 64 * (cp & 1); }
#pragma unroll 8
    for (int i = 0; i < 32; ++i) { const int kk = 2 * i + (lane >> 5); scr[kk * 33 + (lane & 31)] = __builtin_nontemporal_load(W + (size_t)(k0 + kk) * N + ncol); }
    LDS_WAIT(); asm volatile("" ::: "memory");
    const int c = lane & 7;
#pragma unroll
    for (int j = 0; j < 4; ++j) { const int nn = (lane >> 3) + 8 * j, n = n0 + nn; const LAS float* s = scr + (8 * c) * 33 + nn; const float cm = __uint_as_float(CMX[n]), inv = (cm > 0.f) ? 127.0f / cm : 0.f;
        v2u o; o.x = q4b((f32x4){s[0 * 33], s[1 * 33], s[2 * 33], s[3 * 33]}, inv); o.y = q4b((f32x4){s[4 * 33], s[5 * 33], s[6 * 33], s[7 * 33]}, inv);
        *(v2u*)(WT8 + ((size_t)(n >> 8) * (K >> 7) + (k0 >> 7)) * 32768 + (n & 255) * 128 + (k0 & 127) + 8 * c) = o; }
    LDS_WAIT(); asm volatile("" ::: "memory");
}
__device__ __forceinline__ void p0_prologue(Frame& F, int pass, unsigned* CMX, float* SX) {
    LAS float* scr = (LAS float*)(F.lds + RING_OFF + F.wave * 16384);
    const int gw = F.vcu * NWAVES + F.wave, NGW = F.G * NWAVES;
    constexpr int I_IN = (DM / 64) * (INW / 32), I_SQ = (DM / 64) * (DM / 32), I_AT = (1024 / 64) * (DM / 32);
    constexpr int NITEMS = I_IN + 3 * I_SQ + I_AT;
    for (int it = gw; it < NITEMS; it += NGW) {
        int r = it;
        if (r < I_IN) { if (pass == 1) p0b_transpose_q8_item(F.w_in, CMX, (unsigned char*)F.WinT, scr, r, F.lane); continue; } r -= I_IN;
        if (pass == 1) continue;
        if (r < I_SQ) { p0_transpose_item(F.w_ret, DM, DM, F.WretT, scr, r, F.lane); continue; } r -= I_SQ;
        if (r < I_SQ) { p0_transpose_item(F.w_out, DM, DM, F.WoutT, scr, r, F.lane); continue; } r -= I_SQ;
        if (r < I_SQ) { p0_transpose_item(F.w_pq, DM, DM, F.WqT, scr, r, F.lane); continue; } r -= I_SQ;
        p0_transpose_item(F.w_att, 1024, DM, F.WattT, scr, r, F.lane);
    }
    if (pass == 1) return;
    for (int it = gw; it < (DM / 64) * (INW / 256); it += NGW) p0a_colmax_item(F.w_in, CMX, it, F.lane);
    for (int m = gw; m < NTOK; m += NGW) rms_row_to_i8_tiled(F.x + (size_t)m * DM, F.mix_g, (unsigned char*)F.XN, SX, m, F.lane);
    for (int idx = gw * 64 + F.lane; idx < 8 * 2 * 128 * 128 / 2; idx += NGW * 64) { const f32x2 v = *(const f32x2*)(F.subk + 2 * idx);
        const unsigned hi = pk2(v.x, v.y); const unsigned lo = pk2(v.x - bflo(hi), v.y - bfhi(hi)); ((unsigned*)F.SKH)[idx] = hi; ((unsigned*)F.SKL)[idx] = lo; }
    for (int idx = gw * 64 + F.lane; idx < SEQ * 64; idx += NGW * 64) { const int pos = idx >> 6, i = idx & 63;
        const float freq = powf(10000.0f, -(float)i / 64.0f), ang = (float)pos * freq; f32x2 cs; cs.x = cosf(ang); cs.y = sinf(ang); F.RTAB[idx] = cs; }
    for (int idx = gw * 64 + F.lane; idx < SEQ * 16; idx += NGW * 64) { const int pos = idx >> 4, i = idx & 15;
        const float freq = powf(500000.0f, -(float)i / 16.0f), ang = (float)pos * freq; f32x2 cs; cs.x = cosf(ang); cs.y = sinf(ang); F.ATAB[idx] = cs; }
}

template <int CTRL> __device__ __forceinline__ float dpp_f(float x) { return __builtin_bit_cast(float, __builtin_amdgcn_mov_dpp(__builtin_bit_cast(int, x), CTRL, 0xf, 0xf, true)); }

typedef short bf16x8 __attribute__((ext_vector_type(8)));
typedef float f32x16 __attribute__((ext_vector_type(16)));
#define MFMA32(a, b, c) __builtin_amdgcn_mfma_f32_32x32x16_bf16((a), (b), (c), 0, 0, 0)
__device__ __forceinline__ unsigned cvtpk(float lo, float hi) { unsigned r; asm volatile("v_cvt_pk_bf16_f32 %0, %1, %2" : "=v"(r) : "v"(lo), "v"(hi)); return r; }

__device__ __forceinline__ void ret_phaseB(Frame& F, bf16* UF, bf16* UB) {
    for (int task = F.vcu * 512 + F.tid; task < 131072; task += F.G * 512) {
        const int piece = task & 4095, bh = (task >> 12) & 15, dir = task >> 16, b = bh >> 3, h = bh & 7;
        const float cd = expf(-expf(dir ? F.dec_b[h] : F.dec_f[h]) * 128.0f);
        bf16* base = (dir ? UB : UF) + (size_t)piece * 8;
        float s[8];
#pragma unroll
        for (int i = 0; i < 8; ++i) s[i] = 0.f;
        const size_t cstride = (size_t)8 * 32768;
        bf16* p0 = base + (size_t)(b * 32 * 8 + h) * 32768;
        v4u wv[32];
#pragma unroll
        for (int cc = 0; cc < 32; ++cc) { const int c = dir ? 31 - cc : cc; wv[cc] = *(const v4u*)(p0 + c * cstride); }
#pragma unroll
        for (int cc = 0; cc < 32; ++cc) { const int c = dir ? 31 - cc : cc; const v4u w = wv[cc];
            v4u o; o.x = pk2(s[0], s[1]); o.y = pk2(s[2], s[3]); o.z = pk2(s[4], s[5]); o.w = pk2(s[6], s[7]); *(v4u*)(p0 + c * cstride) = o;
            s[0] = s[0] * cd + bflo(w.x); s[1] = s[1] * cd + bfhi(w.x); s[2] = s[2] * cd + bflo(w.y); s[3] = s[3] * cd + bfhi(w.y);
            s[4] = s[4] * cd + bflo(w.z); s[5] = s[5] * cd + bfhi(w.z); s[6] = s[6] * cd + bflo(w.w); s[7] = s[7] * cd + bfhi(w.w); }
    }
}


constexpr int LROW = 272;
template <int NI> __device__ __forceinline__ void tile_ld(v4u (&g)[NI], const bf16* src, size_t src_stride, int tid) {
    const bf16* p = src + (size_t)(tid >> 4) * src_stride + (tid & 15) * 8;
#pragma unroll
    for (int i = 0; i < NI; ++i) g[i] = *(const v4u*)(p + (size_t)(32 * i) * src_stride);
}
template <int NI> __device__ __forceinline__ void tile_st(const v4u (&g)[NI], LAS unsigned char* dst, int tid) {
    LAS unsigned char* p = dst + (tid >> 4) * LROW + (tid & 15) * 16;
#pragma unroll
    for (int i = 0; i < NI; ++i) *(LAS v4u*)(p + 32 * i * LROW) = g[i];
}
#define BLK_SYNC() do { asm volatile("s_waitcnt lgkmcnt(0)" ::: "memory"); __builtin_amdgcn_s_barrier(); asm volatile("" ::: "memory"); } while (0)


template <int NI> __device__ __forceinline__ void tile_out(bf16* dst, const LAS unsigned char* srcl, int tid) {
    const LAS unsigned char* p = srcl + (tid >> 4) * LROW + (tid & 15) * 16; bf16* d = dst + (size_t)(tid >> 4) * 128 + (tid & 15) * 8;
#pragma unroll
    for (int i = 0; i < NI; ++i) *(v4u*)(d + (size_t)(32 * i) * 128) = *(const LAS v4u*)(p + 32 * i * LROW);
}

__device__ __forceinline__ void att_merge(Frame& F, const bf16* OGN, const float* LSE) {
#pragma unroll 4
    for (int task = F.vcu * 512 + F.tid; task < NTOK * 128; task += F.G * 512) {
        const int m = task >> 7, c8 = (task & 127) * 8, hh = c8 >> 7;
        const float l0 = LSE[(size_t)m * 8 + hh], l1 = LSE[(size_t)NTOK * 8 + (size_t)m * 8 + hh], l2 = LSE[(size_t)2 * NTOK * 8 + (size_t)m * 8 + hh];
        const float mx = fmaxf(l0, fmaxf(l1, l2)); float w0 = __expf(l0 - mx), w1 = __expf(l1 - mx), w2 = __expf(l2 - mx); const float inv = 1.0f / (w0 + w1 + w2); w0 *= inv; w1 *= inv; w2 *= inv;
        const size_t o = (size_t)m * 1024 + c8;
        const v4u a = *(const v4u*)(OGN + o), bq = *(const v4u*)(OGN + (size_t)NTOK * 1024 + o), c = *(const v4u*)(OGN + (size_t)2 * NTOK * 1024 + o);
        v4u res;
        res.x = pk2(w0 * bflo(a.x) + w1 * bflo(bq.x) + w2 * bflo(c.x), w0 * bfhi(a.x) + w1 * bfhi(bq.x) + w2 * bfhi(c.x));
        res.y = pk2(w0 * bflo(a.y) + w1 * bflo(bq.y) + w2 * bflo(c.y), w0 * bfhi(a.y) + w1 * bfhi(bq.y) + w2 * bfhi(c.y));
        res.z = pk2(w0 * bflo(a.z) + w1 * bflo(bq.z) + w2 * bflo(c.z), w0 * bfhi(a.z) + w1 * bfhi(bq.z) + w2 * bfhi(c.z));
        res.w = pk2(w0 * bflo(a.w) + w1 * bflo(bq.w) + w2 * bflo(c.w), w0 * bfhi(a.w) + w1 * bfhi(bq.w) + w2 * bfhi(c.w));
        *(v4u*)(F.ATT + o) = res;
    }
}

typedef short trv4 __attribute__((ext_vector_type(4)));
constexpr int VROW = 320;
__device__ __forceinline__ void att_phase3(Frame& F, bf16* OGN, float* LSE, const unsigned long long* SSQ) {
    const bf16* AQ = F.PROJ + PO_AQ; const bf16* AK = F.PROJ + PO_AK; const bf16* AV = F.PROJ + PO_AV;
    LAS unsigned char* Lk = F.lds + RING_OFF;
    const int tid = F.tid, lane = F.lane, r = lane & 31, lh = lane >> 5, w = F.wave;
    for (int unit = F.vcu; unit < 2 * 24 * 16; unit += F.G) {
        int blk = unit & 15; asm volatile("" : "+v"(blk));
        int ts = tid; asm volatile("" : "+v"(ts));
        const int bh = unit >> 4, head = bh % 24, b = bh / 24, g = head >> 3, hh = head & 7, sh = 2 * g, dil = 1 << sh, L = SEQ >> sh;
        const int nb = L >> 8, p = blk / nb, l0 = (blk % nb) * 256, lq = l0 + 32 * w + r;
        const size_t mq = (size_t)b * SEQ + (size_t)lq * dil + p;
        __syncthreads();
        { const int ch = ts & 15, c8 = ch * 8; const float* kg_ = F.kn_g; asm volatile("" : "+s"(kg_));
          const f32x4 g0 = *(const f32x4*)(kg_ + c8), g1 = *(const f32x4*)(kg_ + c8 + 4);
          const float gg[8] = {g0.x, g0.y, g0.z, g0.w, g1.x, g1.y, g1.z, g1.w};
#pragma unroll 1
          for (int ib = 0; ib < 12; ib += 6) {
              v4u wr_[6]; unsigned long long sq_[6];
#pragma unroll
              for (int i = 0; i < 6; ++i) { const int slot = 32 * (ib + i) + (ts >> 4), l = l0 - 64 + slot; const bool ok = (l >= 0 && l < L); const int pos = ok ? l * dil + p : 0; const size_t mk = (size_t)b * SEQ + pos;
                  wr_[i] = *(const v4u*)(AK + mk * 3072 + head * 128 + c8); sq_[i] = SSQ[((size_t)NTOK + mk) * 24 + head]; }
#pragma unroll
              for (int i = 0; i < 6; ++i) { const int slot = 32 * (ib + i) + (ts >> 4), l = l0 - 64 + slot; const bool ok = (l >= 0 && l < L); const int pos = ok ? l * dil + p : 0;
                  const v4u w_ = wr_[i]; const float rstd = 1.0f / sqrtf((float)sq_[i] * (1.f / (128.f * 16777216.0f)) + EPS);
                  float x[8] = {bflo(w_.x), bfhi(w_.x), bflo(w_.y), bfhi(w_.y), bflo(w_.z), bfhi(w_.z), bflo(w_.w), bfhi(w_.w)};
#pragma unroll
                  for (int j = 0; j < 8; ++j) x[j] = x[j] * rstd * gg[j];
                  float oth[8];
#pragma unroll
                  for (int j = 0; j < 8; ++j) oth[j] = dpp_f<0x4E>(x[j]);
                  if (ch < 4) { const f32x2* tab = F.ATAB + pos * 16 + 8 * (ch & 1);
#pragma unroll
                      for (int j = 0; j < 8; ++j) { const f32x2 cs = tab[j]; x[j] = (ch < 2) ? (x[j] * cs.x - oth[j] * cs.y) : (x[j] * cs.x + oth[j] * cs.y); } }
                  v4u v; v.x = pk2(x[0], x[1]); v.y = pk2(x[2], x[3]); v.z = pk2(x[4], x[5]); v.w = pk2(x[6], x[7]);
                  if (!ok) v = (v4u){0u, 0u, 0u, 0u};
                  *(LAS v4u*)(Lk + slot * LROW + 2 * c8) = v; } } }
        bf16x8 qf[8];
        { const bf16* qp = AQ + mq * 3072 + head * 128 + 8 * lh; const float rstd = 1.0f / sqrtf((float)SSQ[mq * 24 + head] * (1.f / (128.f * 16777216.0f)) + EPS); const int posq = lq * dil + p;
          const float* qg_ = F.qn_g; asm volatile("" : "+s"(qg_));
          float y0[8], y1[8];
#pragma unroll
          for (int ks = 0; ks < 8; ++ks) { const v4u w_ = *(const v4u*)(qp + 16 * ks); const f32x4 g0 = *(const f32x4*)(qg_ + 16 * ks + 8 * lh), g1 = *(const f32x4*)(qg_ + 16 * ks + 8 * lh + 4);
              float x[8] = {bflo(w_.x) * rstd * g0.x, bfhi(w_.x) * rstd * g0.y, bflo(w_.y) * rstd * g0.z, bfhi(w_.y) * rstd * g0.w, bflo(w_.z) * rstd * g1.x, bfhi(w_.z) * rstd * g1.y, bflo(w_.w) * rstd * g1.z, bfhi(w_.w) * rstd * g1.w};
              if (ks == 0) {
#pragma unroll
                  for (int j = 0; j < 8; ++j) y0[j] = x[j]; }
              else if (ks == 1) {
#pragma unroll
                  for (int j = 0; j < 8; ++j) y1[j] = x[j];
                  const f32x2* tab = F.ATAB + posq * 16 + 8 * lh; float a0[8], a1[8];
#pragma unroll
                  for (int j = 0; j < 8; ++j) { const f32x2 cs = tab[j]; a0[j] = y0[j] * cs.x - y1[j] * cs.y; a1[j] = y1[j] * cs.x + y0[j] * cs.y; }
                  v4u q0; q0.x = pk2(a0[0], a0[1]); q0.y = pk2(a0[2], a0[3]); q0.z = pk2(a0[4], a0[5]); q0.w = pk2(a0[6], a0[7]); qf[0] = __builtin_bit_cast(bf16x8, q0);
                  v4u q1; q1.x = pk2(a1[0], a1[1]); q1.y = pk2(a1[2], a1[3]); q1.z = pk2(a1[4], a1[5]); q1.w = pk2(a1[6], a1[7]); qf[1] = __builtin_bit_cast(bf16x8, q1); }
              else { v4u qq; qq.x = pk2(x[0], x[1]); qq.y = pk2(x[2], x[3]); qq.z = pk2(x[4], x[5]); qq.w = pk2(x[6], x[7]); qf[ks] = __builtin_bit_cast(bf16x8, qq); } } }
#pragma unroll
        for (int ks = 0; ks < 8; ++ks) asm volatile("" : "+v"(qf[ks]));
        __syncthreads();
        v4u vv[12];
        { const int c8 = (ts & 15) * 8;
#pragma unroll
          for (int i = 0; i < 12; ++i) { const int slot = 32 * i + (ts >> 4), l = l0 - 64 + slot; vv[i] = (v4u){0u, 0u, 0u, 0u};
              if (l >= 0 && l < L) vv[i] = *(const v4u*)(AV + ((size_t)b * SEQ + (size_t)l * dil + p) * 3072 + head * 128 + c8); } }
        f32x16 st[5];
#pragma unroll
        for (int kt = 0; kt < 5; ++kt) { const LAS unsigned char* kp = Lk + (32 * w + 32 * kt + r) * LROW + 16 * lh; f32x16 a = (f32x16){0};
#pragma unroll
            for (int ks = 0; ks < 8; ++ks) { const bf16x8 kf = *(const LAS bf16x8*)(kp + 32 * ks); a = MFMA32(kf, qf[ks], a); }
            st[kt] = a; asm volatile("" ::: "memory"); }
        __syncthreads();
        { const int c8 = (ts & 15) * 8;
#pragma unroll
          for (int i = 0; i < 12; ++i) { const int slot = 32 * i + (ts >> 4); *(LAS v4u*)(Lk + slot * VROW + 2 * c8) = vv[i]; } }
        float mx = -1e30f;
#pragma unroll
        for (int kt = 0; kt < 5; ++kt)
#pragma unroll
            for (int reg = 0; reg < 16; ++reg) { const int lk = l0 + 32 * w - 64 + 32 * kt + (reg & 3) + 8 * (reg >> 2) + 4 * lh; const int rel = lk - lq;
                const bool ok = (lk >= 0) && (lk < L) && (rel <= 64) && (rel >= -64);
                const float s = ok ? st[kt][reg] * 0.08838834764831845f : -1e30f; st[kt][reg] = s; mx = fmaxf(mx, s); }
        mx = fmaxf(mx, __shfl_xor(mx, 32));
        float sum = 0.f;
#pragma unroll
        for (int kt = 0; kt < 5; ++kt)
#pragma unroll
            for (int reg = 0; reg < 16; ++reg) { const float pv = __expf(st[kt][reg] - mx); st[kt][reg] = pv; sum += pv; }
        sum += __shfl_xor(sum, 32);
        bf16x8 pb[5][2];
#pragma unroll
        for (int kt = 0; kt < 5; ++kt)
#pragma unroll
            for (int s = 0; s < 2; ++s) { v4u pk; pk.x = cvtpk(st[kt][8 * s], st[kt][8 * s + 1]); pk.y = cvtpk(st[kt][8 * s + 2], st[kt][8 * s + 3]); pk.z = cvtpk(st[kt][8 * s + 4], st[kt][8 * s + 5]); pk.w = cvtpk(st[kt][8 * s + 6], st[kt][8 * s + 7]);
                pb[kt][s] = __builtin_bit_cast(bf16x8, pk); }
        __syncthreads();
        f32x16 acc[4];
#pragma unroll
        for (int dt = 0; dt < 4; ++dt) acc[dt] = (f32x16){0};
        const LAS unsigned char* vtr = Lk + (32 * w + 4 * lh + ((lane & 15) >> 2)) * VROW + (16 * ((lane >> 4) & 1) + 4 * (lane & 3)) * 2;
#pragma unroll
        for (int kt = 0; kt < 5; ++kt)
#pragma unroll
            for (int s = 0; s < 2; ++s) { asm volatile("" ::: "memory");
#pragma unroll
                for (int dt = 0; dt < 4; ++dt) { const LAS unsigned char* vp = vtr + (32 * kt + 16 * s) * VROW + 64 * dt;
                    const trv4 lo = __builtin_amdgcn_ds_read_tr16_b64_v4i16((LAS trv4*)vp), hi = __builtin_amdgcn_ds_read_tr16_b64_v4i16((LAS trv4*)(vp + 8 * VROW));
                    const bf16x8 av = (bf16x8){lo[0], lo[1], lo[2], lo[3], hi[0], hi[1], hi[2], hi[3]}; acc[dt] = MFMA32(av, pb[kt][s], acc[dt]); } }
        const float inv = 1.0f / sum;
        __syncthreads();
        { LAS unsigned char* ot = Lk + w * (32 * LROW); LAS unsigned char* op = ot + r * LROW + 8 * lh;
#pragma unroll
          for (int dt = 0; dt < 4; ++dt)
#pragma unroll
              for (int q = 0; q < 4; ++q) { v2u o; o.x = cvtpk(acc[dt][4 * q] * inv, acc[dt][4 * q + 1] * inv); o.y = cvtpk(acc[dt][4 * q + 2] * inv, acc[dt][4 * q + 3] * inv); *(LAS v2u*)(op + 64 * dt + 16 * q) = o; }
          LDS_WAIT(); asm volatile("" ::: "memory");
#pragma unroll
          for (int i4 = 0; i4 < 8; ++i4) { const int qr = 4 * i4 + (lane >> 4); const size_t mrow = (size_t)b * SEQ + (size_t)(l0 + 32 * w + qr) * dil + p;
              *(v4u*)(OGN + (size_t)g * NTOK * 1024 + mrow * 1024 + hh * 128 + (lane & 15) * 8) = *(const LAS v4u*)(ot + qr * LROW + (lane & 15) * 16); } }
        if (lh == 0) LSE[(size_t)g * NTOK * 8 + mq * 8 + hh] = mx + __logf(sum);
    }
}

constexpr int KROW = 320;
constexpr int VROW2 = 576;
__device__ __forceinline__ bf16x8 tr_frag(const LAS unsigned char* p, int step_bytes) {
    const trv4 lo = __builtin_amdgcn_ds_read_tr16_b64_v4i16((LAS trv4*)p), hi = __builtin_amdgcn_ds_read_tr16_b64_v4i16((LAS trv4*)(p + step_bytes));
    return (bf16x8){lo[0], lo[1], lo[2], lo[3], hi[0], hi[1], hi[2], hi[3]};
}
__device__ __forceinline__ void ret_phaseA3(Frame& F, bf16* UF, bf16* UB) {
    const bf16* RK = F.PROJ + PO_RK; const bf16* RV = F.PROJ + PO_RV;
    LAS unsigned char* Lv = F.lds + RING_OFF;
    LAS unsigned char* Lk2 = Lv + 128 * VROW2;
    const int tid = F.tid, lane = F.lane, r = lane & 31, lh = lane >> 5, w = F.wave;
    const int ar = (lane & 15) >> 2, ac = 16 * ((lane >> 4) & 1) + 4 * (lane & 3);
    for (int u = F.vcu; u < 512; u += F.G) {
        const int h = u & 7, m0 = (u >> 3) * 128; const float lgf = -expf(F.dec_f[h]), lgb = -expf(F.dec_b[h]);
        v4u gk[4], gv[8];
        { const bf16* kp = RK + (size_t)(m0 + (tid >> 4)) * 1024 + h * 128 + (tid & 15) * 8;
#pragma unroll
          for (int i = 0; i < 4; ++i) gk[i] = *(const v4u*)(kp + (size_t)(32 * i) * 1024);
          const bf16* vp = RV + (size_t)(m0 + (tid >> 5)) * 2048 + h * 256 + (tid & 31) * 8;
#pragma unroll
          for (int i = 0; i < 8; ++i) gv[i] = *(const v4u*)(vp + (size_t)(16 * i) * 2048); }
        BLK_SYNC();
#pragma unroll
        for (int i = 0; i < 8; ++i) *(LAS v4u*)(Lv + ((tid >> 5) + 16 * i) * VROW2 + (tid & 31) * 16) = gv[i];
        f32x16 af[4], ab[4];
#pragma unroll
        for (int dir = 0; dir < 2; ++dir) {
            if (dir) BLK_SYNC();
#pragma unroll
            for (int i = 0; i < 4; ++i) { const int j = (tid >> 4) + 32 * i; const float dc = dir ? __expf(lgb * (float)j) : __expf(lgf * (float)(127 - j)); v4u o;
                o.x = pk2(bflo(gk[i].x) * dc, bfhi(gk[i].x) * dc); o.y = pk2(bflo(gk[i].y) * dc, bfhi(gk[i].y) * dc); o.z = pk2(bflo(gk[i].z) * dc, bfhi(gk[i].z) * dc); o.w = pk2(bflo(gk[i].w) * dc, bfhi(gk[i].w) * dc);
                *(LAS v4u*)(Lk2 + j * KROW + (tid & 15) * 16) = o; }
            BLK_SYNC();
            f32x16 acc[4];
#pragma unroll
            for (int mt = 0; mt < 4; ++mt) acc[mt] = (f32x16){0};
            const LAS unsigned char* kb = Lk2 + (8 * lh + ar) * KROW + ac * 2; const LAS unsigned char* vb = Lv + (8 * lh + ar) * VROW2 + (32 * w + ac) * 2;
#pragma unroll
            for (int ks = 0; ks < 8; ++ks) { const bf16x8 bv = tr_frag(vb + 16 * ks * VROW2, 4 * VROW2);
#pragma unroll
                for (int mt = 0; mt < 4; ++mt) { const bf16x8 a = tr_frag(kb + 16 * ks * KROW + 64 * mt, 4 * KROW); acc[mt] = MFMA32(a, bv, acc[mt]); } }
#pragma unroll
            for (int mt = 0; mt < 4; ++mt) { if (dir) ab[mt] = acc[mt]; else af[mt] = acc[mt]; }
        }
        BLK_SYNC();
        LAS unsigned char* op = Lv + (32 * w + r) * LROW + 8 * lh;
#pragma unroll
        for (int mt = 0; mt < 4; ++mt)
#pragma unroll
            for (int g = 0; g < 4; ++g) { v2u o; o.x = cvtpk(af[mt][4 * g], af[mt][4 * g + 1]); o.y = cvtpk(af[mt][4 * g + 2], af[mt][4 * g + 3]); *(LAS v2u*)(op + 64 * mt + 16 * g) = o; }
        BLK_SYNC();
        tile_out<8>(UF + (size_t)u * 32768, Lv, tid);
        BLK_SYNC();
#pragma unroll
        for (int mt = 0; mt < 4; ++mt)
#pragma unroll
            for (int g = 0; g < 4; ++g) { v2u o; o.x = cvtpk(ab[mt][4 * g], ab[mt][4 * g + 1]); o.y = cvtpk(ab[mt][4 * g + 2], ab[mt][4 * g + 3]); *(LAS v2u*)(op + 64 * mt + 16 * g) = o; }
        BLK_SYNC();
        tile_out<8>(UB + (size_t)u * 32768, Lv, tid);
    }
}

__device__ __forceinline__ void ret_phaseC3(Frame& F, const bf16* SF, const bf16* SB, bf16* RETO) {
    const bf16* QR = F.PROJ + PO_RQ; const bf16* KR = F.PROJ + PO_RK; const bf16* RG = F.PROJ + PO_RG; const bf16* RV = F.PROJ + PO_RV;
    LAS unsigned char* Lq = F.lds + RING_OFF;
    LAS unsigned char* Lx = Lq + 128 * LROW;
    LAS float* red = (LAS float*)(Lx + 128 * VROW2);
    const int tid = F.tid, lane = F.lane, r = lane & 31, lh = lane >> 5, w = F.wave, it = w & 3, eh = w >> 2;
    v4u g[8];
    int u = F.vcu;
    for (; u < 512; u += F.G) {
        const int h = u & 7, m0 = (u >> 3) * 128;
        const float lgf = -expf(F.dec_f[h]), lgb = -expf(F.dec_b[h]);
        int i = 32 * it + r; asm volatile("" : "+v"(i));
        { v4u gq[4], gk[4]; tile_ld<4>(gq, QR + (size_t)m0 * 1024 + h * 128, 1024, tid); tile_ld<4>(gk, KR + (size_t)m0 * 1024 + h * 128, 1024, tid);
          tile_st<4>(gq, Lq, tid); tile_st<4>(gk, Lx, tid); }
        BLK_SYNC();
        tile_ld<8>(g, SF + (size_t)u * 32768, 128, tid);
        const LAS unsigned char* qp = Lq + i * LROW + 16 * lh;
        bf16x8 pb[4][2];
#pragma unroll
        for (int jt = 0; jt < 4; ++jt) { f32x16 st = (f32x16){0}; const LAS unsigned char* kp = Lx + (32 * jt + r) * LROW + 16 * lh;
#pragma unroll
            for (int ks = 0; ks < 8; ++ks) { const bf16x8 kf = *(const LAS bf16x8*)(kp + 32 * ks), qv = *(const LAS bf16x8*)(qp + 32 * ks); st = MFMA32(kf, qv, st); }
#pragma unroll
            for (int reg = 0; reg < 16; ++reg) { const int j = 32 * jt + (reg & 3) + 8 * (reg >> 2) + 4 * lh; const int dd = i - j;
                st[reg] *= __expf(dd >= 0 ? lgf * (float)dd : lgb * (float)(-dd)); }
#pragma unroll
            for (int s = 0; s < 2; ++s) { v4u pk; pk.x = cvtpk(st[8 * s], st[8 * s + 1]); pk.y = cvtpk(st[8 * s + 2], st[8 * s + 3]); pk.z = cvtpk(st[8 * s + 4], st[8 * s + 5]); pk.w = cvtpk(st[8 * s + 6], st[8 * s + 7]);
                pb[jt][s] = __builtin_bit_cast(bf16x8, pk); }
            asm volatile("" ::: "memory"); }
        BLK_SYNC();
        tile_st<8>(g, Lx, tid);
        BLK_SYNC();
        tile_ld<8>(g, SB + (size_t)u * 32768, 128, tid);
        f32x16 acc[4];
#pragma unroll
        for (int et = 0; et < 4; ++et) acc[et] = (f32x16){0};
        const float sfi = __expf(lgf * (float)(i + 1)), sbi = __expf(lgb * (float)(128 - i));
        const LAS unsigned char* xp = Lx + (128 * eh + r) * LROW + 16 * lh;
#pragma unroll
        for (int ks = 0; ks < 8; ++ks) {
            if ((ks & 1) == 0) asm volatile("" ::: "memory");
            const bf16x8 qv = *(const LAS bf16x8*)(qp + 32 * ks);
#pragma unroll
            for (int et = 0; et < 4; ++et) { const bf16x8 a = *(const LAS bf16x8*)(xp + et * 32 * LROW + 32 * ks); acc[et] = MFMA32(a, qv, acc[et]); } }
        { const float rt = sfi / sbi;
#pragma unroll
          for (int et = 0; et < 4; ++et) acc[et] *= rt; }
        BLK_SYNC();
        tile_st<8>(g, Lx, tid);
        BLK_SYNC();
        { const bf16* vp = RV + (size_t)(m0 + (tid >> 5)) * 2048 + h * 256 + (tid & 31) * 8;
#pragma unroll
          for (int x = 0; x < 8; ++x) g[x] = *(const v4u*)(vp + (size_t)(16 * x) * 2048); }
#pragma unroll
        for (int ks = 0; ks < 8; ++ks) {
            if ((ks & 1) == 0) asm volatile("" ::: "memory");
            const bf16x8 qv = *(const LAS bf16x8*)(qp + 32 * ks);
#pragma unroll
            for (int et = 0; et < 4; ++et) { const bf16x8 a = *(const LAS bf16x8*)(xp + et * 32 * LROW + 32 * ks); acc[et] = MFMA32(a, qv, acc[et]); } }
#pragma unroll
        for (int et = 0; et < 4; ++et) acc[et] *= sbi;
        BLK_SYNC();
#pragma unroll
        for (int x = 0; x < 8; ++x) *(LAS v4u*)(Lx + ((tid >> 5) + 16 * x) * VROW2 + (tid & 31) * 16) = g[x];
        BLK_SYNC();
        { const LAS unsigned char* vp = Lx + (4 * lh + ((lane & 15) >> 2)) * VROW2 + (128 * eh + 16 * ((lane >> 4) & 1) + 4 * (lane & 3)) * 2;
#pragma unroll
          for (int jt = 0; jt < 4; ++jt)
#pragma unroll
              for (int s = 0; s < 2; ++s) {
                  asm volatile("" ::: "memory");
#pragma unroll
                  for (int et = 0; et < 4; ++et) { const bf16x8 av = tr_frag(vp + (32 * jt + 16 * s) * VROW2 + 64 * et, 8 * VROW2); acc[et] = MFMA32(av, pb[jt][s], acc[et]); } } }
        float s1 = 0.f, s2 = 0.f;
#pragma unroll
        for (int et = 0; et < 4; ++et)
#pragma unroll
            for (int reg = 0; reg < 16; ++reg) { const float v = acc[et][reg]; s1 += v; s2 += v * v; }
        s1 += __shfl_xor(s1, 32); s2 += __shfl_xor(s2, 32);
        if (lh == 0) { red[(w * 32 + r) * 2] = s1; red[(w * 32 + r) * 2 + 1] = s2; }
        BLK_SYNC();
        { const int ow = w ^ 4; s1 += red[(ow * 32 + r) * 2]; s2 += red[(ow * 32 + r) * 2 + 1]; }
        const float mu = s1 * (1.f / 256.f), var = fmaxf(s2 * (1.f / 256.f) - mu * mu, 0.f), rstd = 1.0f / sqrtf(var + EPS);
        { LAS unsigned char* op = Lx + i * 528 + (128 * eh + 4 * lh) * 2;
#pragma unroll
          for (int et = 0; et < 4; ++et)
#pragma unroll
              for (int gq4 = 0; gq4 < 4; ++gq4) { v2u o; o.x = cvtpk((acc[et][4 * gq4] - mu) * rstd, (acc[et][4 * gq4 + 1] - mu) * rstd); o.y = cvtpk((acc[et][4 * gq4 + 2] - mu) * rstd, (acc[et][4 * gq4 + 3] - mu) * rstd);
                  *(LAS v2u*)(op + (32 * et + 8 * gq4) * 2) = o; } }
        BLK_SYNC();
        { const int c8 = (tid & 31) * 8; const f32x4 g0 = *(const f32x4*)(F.gn_g + h * 256 + c8), g1 = *(const f32x4*)(F.gn_g + h * 256 + c8 + 4);
#pragma unroll
          for (int p8 = 0; p8 < 8; ++p8) { const int row = 16 * p8 + (tid >> 5); const size_t go = (size_t)(m0 + row) * 2048 + h * 256 + c8;
              const v4u x = *(const LAS v4u*)(Lx + row * 528 + c8 * 2), rg = *(const v4u*)(RG + go); v4u o;
              o.x = pk2(bflo(x.x) * g0.x * bflo(rg.x), bfhi(x.x) * g0.y * bfhi(rg.x)); o.y = pk2(bflo(x.y) * g0.z * bflo(rg.y), bfhi(x.y) * g0.w * bfhi(rg.y));
              o.z = pk2(bflo(x.z) * g1.x * bflo(rg.z), bfhi(x.z) * g1.y * bfhi(rg.z)); o.w = pk2(bflo(x.w) * g1.z * bflo(rg.w), bfhi(x.w) * g1.w * bfhi(rg.w));
              *(v4u*)(RETO + go) = o; } }
        BLK_SYNC();
    }
}

typedef int v4i __attribute__((ext_vector_type(4)));
typedef int v16i __attribute__((ext_vector_type(16)));
__device__ __forceinline__ unsigned q4(f32x4 v, float inv, int zp) {
    const int a = (int)rintf(v.x * inv) + zp, b = (int)rintf(v.y * inv) + zp, c = (int)rintf(v.z * inv) + zp, d = (int)rintf(v.w * inv) + zp;
    return (unsigned)(a & 255) | ((unsigned)(b & 255) << 8) | ((unsigned)(c & 255) << 16) | ((unsigned)(d & 255) << 24);
}
__device__ __forceinline__ void conv_tab8(const float* srcT, unsigned char* dst, float* SC, int wv, int nw, int lane) {
#pragma unroll 2
    for (int e = wv; e < NEXP; e += nw) { const f32x4* src = (const f32x4*)(srcT + (size_t)e * DM) + lane;
        f32x4 v[8]; float m = 0.f;
#pragma unroll
        for (int j = 0; j < 8; ++j) { v[j] = __builtin_nontemporal_load(src + 64 * j); m = fmaxf(m, fmaxf(fmaxf(fabsf(v[j].x), fabsf(v[j].y)), fmaxf(fabsf(v[j].z), fabsf(v[j].w)))); }
        m = wave_max(m); const float sc = (m > 0.f) ? m * (1.0f / 127.0f) : 1.0f, inv = 1.0f / sc;
#pragma unroll
        for (int j = 0; j < 8; ++j) *(unsigned*)(dst + ((size_t)j * NEXP + e) * 256 + 4 * lane) = q4(v[j], inv, 0);
        if (lane == 0) SC[e] = sc; }
}
__device__ __forceinline__ void conv_rows8(const float* pu, const float* pv, unsigned char* U8, unsigned char* V8, float* SU, float* SV, int r0, int r1, int lane) {
#pragma unroll 2
    for (int r = r0; r < r1; ++r) { const bool isv = r >= NEXP; const int e = isv ? r - NEXP : r; const f32x4* src = (const f32x4*)((isv ? pv : pu) + (size_t)e * DM) + lane; unsigned char* dst = isv ? V8 : U8;
        f32x4 v[8]; float m = 0.f;
#pragma unroll
        for (int j = 0; j < 8; ++j) { v[j] = __builtin_nontemporal_load(src + 64 * j); m = fmaxf(m, fmaxf(fmaxf(fabsf(v[j].x), fabsf(v[j].y)), fmaxf(fabsf(v[j].z), fabsf(v[j].w)))); }
        m = wave_max(m); const float sc = (m > 0.f) ? m * (1.0f / 127.0f) : 1.0f, inv = 1.0f / sc;
#pragma unroll
        for (int j = 0; j < 8; ++j) *(unsigned*)(dst + ((size_t)j * NEXP + e) * 256 + 4 * lane) = q4(v[j], inv, 0);
        if (lane == 0) (isv ? SV : SU)[e] = sc; }
}
__device__ __forceinline__ int mbcnt64(unsigned long long m) { return __builtin_amdgcn_mbcnt_hi((unsigned)(m >> 32), __builtin_amdgcn_mbcnt_lo((unsigned)m, 0u)); }
__device__ __forceinline__ void peer_sort_pos(int elo, int ehi, int& plo, int& phi) {
    int off = 0, pl = 0, ph = 0; const int rl = elo >> 12, rh = ehi >> 12;
#pragma unroll
    for (int r = 0; r < 4; ++r) { const unsigned long long ml = __ballot(rl == r), mh = __ballot(rh == r);
        const int cl = __builtin_popcountll(ml), ch = __builtin_popcountll(mh); const int bl = off + mbcnt64(ml), bh = off + cl + mbcnt64(mh);
        pl = (rl == r) ? bl : pl; ph = (rh == r) ? bh : ph; off += cl + ch; }
    plo = pl; phi = ph;
}

template <int CTRL> __device__ __forceinline__ int dppi(int x) { return __builtin_amdgcn_mov_dpp(x, CTRL, 0xf, 0xf, true); }
__device__ __forceinline__ int row_sum16(int x) { x += dppi<0xB1>(x); x += dppi<0x4E>(x); x += dppi<0x141>(x); x += dppi<0x128>(x); return x; }

__device__ __forceinline__ void peerUv_fetch(v4u (&ld)[8], float& su, int& kk, const LAS int* sl, const unsigned char* Us, const float* SU, int c, int sub) {
#pragma unroll
    for (int i = 0; i < 8; ++i) { const int e = sl[4 * i + sub] & 16383; ld[i] = *(const v4u*)(Us + (size_t)e * 256 + 16 * c); }
    const int ent = sl[4 * (c & 7) + sub]; kk = ent >> 14; su = SU[ent & 16383];
}
__device__ __forceinline__ void peerUv_consume(const v4u (&ld)[8], const v4u h, float su, int kk, float sh, float* prow, int c) {
    int res = 0;
#pragma unroll
    for (int i = 0; i < 8; ++i) { int d = __builtin_amdgcn_sdot4((int)ld[i].x, (int)h.x, 0, false); d = __builtin_amdgcn_sdot4((int)ld[i].y, (int)h.y, d, false);
        d = __builtin_amdgcn_sdot4((int)ld[i].z, (int)h.z, d, false); d = __builtin_amdgcn_sdot4((int)ld[i].w, (int)h.w, d, false);
        d = row_sum16(d); res = (c == i) ? d : res; }
    if (c < 8) prow[kk] = (float)res * su * sh;
}
__device__ __forceinline__ void peer_U8v(Frame& F, const bf16* H2u, const unsigned long long* RSQ, const unsigned* RMX, const unsigned char* U8, const float* SU, float* PART) {
    const int s = blockIdx.x & 7, rho = blockIdx.x >> 3, nrho = F.G >> 3, TPW = NTOK / nrho, rounds = TPW / 64;
    const int lane = F.lane, c = lane & 15, sub = lane >> 4;
    const unsigned char* Us = U8 + (size_t)s * NEXP * 256; float* PARTs = PART + (size_t)s * NTOK * 128;
    LAS int* slist = (LAS int*)(F.lds + RING_OFF) + F.wave * 1024;
    for (int rd = 0; rd < rounds; ++rd) {
        const int tb = rho * TPW + rd * 64 + F.wave * 8;
        v4u hq[8]; float sh[8];
#pragma unroll
        for (int tt = 0; tt < 8; ++tt) { const size_t o = (size_t)(tb + tt) * 128 + lane; const int elo = F.EIDX[o], ehi = F.EIDX[o + 64]; int plo, phi; peer_sort_pos(elo, ehi, plo, phi);
            slist[tt * 128 + plo] = elo | (lane << 14); slist[tt * 128 + phi] = ehi | ((64 + lane) << 14);
            { const float rmx = __uint_as_float(RMX[tb + tt]), sc = (rmx > 0.f) ? rmx * (1.0f / 127.0f) : 1.0f, inv = 1.0f / sc;
              const bf16* hp = H2u + (size_t)(tb + tt) * DM + 256 * s + 16 * c; const v4u w0 = *(const v4u*)hp, w1 = *(const v4u*)(hp + 8);
              f32x4 f0 = {bflo(w0.x), bfhi(w0.x), bflo(w0.y), bfhi(w0.y)}, f1 = {bflo(w0.z), bfhi(w0.z), bflo(w0.w), bfhi(w0.w)}, f2 = {bflo(w1.x), bfhi(w1.x), bflo(w1.y), bfhi(w1.y)}, f3 = {bflo(w1.z), bfhi(w1.z), bflo(w1.w), bfhi(w1.w)};
              v4u hv; hv.x = q4(f0, inv, 0); hv.y = q4(f1, inv, 0); hv.z = q4(f2, inv, 0); hv.w = q4(f3, inv, 0); hq[tt] = hv;
              sh[tt] = sc / sqrtf((float)RSQ[tb + tt] * (1.0f / (2048.0f * 16777216.0f)) + EPS); } }
        LDS_WAIT(); asm volatile("" ::: "memory");
        const int qx = (rd & 1) ? 3 : 0;
        v4u lA[8], lB[8]; float suA, suB; int kA, kB;
#define PU_F(L, S_, K_, qq_, tt_) peerUv_fetch(L, S_, K_, slist + (tt_) * 128 + 32 * (((qq_) & 3) ^ qx), Us, SU, c, sub)
#define PU_C(L, S_, K_, tt_) peerUv_consume(L, hq[tt_], S_, K_, sh[tt_], PARTs + (size_t)(tb + (tt_)) * 128, c)
        PU_F(lA, suA, kA, 0, 0);
#pragma unroll 1
        for (int qq = 0; qq < 4; ++qq) {
            PU_F(lB, suB, kB, qq, 1); PU_C(lA, suA, kA, 0);
            PU_F(lA, suA, kA, qq, 2); PU_C(lB, suB, kB, 1);
            PU_F(lB, suB, kB, qq, 3); PU_C(lA, suA, kA, 2);
            PU_F(lA, suA, kA, qq, 4); PU_C(lB, suB, kB, 3);
            PU_F(lB, suB, kB, qq, 5); PU_C(lA, suA, kA, 4);
            PU_F(lA, suA, kA, qq, 6); PU_C(lB, suB, kB, 5);
            PU_F(lB, suB, kB, qq, 7); PU_C(lA, suA, kA, 6);
            PU_F(lA, suA, kA, qq + 1, 0); PU_C(lB, suB, kB, 7);
        }
#undef PU_F
#undef PU_C
        LDS_WAIT(); asm volatile("" ::: "memory");
    }
}

__device__ __forceinline__ void tr4(unsigned a, unsigned b, unsigned c, unsigned d, unsigned& o0, unsigned& o1, unsigned& o2, unsigned& o3) {
    const unsigned t0 = __builtin_amdgcn_perm(a, b, 0x01050004u), t1 = __builtin_amdgcn_perm(a, b, 0x03070206u);
    const unsigned t2 = __builtin_amdgcn_perm(c, d, 0x01050004u), t3 = __builtin_amdgcn_perm(c, d, 0x03070206u);
    o0 = __builtin_amdgcn_perm(t0, t2, 0x01000504u); o1 = __builtin_amdgcn_perm(t0, t2, 0x03020706u);
    o2 = __builtin_amdgcn_perm(t1, t3, 0x01000504u); o3 = __builtin_amdgcn_perm(t1, t3, 0x03020706u);
}
__device__ __forceinline__ void peerVd_consume(int (&acc)[16], const v4u (&ld)[8], const unsigned (&wq)[2]) {
#pragma unroll
    for (int blk = 0; blk < 2; ++blk) { const int w = (int)wq[blk]; unsigned t[4];
        tr4(ld[4 * blk].x, ld[4 * blk + 1].x, ld[4 * blk + 2].x, ld[4 * blk + 3].x, t[0], t[1], t[2], t[3]);
#pragma unroll
        for (int j = 0; j < 4; ++j) acc[j] = __builtin_amdgcn_sdot4((int)t[j], w, acc[j], false);
        tr4(ld[4 * blk].y, ld[4 * blk + 1].y, ld[4 * blk + 2].y, ld[4 * blk + 3].y, t[0], t[1], t[2], t[3]);
#pragma unroll
        for (int j = 0; j < 4; ++j) acc[4 + j] = __builtin_amdgcn_sdot4((int)t[j], w, acc[4 + j], false);
        tr4(ld[4 * blk].z, ld[4 * blk + 1].z, ld[4 * blk + 2].z, ld[4 * blk + 3].z, t[0], t[1], t[2], t[3]);
#pragma unroll
        for (int j = 0; j < 4; ++j) acc[8 + j] = __builtin_amdgcn_sdot4((int)t[j], w, acc[8 + j], false);
        tr4(ld[4 * blk].w, ld[4 * blk + 1].w, ld[4 * blk + 2].w, ld[4 * blk + 3].w, t[0], t[1], t[2], t[3]);
#pragma unroll
        for (int j = 0; j < 4; ++j) acc[12 + j] = __builtin_amdgcn_sdot4((int)t[j], w, acc[12 + j], false); }
}
__device__ __forceinline__ void peer_actw(Frame& F, const float* PART, const float* SV, unsigned short* SE16, unsigned char* SWB, float* SWT) {
    const int gw = F.vcu * NWAVES + F.wave, NGW = F.G * NWAVES, lane = F.lane;
#pragma unroll 2
    for (int t = gw; t < NTOK; t += NGW) { const size_t o = (size_t)t * 128 + lane; const int elo = F.EIDX[o], ehi = F.EIDX[o + 64];
        float a0 = 0.f, a1 = 0.f;
#pragma unroll
        for (int sp = 0; sp < 8; ++sp) { a0 += PART[(size_t)sp * NTOK * 128 + o]; a1 += PART[(size_t)sp * NTOK * 128 + o + 64]; }
        a0 = 0.5f * a0 * (1.0f + erff(a0 * 0.70710678118654752f)) * F.GATE[o] * SV[elo]; a1 = 0.5f * a1 * (1.0f + erff(a1 * 0.70710678118654752f)) * F.GATE[o + 64] * SV[ehi];
        const float wm = wave_max(fmaxf(fabsf(a0), fabsf(a1))); const float sc = (wm > 0.f) ? wm * (1.0f / 127.0f) : 1.0f, inv = 1.0f / sc;
        const int q0 = (int)rintf(a0 * inv), q1 = (int)rintf(a1 * inv);
        int plo, phi; peer_sort_pos(elo, ehi, plo, phi);
        SE16[(size_t)t * 128 + plo] = (unsigned short)elo; SE16[(size_t)t * 128 + phi] = (unsigned short)ehi;
        SWB[(size_t)t * 128 + (plo >> 4) * 16 + (plo & 3) * 4 + ((plo >> 2) & 3)] = (unsigned char)q0; SWB[(size_t)t * 128 + (phi >> 4) * 16 + (phi & 3) * 4 + ((phi >> 2) & 3)] = (unsigned char)q1;
        if (lane == 0) SWT[t] = sc; }
}
__device__ __forceinline__ float xsum4(float x) {
    { auto r = __builtin_amdgcn_permlane16_swap(__float_as_uint(x), __float_as_uint(x), false, false); x = __uint_as_float(r[0]) + __uint_as_float(r[1]); }
    { auto r = __builtin_amdgcn_permlane32_swap(__float_as_uint(x), __float_as_uint(x), false, false); x = __uint_as_float(r[0]) + __uint_as_float(r[1]); }
    return x;
}
__device__ __forceinline__ void peerVe_fetch(v4u (&ld)[8], unsigned (&wq)[2], const LAS unsigned short* se, const LAS unsigned* swq, const unsigned char* Vs, int c, int sub) {
#pragma unroll
    for (int i = 0; i < 8; ++i) { const int e = se[4 * i + sub]; ld[i] = *(const v4u*)(Vs + (size_t)e * 256 + 16 * c); }
    wq[0] = swq[sub]; wq[1] = swq[4 + sub];
}
__device__ __forceinline__ void peer_V8d(Frame& F, const float* X1, const unsigned char* V8, const unsigned short* SE16, const unsigned char* SWB, const float* SWT) {
    const int s = blockIdx.x & 7, rho = blockIdx.x >> 3, nrho = F.G >> 3, TPW = NTOK / nrho, rounds = TPW / 32;
    const int lane = F.lane, c = lane & 15, sub = lane >> 4;
    const unsigned char* Vs = V8 + (size_t)s * NEXP * 256;
    LAS unsigned short* sle = (LAS unsigned short*)(F.lds + RING_OFF + F.wave * 1536);
    LAS unsigned char* swb = (LAS unsigned char*)(sle + 512);
    for (int rd = 0; rd < rounds; ++rd) {
        const int tb = rho * TPW + rd * 32 + F.wave * 4;
        int acc[4][16]; float swt[4];
#pragma unroll
        for (int tt = 0; tt < 4; ++tt) { *(LAS unsigned*)(sle + tt * 128 + 2 * lane) = *(const unsigned*)(SE16 + (size_t)(tb + tt) * 128 + 2 * lane);
            if (lane < 32) *(LAS unsigned*)(swb + tt * 128 + 4 * lane) = *(const unsigned*)(SWB + (size_t)(tb + tt) * 128 + 4 * lane);
            swt[tt] = SWT[tb + tt];
#pragma unroll
            for (int k = 0; k < 16; ++k) acc[tt][k] = 0; }
        LDS_WAIT(); asm volatile("" ::: "memory");
        const int qx = (rd & 1) ? 3 : 0;
        v4u lA[8], lB[8]; unsigned wA[2], wB[2];
#define PV_F(L, Wt, qq_, tt_) peerVe_fetch(L, Wt, sle + (tt_) * 128 + 32 * (((qq_) & 3) ^ qx), (const LAS unsigned*)(swb + (tt_) * 128 + 32 * (((qq_) & 3) ^ qx)), Vs, c, sub)
        PV_F(lA, wA, 0, 0);
#pragma unroll 1
        for (int qq = 0; qq < 4; ++qq) {
            PV_F(lB, wB, qq, 1); peerVd_consume(acc[0], lA, wA);
            PV_F(lA, wA, qq, 2); peerVd_consume(acc[1], lB, wB);
            PV_F(lB, wB, qq, 3); peerVd_consume(acc[2], lA, wA);
            PV_F(lA, wA, qq + 1, 0); peerVd_consume(acc[3], lB, wB);
        }
#undef PV_F
#pragma unroll
        for (int tt = 0; tt < 4; ++tt) { float f[16];
#pragma unroll
            for (int k = 0; k < 16; ++k) f[k] = xsum4((float)acc[tt][k] * swt[tt]);
            if (sub == 0) { const size_t oo = (size_t)(tb + tt) * DM + 256 * s + 16 * c;
#pragma unroll
                for (int k4 = 0; k4 < 4; ++k4) { f32x4 o = *(const f32x4*)(X1 + oo + 4 * k4); o.x += f[4 * k4]; o.y += f[4 * k4 + 1]; o.z += f[4 * k4 + 2]; o.w += f[4 * k4 + 3]; *(f32x4*)(F.out + oo + 4 * k4) = o; } } }
        LDS_WAIT(); asm volatile("" ::: "memory");
    }
}


__device__ __forceinline__ int ord_i(float x) { const int b = __builtin_bit_cast(int, x); return b ^ ((b >> 31) & 0x7fffffff); }
__device__ __forceinline__ float ord_f(int k) { return __builtin_bit_cast(float, k ^ ((k >> 31) & 0x7fffffff)); }
__device__ __forceinline__ int imax3(int a, int b, int c) { int r; asm("v_max3_i32 %0, %1, %2, %3" : "=v"(r) : "v"(a), "v"(b), "v"(c)); return r; }
constexpr int TK_MIN = (int)0x80000000;
__device__ __forceinline__ void topk_phase(Frame& F, const bf16* QH, const bf16* QL, const bf16* SKH, const bf16* SKL) {
    const int tid = F.tid, lane = F.lane, r = lane & 31, lh = lane >> 5;
    LAS unsigned char* Lkh = F.lds + RING_OFF;
    LAS unsigned char* Lkl = Lkh + 128 * LROW;
    LAS int* top = (LAS int*)(Lkl + 128 * LROW) + F.wave * 1536;
    LAS int* best = top + 1024;
    for (int task = F.vcu; task < 8 * (NTOK / 256); task += F.G) {
        const int h = task & 7, t0 = ((task >> 3) * 8 + F.wave) * 32;
#pragma unroll 1
        for (int hf = 0; hf < 2; ++hf) {
            __syncthreads();
            { v4u gh[4], gl[4]; tile_ld<4>(gh, SKH + (size_t)(h * 2 + hf) * 16384, 128, tid); tile_ld<4>(gl, SKL + (size_t)(h * 2 + hf) * 16384, 128, tid); tile_st<4>(gh, Lkh, tid); tile_st<4>(gl, Lkl, tid); }
            bf16x8 qh[8], ql[8];
            { const size_t o = (size_t)(t0 + r) * DM + h * 256 + hf * 128 + 8 * lh;
#pragma unroll
              for (int ks = 0; ks < 8; ++ks) { qh[ks] = *(const bf16x8*)(QH + o + 16 * ks); ql[ks] = *(const bf16x8*)(QL + o + 16 * ks); } }
            __syncthreads();
            int pk[64];
#pragma unroll
            for (int kt = 0; kt < 4; ++kt) { f32x16 a = (f32x16){0}; const int ko = (32 * kt + r) * LROW + 16 * lh;
#pragma unroll
                for (int ks = 0; ks < 8; ++ks) { const bf16x8 kh = *(const LAS bf16x8*)(Lkh + ko + 32 * ks), kl = *(const LAS bf16x8*)(Lkl + ko + 32 * ks);
                    a = MFMA32(kl, qh[ks], a); a = MFMA32(kh, ql[ks], a); a = MFMA32(kh, qh[ks], a); }
#pragma unroll
                for (int reg = 0; reg < 16; ++reg) { const int key = 32 * kt + (reg & 3) + 8 * (reg >> 2) + 4 * lh; pk[16 * kt + reg] = (ord_i(a[reg]) & ~127) | (127 - key); }
                asm volatile("" ::: "memory"); }
#pragma unroll 1
            for (int it = 0; it < 16; ++it) {
                int m = imax3(pk[0], pk[1], pk[2]);
#pragma unroll
                for (int i = 3; i < 63; i += 2) m = imax3(m, pk[i], pk[i + 1]);
                m = max(m, pk[63]);
                const int o = __shfl_xor(m, 32); const int W = max(m, o);
                if (lh == 0) top[(hf * 16 + it) * 32 + r] = W;
#pragma unroll
                for (int i = 0; i < 64; ++i) pk[i] = (pk[i] == W) ? TK_MIN : pk[i];
            }
        }
        LDS_WAIT(); asm volatile("" ::: "memory");
        float v1[16], v2[16];
#pragma unroll
        for (int a = 0; a < 16; ++a) { v1[a] = ord_f(top[a * 32 + r] & ~127); v2[a] = ord_f(top[(16 + a) * 32 + r] & ~127); }
        int cp[25];
        { const float s0 = v1[0] + v2[0], s1 = v1[0] + v2[1]; const int c0 = (ord_i(s0) & ~255) | 255, c1 = (ord_i(s1) & ~255) | 254; cp[0] = lh ? c1 : c0; }
        { const float s0 = v1[0] + v2[2], s1 = v1[0] + v2[3]; const int c0 = (ord_i(s0) & ~255) | 253, c1 = (ord_i(s1) & ~255) | 252; cp[1] = lh ? c1 : c0; }
        { const float s0 = v1[0] + v2[4], s1 = v1[0] + v2[5]; const int c0 = (ord_i(s0) & ~255) | 251, c1 = (ord_i(s1) & ~255) | 250; cp[2] = lh ? c1 : c0; }
        { const float s0 = v1[0] + v2[6], s1 = v1[0] + v2[7]; const int c0 = (ord_i(s0) & ~255) | 249, c1 = (ord_i(s1) & ~255) | 248; cp[3] = lh ? c1 : c0; }
        { const float s0 = v1[0] + v2[8], s1 = v1[0] + v2[9]; const int c0 = (ord_i(s0) & ~255) | 247, c1 = (ord_i(s1) & ~255) | 246; cp[4] = lh ? c1 : c0; }
        { const float s0 = v1[0] + v2[10], s1 = v1[0] + v2[11]; const int c0 = (ord_i(s0) & ~255) | 245, c1 = (ord_i(s1) & ~255) | 244; cp[5] = lh ? c1 : c0; }
        { const float s0 = v1[0] + v2[12], s1 = v1[0] + v2[13]; const int c0 = (ord_i(s0) & ~255) | 243, c1 = (ord_i(s1) & ~255) | 242; cp[6] = lh ? c1 : c0; }
        { const float s0 = v1[0] + v2[14], s1 = v1[0] + v2[15]; const int c0 = (ord_i(s0) & ~255) | 241, c1 = (ord_i(s1) & ~255) | 240; cp[7] = lh ? c1 : c0; }
        { const float s0 = v1[1] + v2[0], s1 = v1[1] + v2[1]; const int c0 = (ord_i(s0) & ~255) | 239, c1 = (ord_i(s1) & ~255) | 238; cp[8] = lh ? c1 : c0; }
        { const float s0 = v1[1] + v2[2], s1 = v1[1] + v2[3]; const int c0 = (ord_i(s0) & ~255) | 237, c1 = (ord_i(s1) & ~255) | 236; cp[9] = lh ? c1 : c0; }
        { const float s0 = v1[1] + v2[4], s1 = v1[1] + v2[5]; const int c0 = (ord_i(s0) & ~255) | 235, c1 = (ord_i(s1) & ~255) | 234; cp[10] = lh ? c1 : c0; }
        { const float s0 = v1[1] + v2[6], s1 = v1[1] + v2[7]; const int c0 = (ord_i(s0) & ~255) | 233, c1 = (ord_i(s1) & ~255) | 232; cp[11] = lh ? c1 : c0; }
        { const float s0 = v1[2] + v2[0], s1 = v1[2] + v2[1]; const int c0 = (ord_i(s0) & ~255) | 223, c1 = (ord_i(s1) & ~255) | 222; cp[12] = lh ? c1 : c0; }
        { const float s0 = v1[2] + v2[2], s1 = v1[2] + v2[3]; const int c0 = (ord_i(s0) & ~255) | 221, c1 = (ord_i(s1) & ~255) | 220; cp[13] = lh ? c1 : c0; }
        { const float s0 = v1[2] + v2[4], s1 = v1[3] + v2[0]; const int c0 = (ord_i(s0) & ~255) | 219, c1 = (ord_i(s1) & ~255) | 207; cp[14] = lh ? c1 : c0; }
        { const float s0 = v1[3] + v2[1], s1 = v1[3] + v2[2]; const int c0 = (ord_i(s0) & ~255) | 206, c1 = (ord_i(s1) & ~255) | 205; cp[15] = lh ? c1 : c0; }
        { const float s0 = v1[3] + v2[3], s1 = v1[4] + v2[0]; const int c0 = (ord_i(s0) & ~255) | 204, c1 = (ord_i(s1) & ~255) | 191; cp[16] = lh ? c1 : c0; }
        { const float s0 = v1[4] + v2[1], s1 = v1[4] + v2[2]; const int c0 = (ord_i(s0) & ~255) | 190, c1 = (ord_i(s1) & ~255) | 189; cp[17] = lh ? c1 : c0; }
        { const float s0 = v1[5] + v2[0], s1 = v1[5] + v2[1]; const int c0 = (ord_i(s0) & ~255) | 175, c1 = (ord_i(s1) & ~255) | 174; cp[18] = lh ? c1 : c0; }
        { const float s0 = v1[6] + v2[0], s1 = v1[6] + v2[1]; const int c0 = (ord_i(s0) & ~255) | 159, c1 = (ord_i(s1) & ~255) | 158; cp[19] = lh ? c1 : c0; }
        { const float s0 = v1[7] + v2[0], s1 = v1[7] + v2[1]; const int c0 = (ord_i(s0) & ~255) | 143, c1 = (ord_i(s1) & ~255) | 142; cp[20] = lh ? c1 : c0; }
        { const float s0 = v1[8] + v2[0], s1 = v1[9] + v2[0]; const int c0 = (ord_i(s0) & ~255) | 127, c1 = (ord_i(s1) & ~255) | 111; cp[21] = lh ? c1 : c0; }
        { const float s0 = v1[10] + v2[0], s1 = v1[11] + v2[0]; const int c0 = (ord_i(s0) & ~255) | 95, c1 = (ord_i(s1) & ~255) | 79; cp[22] = lh ? c1 : c0; }
        { const float s0 = v1[12] + v2[0], s1 = v1[13] + v2[0]; const int c0 = (ord_i(s0) & ~255) | 63, c1 = (ord_i(s1) & ~255) | 47; cp[23] = lh ? c1 : c0; }
        { const float s0 = v1[14] + v2[0], s1 = v1[15] + v2[0]; const int c0 = (ord_i(s0) & ~255) | 31, c1 = (ord_i(s1) & ~255) | 15; cp[24] = lh ? c1 : c0; }
#pragma unroll 1
        for (int it = 0; it < 16; ++it) {
            int m = imax3(cp[0], cp[1], cp[2]);
#pragma unroll
            for (int i = 3; i < 25; i += 2) m = imax3(m, cp[i], cp[i + 1]);
            const int o = __shfl_xor(m, 32); const int W = max(m, o);
            if (lh == 0) best[it * 32 + r] = W;
#pragma unroll
            for (int i = 0; i < 25; ++i) cp[i] = (cp[i] == W) ? TK_MIN : cp[i];
        }
        LDS_WAIT(); asm volatile("" ::: "memory");
        float bv[16]; int bp[16];
#pragma unroll
        for (int it = 0; it < 16; ++it) { const int W = best[it * 32 + r]; bv[it] = ord_f(W & ~255); bp[it] = 255 - (W & 255); }
        float den = 0.f, ex[16];
#pragma unroll
        for (int it = 0; it < 16; ++it) { ex[it] = __expf(bv[it] - bv[0]); den += ex[it]; }
        const float inv = 1.0f / den;
        int* ei = F.EIDX + (size_t)(t0 + r) * 128 + h * 16 + 8 * lh; float* go = F.GATE + (size_t)(t0 + r) * 128 + h * 16 + 8 * lh;
        int eo[8]; float gv[8];
#pragma unroll
        for (int j = 0; j < 8; ++j) { const int pA = bp[j], pB = bp[8 + j]; const int p = lh ? pB : pA;
            const int e1 = 127 - (top[(p >> 4) * 32 + r] & 127), e2 = 127 - (top[(16 + (p & 15)) * 32 + r] & 127);
            eo[j] = e1 * 128 + e2; gv[j] = (lh ? ex[8 + j] : ex[j]) * inv; }
        { v4u w; w.x = eo[0]; w.y = eo[1]; w.z = eo[2]; w.w = eo[3]; *(v4u*)ei = w; w.x = eo[4]; w.y = eo[5]; w.z = eo[6]; w.w = eo[7]; *(v4u*)(ei + 4) = w;
          f32x4 g; g.x = gv[0]; g.y = gv[1]; g.z = gv[2]; g.w = gv[3]; *(f32x4*)go = g; g.x = gv[4]; g.y = gv[5]; g.z = gv[6]; g.w = gv[7]; *(f32x4*)(go + 4) = g; }
        LDS_WAIT(); asm volatile("" ::: "memory");
    }
}
struct Args { const float* in[16]; float* out; unsigned char* ws; int ph_lo, ph_hi, li, pad; };
__global__ void __launch_bounds__(NWAVES * 64, 2) layer_fwd(Args args) {
    extern __shared__ __attribute__((aligned(16))) unsigned char lds[];
    Frame F;
    F.lds = (LAS unsigned char*)lds;
    F.MISC = (volatile LAS unsigned*)(F.lds + MISC_OFF);
    F.tid = threadIdx.x; F.lane = F.tid & 63; F.wave = __builtin_amdgcn_readfirstlane(F.tid >> 6);
    F.G = gridDim.x; { const int bx = blockIdx.x; F.vcu = (F.G % 8 == 0) ? (bx % 8) * (F.G / 8) + bx / 8 : bx; }
    unsigned char* ws = args.ws;
    F.ctl = (gu32*)(ws + WS_CTL);
    F.x = args.in[0]; F.mix_g = args.in[1]; F.w_in = args.in[2]; F.dec_f = args.in[3]; F.dec_b = args.in[4]; F.gn_g = args.in[5]; F.w_ret = args.in[6]; F.qn_g = args.in[7];
    F.kn_g = args.in[8]; F.w_att = args.in[9]; F.w_out = args.in[10]; F.ffn_g = args.in[11]; F.w_pq = args.in[12]; F.subk = args.in[13]; F.pu = args.in[14]; F.pv = args.in[15];
    F.out = args.out;
    F.WinT = (bf16*)(ws + WS_WINT); F.WretT = (bf16*)(ws + WS_WRET); F.WattT = (bf16*)(ws + WS_WATT); F.WoutT = (bf16*)(ws + WS_WOUT); F.WqT = (bf16*)(ws + WS_WQ);
    F.XN = (bf16*)(ws + WS_XN); F.PROJ = (bf16*)(ws + WS_PROJ); F.Ubf = (bf16*)(ws + WS_UBF); F.Vbf = (bf16*)(ws + WS_VBF); F.ATT = (bf16*)(ws + WS_ATT);
    F.EIDX = (int*)(ws + WS_EIDX); F.GATE = (float*)(ws + WS_GATE); F.RTAB = (f32x2*)(ws + WS_RTAB); F.ATAB = (f32x2*)(ws + WS_ATAB); F.SKH = (bf16*)(ws + WS_SKH); F.SKL = (bf16*)(ws + WS_SKL);
    bf16* KDF = (bf16*)(ws + WS_WINT); bf16* KDB = KDF + (size_t)512 * 16384; bf16* VT = (bf16*)(ws + WS_WINT + 32 * MiB);
    bf16* UF = F.XN; bf16* UB = (bf16*)(ws + WS_WINT + 32 * MiB);
    bf16* OGN = (bf16*)(ws + WS_UBF + 64 * MiB); float* LSE = (float*)(ws + WS_WINT + 64 * MiB);
    bf16* RETO = KDF;
    bf16* MERGED = F.PROJ + PO_RQ;
    bf16* H2 = F.PROJ + PO_RV;
    float* TMP = (float*)(F.PROJ + PO_AK);
    bf16* QH = (bf16*)TMP; bf16* QL = QH + (size_t)NTOK * DM;
    float* X1 = (float*)(F.PROJ + PO_GR);
    unsigned char* U8 = ws + WS_UBF; unsigned char* V8 = ws + WS_UBF + 32 * MiB; float* SU = (float*)(ws + WS_SU); float* SV = SU + NEXP;
    unsigned long long* RSQ = (unsigned long long*)(SV + NEXP); unsigned* RMX = (unsigned*)(RSQ + NTOK); float* SX = (float*)(RMX + NTOK); unsigned* CMX = (unsigned*)(ws + WS_CTL + 32768);
    unsigned short* SE16 = (unsigned short*)(ws + WS_WINT); unsigned char* SWB = ws + WS_WINT + 2 * MiB; float* SWT = (float*)(ws + WS_WINT + 3 * MiB);
    unsigned long long* SSQ = (unsigned long long*)(ws + WS_UBF + 112 * MiB);
    float* PART = (float*)(ws + WS_WINT + 32 * MiB);
    for (int u = F.tid; u < (LDS_BYTES - LDSCTL_OFF) / 4; u += NWAVES * 64) ((LAS unsigned*)(F.lds + LDSCTL_OFF))[u] = 0u;
    __syncthreads();
    XcdBarrier bar; bar.bar = (unsigned*)(F.ctl + CW_BAR); bar.x = 0; bar.st = nullptr;
    if (N_LAUNCHES == 1) bar = xcd_barrier_post((unsigned*)(F.ctl + CW_BAR), F.MISC + 8);
#define GRID_BAR() do { if (N_LAUNCHES == 1) xcd_barrier(bar); } while (0)
#ifdef PROBE_TS
    unsigned long long tsA_ = 0, tsB_ = 0;
#define TS(k) do { if ((k) == PROBE_TS_A) tsA_ = __builtin_amdgcn_s_memrealtime(); if ((k) == PROBE_TS_B) tsB_ = __builtin_amdgcn_s_memrealtime(); } while (0)
#else
#define TS(k) do {} while (0)
#endif
    TS(0);
    const int lo = args.ph_lo, hi = args.ph_hi;
#define IN(k) (lo <= (k) && (k) < hi)
#define BOTH(k) (IN(k) && IN((k) + 1))
    if (IN(0)) { { for (int z_ = F.vcu * 512 + F.tid; z_ < 2 * NTOK * 24; z_ += F.G * 512) SSQ[z_] = 0ull; for (int z_ = F.vcu * 512 + F.tid; z_ < NTOK; z_ += F.G * 512) { RSQ[z_] = 0ull; RMX[z_] = 0u; } p0_prologue(F, 0, CMX, SX); VM_WAIT(); __syncthreads();
#ifdef PROBE_P0
        { int reps_ = 1; asm volatile("" : "+s"(reps_)); for (int rep_ = 0; rep_ < reps_; ++rep_) { p0_prologue(F, 0, CMX, SX); VM_WAIT(); __syncthreads(); } }
#endif
        GRID_BAR();
#ifdef PROBE_P1
        { int reps_ = 1; asm volatile("" : "+s"(reps_)); for (int rep_ = 0; rep_ < reps_; ++rep_) { p0_prologue(F, 1, CMX, SX); VM_WAIT(); __syncthreads(); } }
#endif
        p0_prologue(F, 1, CMX, SX); VM_WAIT(); __syncthreads(); } if (BOTH(0)) GRID_BAR(); } TS(1);
    if (IN(1)) { { pg8::Gemm g{F.XN, F.WinT, NTOK, INW, DM / 2}; pg8::StaticOrder S; S.init(NTOK, INW, F.G, (int)blockIdx.x);
#ifdef PROBE_GEMM
        pg8::EpiProj8 E{F.PROJ, SSQ, (const float*)F.RTAB, 0, SX, CMX};
        { int md_ = PROBE_GEMM; asm volatile("" : "+s"(md_)); E.mode = md_; pg8::gemm_phase<pg8::EpiProj8, pg8::StaticOrder, PG8_ALIGN, PG8_SP2, true, true>(F.lds + RING_OFF, g, S, E); __syncthreads(); md_ = 0; asm volatile("" : "+s"(md_)); E.mode = md_; }
#else
        pg8::EpiProj8 E{F.PROJ, SSQ, (const float*)F.RTAB, SX, CMX};
#endif
        const int nfull = (NTOK / 256) * (INW / 256) % F.G; const bool bal = (F.G == 256 && nfull == 128);
        int cv0 = 0, cv1 = 0, cvp = 0;
        if (bal) { const int c = (int)blockIdx.x, n = c < 128 ? CONV_R10 : 32 - CONV_R10; cv0 = c < 128 ? (c * 8 + F.wave) * CONV_R10 : 1024 * CONV_R10 + ((c - 128) * 8 + F.wave) * (32 - CONV_R10); cv1 = cv0 + n;
            cvp = (c >> 3) & 7; cvp = cvp * CONV_PRE; cvp = cvp < n ? cvp : n; conv_rows8(F.pu, F.pv, U8, V8, SU, SV, cv0, cv0 + cvp, F.lane); }
        pg8::gemm_phase<pg8::EpiProj8, pg8::StaticOrder, PG8_ALIGN, PG8_SP2, true, true>(F.lds + RING_OFF, g, S, E);
        if (bal) conv_rows8(F.pu, F.pv, U8, V8, SU, SV, cv0 + cvp, cv1, F.lane);
        else { int wv = F.vcu * NWAVES + F.wave, nw = F.G * NWAVES; bool go = (nfull == 0);
          if (nfull > 0 && (int)blockIdx.x >= nfull) { wv = ((int)blockIdx.x - nfull) * NWAVES + F.wave; nw = (F.G - nfull) * NWAVES; go = true; }
          if (go) { conv_tab8(F.pu, U8, SU, wv, nw, F.lane); conv_tab8(F.pv, V8, SV, wv, nw, F.lane); } }
        } if (BOTH(1)) GRID_BAR(); } TS(2);
    if (IN(3)) { { ret_phaseA3(F, UF, UB); att_phase3(F, OGN, LSE, SSQ); } if (BOTH(3)) GRID_BAR(); } TS(3);
    if (IN(4)) { { ret_phaseB(F, UF, UB); att_merge(F, OGN, LSE); } if (BOTH(4)) GRID_BAR(); } TS(4);
    if (IN(5)) { { ret_phaseC3(F, UF, UB, RETO); } if (BOTH(5)) GRID_BAR(); } TS(5);
    if (IN(6)) { { pg8::Gemm g{RETO, F.WretT, NTOK, DM, DM}; pg8::StaticOrder S; S.init(NTOK, DM, F.G, (int)blockIdx.x);
        pg8::EpiGateF32 E{TMP, F.PROJ + PO_GR, DM};
        pg8::gemm_phase<pg8::EpiGateF32, pg8::StaticOrder, PG8_ALIGN, PG8_SP2>(F.lds + RING_OFF, g, S, E);
        } VM_WAIT(); __syncthreads(); }
    TS(6);
    if (IN(7)) { { pg8::Gemm g{F.ATT, F.WattT, NTOK, DM, 1024}; pg8::StaticOrder S; S.init(NTOK, DM, F.G, (int)blockIdx.x);
        pg8::EpiGateAddBf16 E{MERGED, TMP, F.PROJ + PO_GA, DM};
        pg8::gemm_phase<pg8::EpiGateAddBf16, pg8::StaticOrder, PG8_ALIGN, PG8_SP2>(F.lds + RING_OFF, g, S, E);
        } if (BOTH(7)) GRID_BAR(); } TS(7);
    if (IN(8)) { { pg8::Gemm g{MERGED, F.WoutT, NTOK, DM, DM}; pg8::StaticOrder S; S.init(NTOK, DM, F.G, (int)blockIdx.x);
        pg8::EpiResNorm E{X1, F.x, H2, F.ffn_g, RSQ, RMX, DM};
        pg8::gemm_phase<pg8::EpiResNorm, pg8::StaticOrder, PG8_ALIGN, PG8_SP2>(F.lds + RING_OFF, g, S, E);
        } if (BOTH(8)) GRID_BAR(); } TS(8);
    if (IN(10)) { { pg8::Gemm g{H2, F.WqT, NTOK, DM, DM}; pg8::StaticOrder S; S.init(NTOK, DM, F.G, (int)blockIdx.x);
        pg8::EpiHiLoScaled E{QH, QL, RSQ, DM, 1.0f / DM, EPS};
        pg8::gemm_phase<pg8::EpiHiLoScaled, pg8::StaticOrder, PG8_ALIGN, PG8_SP2>(F.lds + RING_OFF, g, S, E);
        } if (BOTH(10)) GRID_BAR(); } TS(9);
    if (IN(11)) { { topk_phase(F, QH, QL, F.SKH, F.SKL); } if (BOTH(11)) GRID_BAR(); } TS(10);
    if (IN(12)) { { peer_U8v(F, H2, RSQ, RMX, U8, SU, PART); } if (BOTH(12)) GRID_BAR(); } TS(11);
    if (IN(13)) { { peer_actw(F, PART, SV, SE16, SWB, SWT); } if (BOTH(13)) GRID_BAR(); } TS(12);
    if (IN(14)) { { peer_V8d(F, X1, V8, SE16, SWB, SWT); } }
    TS(13);
#ifdef PROBE_TS
    if (blockIdx.x == 0) { const unsigned long long te_ = __builtin_amdgcn_s_memrealtime(); const unsigned long long d_ = (tsB_ - tsA_) * (unsigned long long)(PROBE_TS); while (__builtin_amdgcn_s_memrealtime() - te_ < d_) __builtin_amdgcn_s_sleep(8); }
#endif
#undef IN
#undef BOTH
}

extern "C" void kernel_launch(void* const* d_in, const int* in_sizes, int n_in, void* d_out, int out_size, void* d_ws, size_t ws_size, hipStream_t stream) {
    static int grid = 0;
    if (grid == 0) {
        if (n_in != 16 || in_sizes[0] != NTOK * DM || out_size != NTOK * DM || ws_size < WS_END) { fprintf(stderr, "kernel_launch: unexpected shapes / workspace (%d inputs, ws %zu)\n", n_in, ws_size); grid = -1; return; }
        int dev = 0, cus = 0, per_cu = 0;
        if (hipGetDevice(&dev) != hipSuccess || hipDeviceGetAttribute(&cus, hipDeviceAttributeMultiprocessorCount, dev) != hipSuccess) { grid = -1; return; }
        if (hipFuncSetAttribute((const void*)layer_fwd, hipFuncAttributeMaxDynamicSharedMemorySize, LDS_BYTES) != hipSuccess) { grid = -1; return; }
        if (hipOccupancyMaxActiveBlocksPerMultiprocessor(&per_cu, (const void*)layer_fwd, NWAVES * 64, LDS_BYTES) != hipSuccess || per_cu < 1) { fprintf(stderr, "kernel_launch: occupancy query says %d\n", per_cu); grid = -1; (void)hipGetLastError(); return; }
        (void)hipGetLastError();
        grid = cus;
    }
    if (grid < 0) return;
    if (hipMemsetAsync((char*)d_ws + WS_CTL, 0, CTL_ZERO_BYTES, stream) != hipSuccess) return;
    Args a{};
    for (int i = 0; i < 16; ++i) a.in[i] = (const float*)d_in[i];
    a.out = (float*)d_out; a.ws = (unsigned char*)d_ws;
    for (int li = 0; li < N_LAUNCHES; ++li) {
        a.ph_lo = (N_LAUNCHES == 1) ? 0 : li; a.ph_hi = (N_LAUNCHES == 1) ? N_PHASES : li + 1; a.li = li;
        hipLaunchKernelGGL(layer_fwd, dim3(grid), dim3(NWAVES * 64), LDS_BYTES, stream, a);
    }
}
```
